# Optimizing an MI355X kernel written in HIP

```python
import jax, jax.numpy as jnp
from jax import lax
import numpy as np

D_MODEL = 1024
BATCH = 4
SEQ = 8192
DEPTH = 1

HG_HEADS = 4
HG_DK = 128
HG_DV = 128
HG_KDIM = HG_HEADS * HG_DK
HG_WIDTH = HG_HEADS * HG_DV
HG_CHUNK = 64
SB_HEADS = 8
SB_DH = 64
SB_WIDTH = SB_HEADS * SB_DH
SB_BLOCK = 128
D_MIX = HG_WIDTH + SB_WIDTH
IN_SPLITS = (HG_KDIM, 2 * HG_KDIM, 2 * HG_KDIM + HG_WIDTH, 2 * HG_KDIM + 2 * HG_WIDTH,
             2 * HG_KDIM + 2 * HG_WIDTH + SB_WIDTH, 2 * HG_KDIM + 2 * HG_WIDTH + 2 * SB_WIDTH)
IN_COLS = 2 * HG_KDIM + 2 * HG_WIDTH + 3 * SB_WIDTH
N_EXPERTS = 32
TOP_K = 4
D_FF = 1024
MOE_BLOCK = 256
SWIGLU_LIMIT = 7.0
SWIGLU_ALPHA = 1.702
NORM_EPS = 1e-5

kernel_name = "hymba_hgrn2_stickbreaking_moe"


def rms_norm(x, gain):
    xf = x.astype(jnp.float32)
    var = jnp.mean(xf * xf, axis=-1, keepdims=True)
    return xf * lax.rsqrt(var + NORM_EPS) * gain.astype(jnp.float32)


def hgrn2_group(q_raw, f_raw, i_raw, g_raw, lb, gain):
    B, S, _ = q_raw.shape
    nc = S // HG_CHUNK
    q = jax.nn.silu(q_raw)
    f_sig = jax.nn.sigmoid(f_raw)
    logf = jnp.log(lb + (1.0 - lb) * f_sig)
    k = (1.0 - lb) * (1.0 - f_sig)

    def chunks(t, d):
        return t.reshape(B, nc, HG_CHUNK, HG_HEADS, d).transpose(1, 0, 3, 2, 4)

    causal = jnp.tril(jnp.ones((HG_CHUNK, HG_CHUNK), dtype=bool))

    def step(state, inp):
        qc, kc, gc, vc = inp
        G = jnp.cumsum(gc, axis=2)
        diff = G[:, :, :, None, :] - G[:, :, None, :, :]
        decay = jnp.exp(jnp.where(causal[:, :, None], diff, -jnp.inf))
        scores = jnp.einsum('bhtk,bhtsk,bhsk->bhts', qc, decay, kc)
        o = (jnp.einsum('bhts,bhsv->bhtv', scores, vc)
             + jnp.einsum('bhtk,bhkv->bhtv', qc * jnp.exp(G), state))
        G_last = G[:, :, -1:, :]
        new_state = (jnp.exp(G_last[:, :, 0, :])[..., None] * state
                     + jnp.einsum('bhsk,bhsv->bhkv', kc * jnp.exp(G_last - G), vc))
        return new_state, o

    state0 = jnp.zeros((B, HG_HEADS, HG_DK, HG_DV), jnp.float32)
    _, o = lax.scan(step, state0, (chunks(q, HG_DK), chunks(k, HG_DK), chunks(logf, HG_DK), chunks(i_raw, HG_DV)))
    o = o.transpose(1, 0, 3, 2, 4).reshape(B, S, HG_HEADS, HG_DV)
    o = rms_norm(o, gain.reshape(HG_HEADS, HG_DV)).reshape(B, S, HG_WIDTH)
    return o * jax.nn.silu(g_raw)


def stick_breaking_group(q_raw, k_raw, v_raw, gain):
    B, S, _ = q_raw.shape
    nqb = S // SB_BLOCK
    scale = SB_DH ** -0.5

    def heads(t):
        return t.reshape(B, S, SB_HEADS, SB_DH).transpose(0, 2, 1, 3)

    q, k, v = heads(q_raw), heads(k_raw), heads(v_raw)
    blk = jnp.arange(SB_BLOCK)

    def query_block(qi):
        t0 = qi * SB_BLOCK
        qb = lax.dynamic_slice_in_dim(q, t0, SB_BLOCK, axis=2)
        t_pos = t0 + blk

        def cond(c):
            return c[0] >= 0

        def body(c):
            j, acc, out = c
            s0 = j * SB_BLOCK
            kb = lax.dynamic_slice_in_dim(k, s0, SB_BLOCK, axis=2)
            vb = lax.dynamic_slice_in_dim(v, s0, SB_BLOCK, axis=2)
            mask = (s0 + blk)[None, :] < t_pos[:, None]
            z = jnp.einsum('bhtd,bhsd->bhts', qb, kb) * scale
            sp = jnp.where(mask, jax.nn.softplus(z), 0.0)
            later = lax.cumsum(sp, axis=3, reverse=True) - sp
            log_a = jax.nn.log_sigmoid(z) - later - acc[..., None]
            a = jnp.where(mask, jnp.exp(log_a), 0.0)
            out = out + jnp.einsum('bhts,bhsd->bhtd', a, vb)
            return j - 1, acc + jnp.sum(sp, axis=-1), out

        init = (qi, jnp.zeros((B, SB_HEADS, SB_BLOCK), jnp.float32),
                jnp.zeros((B, SB_HEADS, SB_BLOCK, SB_DH), jnp.float32))
        _, _, out = lax.while_loop(cond, body, init)
        return out

    o = lax.map(query_block, jnp.arange(nqb, dtype=jnp.int32))
    o = o.transpose(1, 0, 3, 2, 4).reshape(B, S, SB_HEADS, SB_DH)
    return rms_norm(o, gain.reshape(SB_HEADS, SB_DH)).reshape(B, S, SB_WIDTH)


def moe_ffn(u, w_router, b_router, w_gate, b_gate, w_up, b_up, w_down, b_down):
    N, D = u.shape
    NK = N * TOP_K
    logits = jnp.einsum('nd,de->ne', u, w_router) + b_router
    top_vals, top_idx = lax.top_k(logits, TOP_K)
    gates = jax.nn.softmax(top_vals.astype(jnp.float32), axis=-1)
    flat_e = top_idx.reshape(-1)
    flat_tok = jnp.repeat(jnp.arange(N, dtype=jnp.int32), TOP_K)
    order = jnp.argsort(flat_e)
    sorted_e = flat_e[order]
    sorted_tok = flat_tok[order]
    sorted_gate = gates.reshape(-1)[order]
    counts = jnp.zeros((N_EXPERTS,), jnp.int32).at[flat_e].add(1)
    padded = ((counts + MOE_BLOCK - 1) // MOE_BLOCK) * MOE_BLOCK
    start_sorted = jnp.cumsum(counts) - counts
    cum_pad = jnp.cumsum(padded)
    start_pad = cum_pad - padded
    dest = start_pad[sorted_e] + (jnp.arange(NK, dtype=jnp.int32) - start_sorted[sorted_e])
    P = ((NK + MOE_BLOCK - 1) // MOE_BLOCK) * MOE_BLOCK + N_EXPERTS * MOE_BLOCK
    nb = P // MOE_BLOCK
    block_start = jnp.arange(nb, dtype=jnp.int32) * MOE_BLOCK
    block_e = jnp.minimum(jnp.sum(cum_pad[None, :] <= block_start[:, None], axis=1), N_EXPERTS - 1)
    x_disp = jnp.zeros((P, D), u.dtype).at[dest].set(u[sorted_tok])

    def expert_block(args):
        xb, e = args
        hg = xb @ w_gate[e] + b_gate[e]
        hu = xb @ w_up[e] + b_up[e]
        hg = jnp.minimum(hg, SWIGLU_LIMIT)
        hu = jnp.clip(hu, -SWIGLU_LIMIT, SWIGLU_LIMIT)
        glu = hg * jax.nn.sigmoid(SWIGLU_ALPHA * hg)
        return ((hu + 1.0) * glu) @ w_down[e] + b_down[e]

    y_disp = lax.map(expert_block, (x_disp.reshape(nb, MOE_BLOCK, D), block_e)).reshape(P, D)
    y = y_disp[dest] * sorted_gate[:, None].astype(y_disp.dtype)
    return jax.ops.segment_sum(y, sorted_tok, num_segments=N)


def setup_inputs(seed: int = 0) -> dict:
    key = jax.random.key(seed)
    ks = jax.random.split(key, 18)
    f32 = jnp.float32
    nrm = lambda k, shape, s: jax.random.normal(k, shape, f32) * s
    gain = lambda k, shape: 1.0 + 0.02 * jax.random.normal(k, shape, f32)
    return {
        'x': jax.random.normal(ks[0], (BATCH, SEQ, D_MODEL), f32),
        'w_in': nrm(ks[1], (DEPTH, D_MODEL, IN_COLS), D_MODEL ** -0.5),
        'w_out': nrm(ks[2], (DEPTH, D_MIX, D_MODEL), D_MIX ** -0.5),
        'hg_lb_logits': nrm(ks[3], (DEPTH + 1, HG_KDIM), 0.5),
        'hg_norm_gain': gain(ks[4], (DEPTH, HG_WIDTH)),
        'sb_norm_gain': gain(ks[5], (DEPTH, SB_WIDTH)),
        'norm_mix_gain': gain(ks[6], (DEPTH, D_MODEL)),
        'norm_ffn_gain': gain(ks[7], (DEPTH, D_MODEL)),
        'w_router': nrm(ks[8], (DEPTH, D_MODEL, N_EXPERTS), D_MODEL ** -0.5),
        'b_router': nrm(ks[9], (DEPTH, N_EXPERTS), 0.01),
        'w_gate': nrm(ks[10], (DEPTH, N_EXPERTS, D_MODEL, D_FF), D_MODEL ** -0.5),
        'b_gate': nrm(ks[11], (DEPTH, N_EXPERTS, D_FF), 0.01),
        'w_up': nrm(ks[12], (DEPTH, N_EXPERTS, D_MODEL, D_FF), D_MODEL ** -0.5),
        'b_up': nrm(ks[13], (DEPTH, N_EXPERTS, D_FF), 0.01),
        'w_down': nrm(ks[14], (DEPTH, N_EXPERTS, D_FF, D_MODEL), D_FF ** -0.5),
        'b_down': nrm(ks[15], (DEPTH, N_EXPERTS, D_MODEL), 0.01),
        'norm_final_gain': gain(ks[16], (D_MODEL,)),
    }


def reference(x, w_in, w_out, hg_lb_logits, hg_norm_gain, sb_norm_gain, norm_mix_gain, norm_ffn_gain,
              w_router, b_router, w_gate, b_gate, w_up, b_up, w_down, b_down, norm_final_gain):
    B, S, D = x.shape
    lb_all = jnp.cumsum(jax.nn.softmax(hg_lb_logits.astype(jnp.float32), axis=0), axis=0)
    h = x.astype(jnp.float32)
    for l in range(DEPTH):
        u = rms_norm(h, norm_mix_gain[l])
        proj = jnp.einsum('bsd,dc->bsc', u, w_in[l]).astype(jnp.float32)
        hq, hf, hi, hg, sq, sk, sv = jnp.split(proj, IN_SPLITS, axis=-1)
        o_hg = hgrn2_group(hq, hf, hi, hg, lb_all[l], hg_norm_gain[l])
        o_sb = stick_breaking_group(sq, sk, sv, sb_norm_gain[l])
        mix = jnp.concatenate([o_hg, o_sb], axis=-1)
        h = h + jnp.einsum('bsc,cd->bsd', mix, w_out[l])
        u = rms_norm(h, norm_ffn_gain[l]).reshape(B * S, D)
        h = h + moe_ffn(u, w_router[l], b_router[l], w_gate[l], b_gate[l], w_up[l], b_up[l],
                        w_down[l], b_down[l]).reshape(B, S, D).astype(jnp.float32)
    return rms_norm(h, norm_final_gain).astype(x.dtype)
```

```cpp
#include <hip/hip_runtime.h>
#include <cstdio>
#include <cstdint>

#ifndef PROBE_FLAGS
#define PROBE_FLAGS 0
#endif
#ifndef N_LAUNCH_MODE
#define N_LAUNCH_MODE 1
#endif

#define LAS __attribute__((address_space(3)))
typedef unsigned short bf16;
typedef short bf16x8 __attribute__((ext_vector_type(8)));
typedef float f32x2 __attribute__((ext_vector_type(2)));
typedef float f32x4 __attribute__((ext_vector_type(4)));
typedef float f32x16 __attribute__((ext_vector_type(16)));
typedef unsigned u32x2 __attribute__((ext_vector_type(2)));
typedef unsigned u32x4 __attribute__((ext_vector_type(4)));

constexpr int NTOK = 32768, DM = 1024, SEQ = 8192, NBATCH = 4;
constexpr int INC = 3584;
constexpr int C_HQ = 0, C_HF = 512, C_HI = 1024, C_HG = 1536, C_SQ = 2048, C_SK = 2560, C_SV = 3072;
constexpr int NE = 32, TOPK = 4, DFF = 1024, NK = NTOK * TOPK;
constexpr int ECAP = NTOK;
constexpr float EPS = 1e-5f, SW_LIMIT = 7.0f, SW_ALPHA = 1.702f;
constexpr float W8_SCALE = 64.0f, W8_INV = 1.0f / 64.0f;
constexpr float SB_EXIT = 110.0f;

constexpr size_t WS_WDN = 0;
constexpr size_t WS_WGU = WS_WDN + 67108864;
constexpr size_t WS_C = WS_WGU + 134217728;
constexpr size_t C_BYTES = (size_t)(NK + 256) * 2048;
constexpr size_t WS_D = WS_C + C_BYTES;
constexpr size_t WS_E = WS_D + 67108864;
constexpr size_t WS_H1B = WS_C;
constexpr size_t WS_MIX = WS_D;
constexpr size_t WS_H1Q = WS_WDN + 33554432;
constexpr size_t WS_PROJ = WS_C;
constexpr size_t WS_WIN = WS_PROJ + (size_t)NTOK * INC * 2;
constexpr size_t WS_WOUT = WS_WIN + (size_t)INC * 1024 * 2;
constexpr size_t WS_HST = WS_WOUT + (size_t)1024 * 1024 * 2;
constexpr size_t WS_HDEC = WS_HST + (size_t)256 * 65536;
static_assert(WS_HDEC + 256 * 128 * 4 <= WS_C + C_BYTES, "C region");
constexpr size_t WS_CTL = WS_E;
constexpr size_t CTL_BYTES = 1u << 20;
constexpr size_t WS_RSTD = WS_CTL + CTL_BYTES;
constexpr size_t WS_STOK = WS_RSTD + (size_t)NTOK * 4;
constexpr size_t WS_SGATE = WS_STOK + (size_t)NE * ECAP * 4;
constexpr size_t WS_SRSTD = WS_SGATE + (size_t)NE * ECAP * 4;
constexpr size_t WS_END = WS_SRSTD + (size_t)NE * ECAP * 4;
constexpr size_t HID_BYTES = (size_t)(NK + 256) * 1024;
constexpr size_t WS_HID = WS_C + C_BYTES - HID_BYTES;
constexpr size_t WS_Y = WS_WGU;
static_assert(WS_Y + (size_t)NK * DM <= WS_HID, "y vs hidden");
constexpr float Y8_SCALE = 16.0f, Y8_INV = 1.0f / 16.0f;
constexpr size_t WS_TSLOT = WS_END;
constexpr size_t WS_END2 = WS_TSLOT + (size_t)NTOK * 4 * 4;
constexpr int CW_JOB = 32;
constexpr int CW_CNT = 64;
constexpr int CW_BAR = 4096;

constexpr int RING_BYTES = 131072;
constexpr int MISC_OFF = RING_BYTES;
constexpr int IDX_OFF = MISC_OFF + 9216;
constexpr int META_OFF = MISC_OFF + 10240, META_BYTES = 3072;
constexpr int LDS_BYTES = 147456;
constexpr int NWAVES = 8, NTHR = 512;

__device__ __forceinline__ unsigned f2bf(float f) { unsigned u = __builtin_bit_cast(unsigned, f); return (u + 0x7fffu + ((u >> 16) & 1u)) >> 16; }
__device__ __forceinline__ unsigned pk2(float lo, float hi) { return f2bf(lo) | (f2bf(hi) << 16); }
__device__ __forceinline__ unsigned pk4_fp8(float a, float b, float c, float d) { int w = __builtin_amdgcn_cvt_pk_fp8_f32(a, b, 0, false); w = __builtin_amdgcn_cvt_pk_fp8_f32(c, d, w, true); return (unsigned)w; }
__device__ __forceinline__ float bf2f(unsigned b) { return __builtin_bit_cast(float, b << 16); }
__device__ __forceinline__ float bflo(unsigned w) { return __builtin_bit_cast(float, w << 16); }
__device__ __forceinline__ float bfhi(unsigned w) { return __builtin_bit_cast(float, w & 0xffff0000u); }
__device__ __forceinline__ float wave_sum(float v) {
#pragma unroll
    for (int o = 1; o < 64; o <<= 1) v += __shfl_xor(v, o);
    return v;
}
__device__ __forceinline__ float sigmoidf_(float x) { return __builtin_amdgcn_rcpf(1.0f + __builtin_amdgcn_exp2f(-1.44269504f * x)); }
__device__ __forceinline__ float siluf_(float x) { return x * sigmoidf_(x); }
__device__ __forceinline__ float softplusf_(float z) { return fmaxf(z, 0.f) + __logf(1.0f + __expf(-fabsf(z))); }
#define LDS_WAIT() asm volatile("s_waitcnt lgkmcnt(0)" ::: "memory")
#define VM_WAIT() asm volatile("s_waitcnt vmcnt(0)" ::: "memory")

struct Ctx {
    const float *x, *w_in, *w_out, *lb_logits, *hg_gain, *sb_gain, *mix_gain, *ffn_gain, *w_router, *b_router, *w_gate, *b_gate, *w_up, *b_up, *w_down, *b_down, *fin_gain;
    float* out; unsigned char* ws;
    LAS unsigned char* lds;
    int tid, lane, wave, G, bid, flags, vc;
};

#define XB_TMO      128
#define XB_XCNT(j)  (256  + 64 * (j))
#define XB_XSUB(j)  (1280 + 64 * (j))
#define XB_XGEN(j)  (2304 + 64 * (j))
#define XB_TOP      3328
#define XB_TOPGEN   3392
#define XCD_BAR_WORDS 3456
#define XB_SPIN_CAP (1u << 22)
__device__ __forceinline__ unsigned xb_ld(unsigned* p)              { return __hip_atomic_load(p, __ATOMIC_RELAXED, __HIP_MEMORY_SCOPE_AGENT); }
__device__ __forceinline__ unsigned xb_add(unsigned* p, unsigned v) { return __hip_atomic_fetch_add(p, v, __ATOMIC_RELAXED, __HIP_MEMORY_SCOPE_AGENT); }
__device__ __forceinline__ unsigned xb_xcc_id() { return (unsigned)__builtin_amdgcn_s_getreg((3 << 11) | 20) & 0xFu; }
#define XB_SPIN(cond, bar) do { unsigned _sp = 0; while (cond) { __builtin_amdgcn_s_sleep(1); \
    if ((++_sp & 255u) == 0u) { if (xb_ld(&(bar)[XB_TMO])) break; if (_sp > XB_SPIN_CAP) { atomicAdd(&(bar)[XB_TMO], 1u); break; } } } } while (0)
struct XcdBarrier { unsigned* bar; unsigned x; volatile LAS unsigned* st; };
__device__ __forceinline__ XcdBarrier xcd_barrier_post(unsigned* bar, volatile LAS unsigned* st) {
    XcdBarrier b; b.bar = bar; b.x = xb_xcc_id(); b.st = st;
    if (threadIdx.x == 0) st[2] = xb_add(&bar[XB_XCNT(b.x)], 1u);
    return b;
}
__device__ __forceinline__ void xcd_barrier_complete(unsigned* bar, unsigned x, unsigned& nloc, unsigned& nx) {
    const unsigned G = gridDim.x * gridDim.y * gridDim.z;
    unsigned sum, cnt, mine, sp = 0u;
    for (;;) {
        sum = 0u; cnt = 0u; mine = 0u;
#pragma unroll
        for (unsigned j = 0; j < 16; ++j) { const unsigned c = xb_ld(&bar[XB_XCNT(j)]); sum += c; cnt += (c > 0u) ? 1u : 0u; mine = (j == x) ? c : mine; }
        if (sum == G) break;
        __builtin_amdgcn_s_sleep(1);
        if ((++sp & 255u) == 0u) { if (xb_ld(&bar[XB_TMO])) break; if (sp > XB_SPIN_CAP) { atomicAdd(&bar[XB_TMO], 1u); break; } }
    }
    nloc = mine > 0u ? mine : 1u; nx = cnt > 0u ? cnt : 1u;
}
__device__ __forceinline__ void xcd_barrier(const XcdBarrier& b) {
    asm volatile("s_waitcnt vmcnt(0)" ::: "memory");
    __syncthreads();
    if (threadIdx.x == 0) {
        unsigned* bar = b.bar;
        __builtin_amdgcn_s_waitcnt(0);
        unsigned nloc = b.st[0], nx = b.st[1];
        if (nloc == 0u) { xcd_barrier_complete(bar, b.x, nloc, nx); b.st[0] = nloc; b.st[1] = nx; }
        const unsigned old = xb_add(&bar[XB_XSUB(b.x)], 1u);
        const unsigned gen = old / nloc;
        if (old + 1u == (gen + 1u) * nloc) {
            __builtin_amdgcn_fence(__ATOMIC_RELEASE, "agent");
            asm volatile("s_waitcnt vmcnt(0)" ::: "memory");
            const unsigned og = xb_add(&bar[XB_TOP], 1u);
            const unsigned tg = og / nx;
            if (og + 1u == (tg + 1u) * nx) xb_add(&bar[XB_TOPGEN], 1u);
            else XB_SPIN(xb_ld(&bar[XB_TOPGEN]) == tg, bar);
            __builtin_amdgcn_fence(__ATOMIC_ACQUIRE, "agent");
            xb_add(&bar[XB_XGEN(b.x)], 1u);
            asm volatile("s_waitcnt vmcnt(0)" ::: "memory");
        } else {
            XB_SPIN(xb_ld(&bar[XB_XGEN(b.x)]) == gen, bar);
            __builtin_amdgcn_fence(__ATOMIC_ACQUIRE, "agent");
            asm volatile("s_waitcnt vmcnt(0)" ::: "memory");
        }
    }
    __syncthreads();
}

namespace gm {
constexpr int BM = 256, BK = 64, HALF = 128, HTB = HALF * BK * 2, NXCD = 8, WGM = 8;
typedef int v8i32 __attribute__((ext_vector_type(8)));
__device__ __forceinline__ int lds_byte(int r, int c) { const int st = (r >> 4) * 2 + (c >> 5), rr = r & 15, cc = c & 31, ob = rr * 64 + cc * 2; return st * 1024 + (ob ^ (((ob >> 9) & 1) << 5)); }
__device__ __forceinline__ void stage_rc(int b, int& R, int& C) { const int st = b / 1024, sb = b % 1024, swz = sb ^ (((sb >> 9) & 1) << 5); R = (st >> 1) * 16 + swz / 64; C = (st & 1) * 32 + (swz % 64) / 2; }
__device__ __forceinline__ int perm32(int rho) { const int n = rho >> 4, i = rho & 15; return 8 * (i >> 2) + 4 * n + (i & 3); }
__device__ __forceinline__ unsigned cvt_pk_bf16(float lo, float hi) { unsigned r; asm volatile("v_cvt_pk_bf16_f32 %0, %1, %2" : "=v"(r) : "v"(lo), "v"(hi)); return r; }

struct Unit { const char* A; const char* B; int pm, pn, e, rows; };

__device__ __forceinline__ bool order_next(int i, int G, int c, int nM, int nN, int& pm, int& pn) {
    const int nwg = nM * nN; const long L = (long)i * G + c; if (L >= nwg) return false;
    int wgid = (int)L; { const int q = nwg / NXCD, r = nwg % NXCD, xcd = wgid % NXCD, off = wgid / NXCD; wgid = (xcd < r ? xcd * (q + 1) : r * (q + 1) + (xcd - r) * q) + off; }
    const int nig = WGM * nN, gid = wgid / nig, fm = gid * WGM, gsz = (nM - fm) < WGM ? (nM - fm) : WGM;
    pm = fm + ((wgid % nig) % gsz); pn = (wgid % nig) / gsz; return true;
}

__device__ __forceinline__ void acc_zero(f32x4 (&acc)[2][2][4][2]) {
#pragma unroll
    for (int a = 0; a < 2; ++a)
#pragma unroll
        for (int b = 0; b < 2; ++b)
#pragma unroll
            for (int m = 0; m < 4; ++m)
#pragma unroll
                for (int n = 0; n < 2; ++n) acc[a][b][m][n] = (f32x4){0.f, 0.f, 0.f, 0.f};
}
template <class P>
__device__ __forceinline__ void gemm_phase(LAS unsigned char* lds, const P& S) {
    const int tid = threadIdx.x, wid = __builtin_amdgcn_readfirstlane(tid >> 6), lane = tid & 63, wr = wid >> 2, wc = wid & 3, fr = lane & 15, fq = lane >> 4;
    constexpr int NT = P::FP8 ? 8 : 16, KB = P::FP8 ? 1024 : 2048;
    int R0, C0, R1, C1; stage_rc(tid * 16, R0, C0); stage_rc(tid * 16 + 8192, R1, C1);
    unsigned voffB[2];
    { const int Rb0 = P::PERM ? ((R0 & ~31) + perm32(R0 & 31)) : R0, Rb1 = P::PERM ? ((R1 & ~31) + perm32(R1 & 31)) : R1;
      voffB[0] = (unsigned)(Rb0 * KB + C0 * 2); voffB[1] = (unsigned)(Rb1 * KB + C1 * 2); }
    const size_t kstep = (size_t)(BK * 2), hstepB = (size_t)HALF * KB;
    const unsigned ldsw = (unsigned)wid * 1024u;
    const int aoff = lds_byte(wr * 64 + fr, fq * 8), boff = lds_byte(wc * 32 + fr, fq * 8);
#define G_SA(b, h) (((b) * 2 + (h)) * HTB)
#define G_SB(b, h) ((4 + (b) * 2 + (h)) * HTB)
#define G_STAGEB(bufoff, gbase) do { const char* _gb = (gbase); asm volatile("" : "+s"(_gb)); _Pragma("unroll") for (int _i = 0; _i < 2; ++_i) \
        __builtin_amdgcn_global_load_lds((const unsigned*)(_gb + voffB[_i]), (LAS unsigned*)(lds + (bufoff) + ldsw + _i * 8192), 16, 0, 0); } while (0)
#define G_STAGEA(bufoff, gbase, vo, h) do { const char* _gb = (gbase); asm volatile("" : "+s"(_gb)); _Pragma("unroll") for (int _i = 0; _i < 2; ++_i) \
        __builtin_amdgcn_global_load_lds((const unsigned*)(_gb + (vo)[h][_i]), (LAS unsigned*)(lds + (bufoff) + ldsw + _i * 8192), 16, 0, 0); } while (0)
#define G_LD16(off) (*(const LAS bf16x8*)(lds + (off)))
#define G_CAT2(lo, hi) __builtin_bit_cast(v8i32, __builtin_shufflevector(lo, hi, 0, 1, 2, 3, 4, 5, 6, 7, 8, 9, 10, 11, 12, 13, 14, 15))
#define G_LDA(dst, b, h) do { _Pragma("unroll") for (int m = 0; m < 4; ++m) { if constexpr (P::FP8) dst##8[m] = G_CAT2(G_LD16(G_SA(b, h) + aoff + m * 2048), G_LD16(G_SA(b, h) + aoff + m * 2048 + 1024)); \
        else { _Pragma("unroll") for (int k = 0; k < 2; ++k) dst[m][k] = G_LD16(G_SA(b, h) + aoff + m * 2048 + k * 1024); } } } while (0)
#define G_LDB(dst, b, h) do { _Pragma("unroll") for (int n = 0; n < 2; ++n) { if constexpr (P::FP8) dst##8[n] = G_CAT2(G_LD16(G_SB(b, h) + boff + n * 2048), G_LD16(G_SB(b, h) + boff + n * 2048 + 1024)); \
        else { _Pragma("unroll") for (int k = 0; k < 2; ++k) dst[n][k] = G_LD16(G_SB(b, h) + boff + n * 2048 + k * 1024); } } } while (0)
#define G_MMA(ai, bj, At, Bt) do { __builtin_amdgcn_s_setprio(1); _Pragma("unroll") for (int m = 0; m < 4; ++m) _Pragma("unroll") for (int n = 0; n < 2; ++n) { \
        if constexpr (P::FP8) asm volatile("v_mfma_f32_16x16x128_f8f6f4 %0, %1, %2, %0" : "+v"(acc[ai][bj][m][n]) : "v"(Bt##8[n]), "v"(At##8[m])); \
        else { _Pragma("unroll") for (int k = 0; k < 2; ++k) acc[ai][bj][m][n] = __builtin_amdgcn_mfma_f32_16x16x32_bf16(Bt[n][k], At[m][k], acc[ai][bj][m][n], 0, 0, 0); } } \
        __builtin_amdgcn_s_setprio(0); } while (0)
#define G_MMA_TAIL() do { if constexpr (P::FP8) asm volatile("s_nop 15" ::: "memory"); } while (0)
#define G_WAIT_V(n) asm volatile("s_waitcnt vmcnt(" #n ")" ::: "memory")
#define G_WAIT_L(n) asm volatile("s_waitcnt lgkmcnt(" #n ")" ::: "memory")
#define G_BAR __builtin_amdgcn_s_barrier()
#define G_SCHED __builtin_amdgcn_sched_barrier(0)
    Unit cur, nxt; int ui = 0;
    if (!S.next(0, cur)) return;
    f32x4 acc[2][2][4][2];
    S.acc_init(acc, cur, wr, wc, fr, fq);
    bf16x8 At[4][2], B0[2][2], B1[2][2]; v8i32 At8[4], B08[2], B18[2];
    unsigned voA[2][2];
    S.a_off(cur, R0, C0, R1, C1, voA);
    const char* cA = cur.A; const char* cB = cur.B;
    G_STAGEB(G_SB(0, 0), cB); G_STAGEB(G_SB(0, 1), cB + hstepB); G_STAGEA(G_SA(0, 0), cA + S.koff(0), voA, 0); G_STAGEA(G_SA(0, 1), cA + S.koff(0), voA, 1);
    if (wr == 1) G_BAR;
    G_WAIT_V(2); G_BAR;
    G_STAGEB(G_SB(1, 0), cB + kstep); G_STAGEA(G_SA(1, 0), cA + S.koff(1), voA, 0); G_STAGEB(G_SB(1, 1), cB + hstepB + kstep);
    G_WAIT_V(6); G_BAR;
    for (;;) {
        const bool has_next = S.next(ui + 1, nxt);
        const char* nA = has_next ? nxt.A : cA; const char* nB = has_next ? nxt.B : cB;
        S.meta_prefetch(cur, lds, wid, ui);
        if constexpr (P::GATHER) { if (has_next) S.idx_prefetch(nxt, lds, wid); }
#pragma unroll 1
        for (int t = 0; t < NT; t += 2) {
            const bool last = (t == NT - 2);
            const char* a1 = cA + S.koff(t + 1);
            const char* a2 = last ? nA + S.koff(0) : cA + S.koff(t + 2); const char* b2 = last ? nB : cB + (size_t)(t + 2) * kstep;
            const char* a3 = last ? nA + S.koff(1) : cA + S.koff(t + 3); const char* b3 = b2 + kstep;
            G_LDB(B0, 0, 0); G_LDB(B1, 0, 1); G_SCHED; G_LDA(At, 0, 0); G_STAGEA(G_SA(1, 1), a1, voA, 1);
            if constexpr (P::GATHER) { if (last && has_next) S.a_off_lds(nxt, R0, C0, R1, C1, lds, voA); }
            G_WAIT_V(8); G_WAIT_L(0); G_BAR; G_MMA(0, 0, At, B0); G_MMA(0, 1, At, B1); G_MMA_TAIL(); G_BAR; G_SCHED;
            G_LDA(At, 0, 1); G_STAGEB(G_SB(0, 0), b2); G_STAGEB(G_SB(0, 1), b2 + hstepB); G_STAGEA(G_SA(0, 0), a2, voA, 0);
            G_WAIT_V(8); G_WAIT_L(0); G_BAR; G_MMA(1, 0, At, B0); G_MMA(1, 1, At, B1); G_MMA_TAIL(); G_BAR; G_SCHED;
            G_LDB(B0, 1, 0); G_LDB(B1, 1, 1); G_SCHED; G_LDA(At, 1, 0); G_STAGEA(G_SA(0, 1), a2, voA, 1);
            G_WAIT_V(8); G_WAIT_L(0); G_BAR; G_MMA(0, 0, At, B0); G_MMA(0, 1, At, B1); G_MMA_TAIL(); G_BAR; G_SCHED;
            G_LDA(At, 1, 1); G_STAGEB(G_SB(1, 0), b3); G_STAGEB(G_SB(1, 1), b3 + hstepB); G_STAGEA(G_SA(1, 0), a3, voA, 0);
            G_WAIT_V(8); G_WAIT_L(0); G_BAR; G_MMA(1, 0, At, B0); G_MMA(1, 1, At, B1); G_MMA_TAIL(); G_BAR; G_SCHED;
        }
        if (wr == 0) G_BAR;
        S.epi(acc, cur, wr, wc, fr, fq, lds, ui);
        if (!has_next) break;
        S.acc_init(acc, nxt, wr, wc, fr, fq);
        cur = nxt; cA = nA; cB = nB; ++ui;
        if (wr == 1) G_BAR;
    }
    G_WAIT_V(0);
    G_BAR;
#undef G_SA
#undef G_SB
#undef G_STAGEA
#undef G_STAGEB
#undef G_LDA
#undef G_LDB
#undef G_MMA
#undef G_MMA_TAIL
#undef G_CAT2
#undef G_LD16
#undef G_WAIT_V
#undef G_WAIT_L
#undef G_BAR
#undef G_SCHED
}
}

template <bool FP8> __device__ __forceinline__ void p0_tile(const f32x4 (&rg)[8], unsigned (&o)[16], int k0, const LAS float* kscale, float mult, LAS float* scr, int lane) {
    const int kr = lane >> 4, c16 = lane & 15;
    asm volatile("" ::: "memory");
#pragma unroll
    for (int j = 0; j < 8; ++j) *(LAS f32x4*)(scr + (4 * j + kr) * 68 + 4 * c16) = rg[j];
    asm volatile("" ::: "memory");
    float v[32];
#pragma unroll
    for (int k = 0; k < 32; ++k) v[k] = scr[k * 68 + lane] * mult;
    if (kscale) {
#pragma unroll
        for (int q = 0; q < 8; ++q) { const f32x4 g = *(const LAS f32x4*)(kscale + k0 + 4 * q); v[4 * q] *= g[0]; v[4 * q + 1] *= g[1]; v[4 * q + 2] *= g[2]; v[4 * q + 3] *= g[3]; }
    }
    if constexpr (FP8) {
#pragma unroll
        for (int q = 0; q < 8; ++q) o[q] = pk4_fp8(v[4 * q], v[4 * q + 1], v[4 * q + 2], v[4 * q + 3]);
    } else {
#pragma unroll
        for (int q = 0; q < 16; ++q) o[q] = pk2(v[2 * q], v[2 * q + 1]);
    }
    asm volatile("" ::: "memory");
}
template <bool FP8> __device__ __forceinline__ void p0_job(const float* W, int N, unsigned char* WT, int n0, int kq, long drow0, const LAS float* kscale, float mult, LAS float* scr, int lane) {
    const int kr = lane >> 4, c16 = lane & 15;
    const float* src = W + (size_t)(kq * 256 + kr) * N + n0 + 4 * c16;
    f32x4 rr[3][8];
#pragma unroll
    for (int j = 0; j < 8; ++j) rr[0][j] = *(const f32x4*)(src + (size_t)(4 * j) * N);
#pragma unroll
    for (int j = 0; j < 8; ++j) rr[1][j] = *(const f32x4*)(src + (size_t)(32 + 4 * j) * N);
#pragma unroll
    for (int j = 0; j < 8; ++j) rr[2][j] = *(const f32x4*)(src + (size_t)(64 + 4 * j) * N);
    unsigned char* drow = WT + (size_t)(drow0 + lane) * (FP8 ? 1024 : 2048) + (size_t)kq * 256 * (FP8 ? 1 : 2);
    unsigned line[32];
#pragma unroll
    for (int t = 0; t < 8; ++t) {
        f32x4 cur[8];
#pragma unroll
        for (int j = 0; j < 8; ++j) cur[j] = rr[t % 3][j];
        if (t + 3 < 8) {
#pragma unroll
            for (int j = 0; j < 8; ++j) rr[t % 3][j] = *(const f32x4*)(src + (size_t)(32 * (t + 3) + 4 * j) * N);
        }
        unsigned o[16];
        p0_tile<FP8>(cur, o, kq * 256 + 32 * t, kscale, mult, scr, lane);
        if constexpr (FP8) {
#pragma unroll
            for (int q = 0; q < 8; ++q) line[8 * (t & 3) + q] = o[q];
            if ((t & 3) == 3) {
#pragma unroll
                for (int q = 0; q < 8; ++q) *(u32x4*)(drow + 128 * (t >> 2) + 16 * q) = (u32x4){line[4 * q], line[4 * q + 1], line[4 * q + 2], line[4 * q + 3]};
            }
        } else {
#pragma unroll
            for (int q = 0; q < 16; ++q) line[16 * (t & 1) + q] = o[q];
            if ((t & 1) == 1) {
#pragma unroll
                for (int q = 0; q < 8; ++q) *(u32x4*)(drow + 128 * (t >> 1) + 16 * q) = (u32x4){line[4 * q], line[4 * q + 1], line[4 * q + 2], line[4 * q + 3]};
            }
        }
    }
}
__device__ __forceinline__ void moe_one_job(Ctx& F, int r, LAS float* scr, const LAS float* gainl) {
    unsigned char* WGU = F.ws + WS_WGU; unsigned char* WDN = F.ws + WS_WDN;
    constexpr int J_E = 16 * 4;
    const int e = r / (3 * J_E), q = r % (3 * J_E), which = q / J_E, rr = q % J_E, nb = rr & 15, kq = rr >> 4, n0 = nb * 64;
    if (which == 0) p0_job<true>(F.w_gate + (size_t)e * 1048576, 1024, WGU, n0, kq, (long)(e * 8 + (n0 >> 7)) * 256 + (n0 & 127), gainl, W8_SCALE, scr, F.lane);
    else if (which == 1) p0_job<true>(F.w_up + (size_t)e * 1048576, 1024, WGU, n0, kq, (long)(e * 8 + (n0 >> 7)) * 256 + 128 + (n0 & 127), gainl, W8_SCALE, scr, F.lane);
    else p0_job<true>(F.w_down + (size_t)e * 1048576, 1024, WDN, n0, kq, (long)e * 1024 + n0, nullptr, W8_SCALE, scr, F.lane);
}
__device__ __forceinline__ void moe_convert_jobs(Ctx& F, LAS float* scr, const LAS float* gainl) {
    unsigned* ctr = (unsigned*)(F.ws + WS_CTL) + CW_JOB;
    constexpr int NJ = NE * 3 * 64;
    const int nstatic = (F.G * 16 <= NJ) ? F.G * 16 : 0;
    if (F.wave >= 4 && nstatic) { const int j0 = F.bid * 16 + (F.wave - 4);
        for (int r = j0; r < j0 + 16; r += 4) moe_one_job(F, r, scr, gainl); }
    for (;;) {
        unsigned tk = 0; if (F.lane == 0) tk = __hip_atomic_fetch_add(ctr, 2u, __ATOMIC_RELAXED, __HIP_MEMORY_SCOPE_AGENT);
        const int j0 = nstatic + __builtin_amdgcn_readfirstlane((int)tk);
        if (j0 >= NJ) break;
        for (int r = j0; r < j0 + 2; ++r) moe_one_job(F, r, scr, gainl);
    }
}
__device__ __forceinline__ void phase0(Ctx& F) {
    LAS float* scr = (LAS float*)(F.lds + F.wave * 16384);
    const int gw = F.bid * NWAVES + F.wave, NGW = F.G * NWAVES;
    unsigned char* WIN = F.ws + WS_WIN; unsigned char* WOUT = F.ws + WS_WOUT;
    constexpr int J_IN = (INC / 64) * 4, J_OUT = 16 * 4;
    constexpr int NJOBS = J_IN + J_OUT;
    for (int it = gw; it < NJOBS; it += NGW) {
        int r = it;
        if (r < J_IN) { const int nb = r >> 2, kq = r & 3; p0_job<false>(F.w_in, INC, WIN, nb * 64, kq, nb * 64, nullptr, 1.0f, scr, F.lane); continue; } r -= J_IN;
        { const int nb = r >> 2, kq = r & 3; p0_job<false>(F.w_out, 1024, WOUT, nb * 64, kq, nb * 64, nullptr, 1.0f, scr, F.lane); }
    }
    bf16* U = (bf16*)(F.ws + WS_D);
    const f32x4* gr = (const f32x4*)F.mix_gain + F.lane;
    f32x4 g[4];
#pragma unroll
    for (int j = 0; j < 4; ++j) g[j] = gr[64 * j];
    f32x4 nv[4];
    if (gw < NTOK) {
#pragma unroll
        for (int j = 0; j < 4; ++j) nv[j] = ((const f32x4*)(F.x + (size_t)gw * DM) + F.lane)[64 * j];
    }
    for (int m = gw; m < NTOK; m += NGW) {
        f32x4 v[4]; float s = 0.f;
#pragma unroll
        for (int j = 0; j < 4; ++j) v[j] = nv[j];
        if (m + NGW < NTOK) {
#pragma unroll
            for (int j = 0; j < 4; ++j) nv[j] = ((const f32x4*)(F.x + (size_t)(m + NGW) * DM) + F.lane)[64 * j];
        }
#pragma unroll
        for (int j = 0; j < 4; ++j) s += (v[j].x * v[j].x + v[j].y * v[j].y) + (v[j].z * v[j].z + v[j].w * v[j].w);
        const float rstd = 1.0f / sqrtf(wave_sum(s) * (1.f / DM) + EPS);
        unsigned long long* o8 = (unsigned long long*)(U + (size_t)m * DM) + F.lane;
#pragma unroll
        for (int j = 0; j < 4; ++j)
            o8[64 * j] = (unsigned long long)pk2(v[j].x * rstd * g[j].x, v[j].y * rstd * g[j].y) | ((unsigned long long)pk2(v[j].z * rstd * g[j].z, v[j].w * rstd * g[j].w) << 32);
    }
}

struct P1Pol {
    static constexpr bool PERM = true, FP8 = false, GATHER = false;
    const char* A; const char* B; bf16* O; const float* lbl; int G, c, flags;
    __device__ __forceinline__ bool next(int i, gm::Unit& u) const { int pm, pn; if (!gm::order_next(i, G, c, NTOK / 256, INC / 256, pm, pn)) return false;
        u.pm = pm; u.pn = pn; u.A = A + (size_t)pm * 256 * 2048; u.B = B + (size_t)pn * 256 * 2048; u.e = 0; u.rows = 256; return true; }
    __device__ __forceinline__ void a_off(const gm::Unit&, int R0, int C0, int R1, int C1, unsigned (&vo)[2][2]) const {
        vo[0][0] = (unsigned)(R0 * 1024 + C0) * 2u; vo[0][1] = (unsigned)(R1 * 1024 + C1) * 2u; vo[1][0] = vo[0][0] + 128u * 2048u; vo[1][1] = vo[0][1] + 128u * 2048u; }
    __device__ __forceinline__ size_t koff(int t) const { return (size_t)t * 128; }
    template <int TYPE> __device__ __forceinline__ void epi_t(const f32x4 (&acc)[2][2][4][2], const gm::Unit& u, int wr, int wc, int fr, int fq) const {
        const int row0 = u.pm * 256 + wr * 64 + fr, col0 = u.pn * 256 + wc * 32 + 8 * fq;
        f32x4 lbv[2][2];
        if constexpr (TYPE == 1) {
#pragma unroll
            for (int bj = 0; bj < 2; ++bj)
#pragma unroll
                for (int n = 0; n < 2; ++n) { const int c = col0 + bj * 128 + 4 * n - C_HF; const f32x4 a0 = *(const f32x4*)(lbl + c), a1 = *(const f32x4*)(lbl + 512 + c);
#pragma unroll
                    for (int j = 0; j < 4; ++j) lbv[bj][n][j] = sigmoidf_(a0[j] - a1[j]); }
        }
#pragma unroll
        for (int ai = 0; ai < 2; ++ai)
#pragma unroll
            for (int m = 0; m < 4; ++m) { bf16* rowp = O + (size_t)(row0 + ai * 128 + m * 16) * INC + col0;
#pragma unroll
                for (int bj = 0; bj < 2; ++bj) { f32x4 v[2];
#pragma unroll
                    for (int n = 0; n < 2; ++n)
#pragma unroll
                        for (int j = 0; j < 4; ++j) { const float x = acc[ai][bj][m][n][j];
                            if constexpr (TYPE == 0) v[n][j] = x * sigmoidf_(x);
                            else if constexpr (TYPE == 1) { const float lb = lbv[bj][n][j]; v[n][j] = __logf(lb + (1.0f - lb) * sigmoidf_(x)); }
                            else if constexpr (TYPE == 4) v[n][j] = x * 0.125f;
                            else v[n][j] = x; }
                    u32x4 w; w.x = gm::cvt_pk_bf16(v[0][0], v[0][1]); w.y = gm::cvt_pk_bf16(v[0][2], v[0][3]); w.z = gm::cvt_pk_bf16(v[1][0], v[1][1]); w.w = gm::cvt_pk_bf16(v[1][2], v[1][3]);
                    *(u32x4*)(rowp + bj * 128) = w; } }
    }
    __device__ __forceinline__ void acc_init(f32x4 (&acc)[2][2][4][2], const gm::Unit&, int, int, int, int) const { gm::acc_zero(acc); }
    __device__ __forceinline__ void meta_prefetch(const gm::Unit&, LAS unsigned char*, int, int) const {}
    __device__ __forceinline__ void epi(const f32x4 (&acc)[2][2][4][2], const gm::Unit& u, int wr, int wc, int fr, int fq, LAS unsigned char*, int) const {
        if (flags & 1) { if (acc[0][0][0][0][0] == 1.2345e-30f) O[0] = 1; return; }
        const int type = u.pn >> 1;
        if (type == 0 || type == 3) epi_t<0>(acc, u, wr, wc, fr, fq);
        else if (type == 1) epi_t<1>(acc, u, wr, wc, fr, fq);
        else if (type == 4) epi_t<4>(acc, u, wr, wc, fr, fq);
        else epi_t<2>(acc, u, wr, wc, fr, fq);
    }
};
__device__ __forceinline__ void phase1(Ctx& F) {
    P1Pol S{(const char*)(F.ws + WS_D), (const char*)(F.ws + WS_WIN), (bf16*)(F.ws + WS_PROJ), F.lb_logits, F.G, F.vc, F.flags};
    gm::gemm_phase<P1Pol>(F.lds, S);
}

typedef short s16x4 __attribute__((ext_vector_type(4)));
__device__ __forceinline__ s16x4 tr_read(LAS const unsigned char* p) { return __builtin_bit_cast(s16x4, __builtin_amdgcn_ds_read_tr16_b64_v4i16((LAS s16x4*)p)); }
__device__ __forceinline__ bf16x8 cat8(s16x4 a, s16x4 b) { return (bf16x8){a[0], a[1], a[2], a[3], b[0], b[1], b[2], b[3]}; }
__device__ __forceinline__ bf16x8 pack8(f32x4 a, f32x4 b) { u32x4 w; w.x = gm::cvt_pk_bf16(a[0], a[1]); w.y = gm::cvt_pk_bf16(a[2], a[3]); w.z = gm::cvt_pk_bf16(b[0], b[1]); w.w = gm::cvt_pk_bf16(b[2], b[3]); return __builtin_bit_cast(bf16x8, w); }
#define MFMA16(a, b, c) __builtin_amdgcn_mfma_f32_16x16x32_bf16((a), (b), (c), 0, 0, 0)
#define MFMA32(a, b, c) __builtin_amdgcn_mfma_f32_32x32x16_bf16((a), (b), (c), 0, 0, 0)
constexpr int SBV_PITCH = 192, SBV_BYTES = 32 * SBV_PITCH;
__device__ __forceinline__ void sb_attn_fast(Ctx& F) {
    bf16* PROJ = (bf16*)(F.ws + WS_PROJ);
    LAS unsigned char* VT = F.lds + F.wave * SBV_BYTES;
    const int l = F.lane, c = l & 31, hh = l >> 5, i = l & 15, sub = (l >> 4) & 1;
    const int gw = F.bid * 4 + F.wave, NGW = F.G * 4;
    for (int item = gw; item < NBATCH * 8 * (SEQ / 32); item += NGW) {
        const int qt = item & 255, bh = item >> 8, b = bh >> 3, h = bh & 7, t0 = qt * 32;
        const size_t tokbase = (size_t)b * SEQ;
        const bf16* qp = PROJ + (tokbase + t0 + c) * INC + C_SQ + h * 64;
        bf16* mixp = (bf16*)(F.ws + WS_MIX) + (tokbase + t0 + c) * DM + 512 + h * 64;
        bf16x8 qfr[4];
#pragma unroll
        for (int ks = 0; ks < 4; ++ks) qfr[ks] = *(const bf16x8*)(qp + 16 * ks + 8 * hh);
        const bf16* kb = PROJ + tokbase * INC + C_SK + h * 64 + 8 * hh;
        const bf16* vb = PROJ + tokbase * INC + C_SV + h * 64 + (l & 7) * 8;
        f32x16 O0, O1;
#pragma unroll
        for (int r = 0; r < 16; ++r) { O0[r] = 0.f; O1[r] = 0.f; }
        float accrun = 0.f;
        bf16x8 kn[3][4]; u32x4 vn[3][4];
#pragma unroll
        for (int d = 0; d < 3; ++d) { const int sd = (t0 - 32 * d) > 0 ? (t0 - 32 * d) : 0;
#pragma unroll
            for (int ks = 0; ks < 4; ++ks) kn[d][ks] = *(const bf16x8*)(kb + (size_t)(sd + c) * INC + 16 * ks);
#pragma unroll
            for (int q = 0; q < 4; ++q) vn[d][q] = *(const u32x4*)(vb + (size_t)(sd + 8 * q + (l >> 3)) * INC);
            asm volatile("" ::: "memory");
        }
#define ATT_TILE(SV, D) { \
            const int s_ = (SV); const int sn_ = (s_ - 96) > 0 ? (s_ - 96) : 0; \
            asm volatile("" ::: "memory"); \
            _Pragma("unroll") for (int q = 0; q < 4; ++q) *(LAS u32x4*)(VT + (8 * q + (l >> 3)) * SBV_PITCH + (l & 7) * 16) = vn[D][q]; \
            asm volatile("" ::: "memory"); \
            f32x16 z; \
            _Pragma("unroll") for (int r = 0; r < 16; ++r) z[r] = 0.f; \
            _Pragma("unroll") for (int ks = 0; ks < 4; ++ks) z = MFMA32(kn[D][ks], qfr[ks], z); \
            __builtin_amdgcn_sched_barrier(0); \
            _Pragma("unroll") for (int ks = 0; ks < 4; ++ks) kn[D][ks] = *(const bf16x8*)(kb + (size_t)(sn_ + c) * INC + 16 * ks); \
            _Pragma("unroll") for (int q = 0; q < 4; ++q) vn[D][q] = *(const u32x4*)(vb + (size_t)(sn_ + 8 * q + (l >> 3)) * INC); \
            const bool diag = (s_ == t0); \
            float sp[16], la[16]; \
            _Pragma("unroll") for (int r = 0; r < 16; ++r) { const int key = (r & 3) + 8 * (r >> 2) + 4 * hh; const bool ok = !diag || key < c; \
                const float spr = softplusf_(z[r]); sp[r] = ok ? spr : 0.f; la[r] = ok ? (z[r] - spr) : -1.0e30f; } \
            float gs[4], pg[4]; \
            _Pragma("unroll") for (int q = 0; q < 4; ++q) { gs[q] = (sp[4 * q] + sp[4 * q + 1]) + (sp[4 * q + 2] + sp[4 * q + 3]); pg[q] = __shfl_xor(gs[q], 32); } \
            float lgq[4]; float tail = 0.f; \
            _Pragma("unroll") for (int q = 3; q >= 0; --q) { lgq[q] = tail + (hh == 0 ? pg[q] : 0.f); tail += gs[q] + pg[q]; } \
            f32x4 a4[4]; \
            _Pragma("unroll") for (int q = 0; q < 4; ++q) { const float base = accrun + lgq[q]; \
                const float w3 = base, w2 = w3 + sp[4 * q + 3], w1 = w2 + sp[4 * q + 2], w0 = w1 + sp[4 * q + 1]; \
                a4[q] = (f32x4){__expf(la[4 * q] - w0), __expf(la[4 * q + 1] - w1), __expf(la[4 * q + 2] - w2), __expf(la[4 * q + 3] - w3)}; } \
            accrun += tail; \
            const bf16x8 p0 = pack8(a4[0], a4[1]), p1 = pack8(a4[2], a4[3]); \
            asm volatile("" ::: "memory"); \
            _Pragma("unroll") for (int s2 = 0; s2 < 2; ++s2) { const bf16x8 pf = s2 ? p1 : p0; \
                LAS const unsigned char* vr = VT + (16 * s2 + 4 * hh + (i >> 2)) * SBV_PITCH + (16 * sub + 4 * (i & 3)) * 2; \
                const bf16x8 v0 = cat8(tr_read(vr), tr_read(vr + 8 * SBV_PITCH)); \
                const bf16x8 v1 = cat8(tr_read(vr + 64), tr_read(vr + 8 * SBV_PITCH + 64)); \
                O0 = MFMA32(v0, pf, O0); O1 = MFMA32(v1, pf, O1); } \
            asm volatile("" ::: "memory"); }
        for (int s0 = t0; ; s0 -= 96) {
            ATT_TILE(s0, 0)
            if (s0 < 32 || __ballot(accrun <= SB_EXIT) == 0ull) break;
            ATT_TILE(s0 - 32, 1)
            if (s0 < 64 || __ballot(accrun <= SB_EXIT) == 0ull) break;
            ATT_TILE(s0 - 64, 2)
            if (s0 < 96 || __ballot(accrun <= SB_EXIT) == 0ull) break;
        }
#undef ATT_TILE
        float ssq = 0.f;
#pragma unroll
        for (int r = 0; r < 16; ++r) ssq += O0[r] * O0[r] + O1[r] * O1[r];
        ssq += __shfl_xor(ssq, 32);
        const float rn = 1.0f / sqrtf(ssq * (1.f / 64) + EPS);
#pragma unroll
        for (int dt = 0; dt < 2; ++dt)
#pragma unroll
            for (int q = 0; q < 4; ++q) { const int d0 = 32 * dt + 8 * q + 4 * hh; const f32x4 gn = *(const f32x4*)(F.sb_gain + h * 64 + d0);
                const float o0 = (dt ? O1[4 * q] : O0[4 * q]) * rn * gn[0], o1 = (dt ? O1[4 * q + 1] : O0[4 * q + 1]) * rn * gn[1], o2 = (dt ? O1[4 * q + 2] : O0[4 * q + 2]) * rn * gn[2], o3 = (dt ? O1[4 * q + 3] : O0[4 * q + 3]) * rn * gn[3];
                *(u32x2*)(mixp + d0) = (u32x2){gm::cvt_pk_bf16(o0, o1), gm::cvt_pk_bf16(o2, o3)}; }
    }
}
constexpr int HA_SET = 8192 + 9216 + 9216;
__device__ __forceinline__ void hgrn_passA(Ctx& F) {
    const bf16* PROJ = (const bf16*)(F.ws + WS_PROJ);
    float* HST = (float*)(F.ws + WS_HST); float* HDEC = (float*)(F.ws + WS_HDEC);
    const int i = F.lane & 15, g = F.lane >> 4, w = F.wave;
    for (int it = F.bid; it < 256; it += F.G) {
        const int b = it >> 6, h = (it >> 4) & 3, sc = it & 15;
        const size_t rowbase = (size_t)b * SEQ + sc * 512;
        const int row = F.tid >> 4, chunk = F.tid & 15;
        const bf16* gp = PROJ + (rowbase + row) * INC + h * 128 + chunk * 8;
        f32x4 acc[8];
#pragma unroll
        for (int kt = 0; kt < 8; ++kt) acc[kt] = (f32x4){0.f, 0.f, 0.f, 0.f};
        float run = 0.f;
        const int k = F.tid & 127, tq = F.tid >> 7;
        u32x4 nf = *(const u32x4*)(gp + (size_t)15 * 32 * INC + C_HF), nv = *(const u32x4*)(gp + (size_t)15 * 32 * INC + C_HI);
        __syncthreads();
        for (int tl = 15; tl >= 0; --tl) {
            LAS unsigned char* set = F.lds + (tl & 1) * HA_SET;
            LAS unsigned char* RAWF = set; LAS unsigned char* KH = set + 8192; LAS unsigned char* VI = set + 8192 + 9216;
            *(LAS u32x4*)(RAWF + row * 256 + chunk * 16) = nf; *(LAS u32x4*)(VI + row * 288 + chunk * 16) = nv;
            if (tl > 0) { nf = *(const u32x4*)(gp + (size_t)(tl - 1) * 32 * INC + C_HF); nv = *(const u32x4*)(gp + (size_t)(tl - 1) * 32 * INC + C_HI); }
            __syncthreads();
#pragma unroll
            for (int s = 31; s >= 0; --s) { const float lf = bf2f(*(const LAS unsigned short*)(RAWF + s * 256 + k * 2));
                if ((s >> 3) == tq) *(LAS unsigned short*)(KH + s * 288 + k * 2) = (unsigned short)f2bf((1.0f - __expf(lf)) * __expf(run));
                run += lf; }
            __syncthreads();
            const bf16x8 bv = cat8(tr_read(VI + (4 * g + (i >> 2)) * 288 + (16 * w + 4 * (i & 3)) * 2), tr_read(VI + (16 + 4 * g + (i >> 2)) * 288 + (16 * w + 4 * (i & 3)) * 2));
#pragma unroll
            for (int kt = 0; kt < 8; ++kt) {
                const bf16x8 av = cat8(tr_read(KH + (4 * g + (i >> 2)) * 288 + (16 * kt + 4 * (i & 3)) * 2), tr_read(KH + (16 + 4 * g + (i >> 2)) * 288 + (16 * kt + 4 * (i & 3)) * 2));
                acc[kt] = MFMA16(av, bv, acc[kt]); }
        }
        float* hp = HST + (size_t)it * 16384;
#pragma unroll
        for (int kt = 0; kt < 8; ++kt) *(f32x4*)(hp + ((w * 8 + kt) * 64 + F.lane) * 4) = acc[kt];
        if (tq == 0) HDEC[it * 128 + k] = __expf(run);
        __syncthreads();
    }
}
__device__ __forceinline__ void hgrn_passB(Ctx& F) {
    float* HST = (float*)(F.ws + WS_HST); const float* HDEC = (const float*)(F.ws + WS_HDEC);
    for (int u = F.bid; u < 256; u += F.G) {
        const int bh = u >> 4, part = u & 15;
        const int e = part * 1024 + F.tid * 2;
        const int kk = 16 * ((e >> 8) & 7) + 4 * (((e >> 2) & 63) >> 4) + (e & 3);
        f32x2 L[16]; f32x2 D[16];
#pragma unroll
        for (int sc = 0; sc < 16; ++sc) { L[sc] = *(const f32x2*)(HST + (size_t)(bh * 16 + sc) * 16384 + e); D[sc] = *(const f32x2*)(HDEC + (bh * 16 + sc) * 128 + kk); }
        f32x2 S = (f32x2){0.f, 0.f};
#pragma unroll
        for (int sc = 0; sc < 16; ++sc) { *(f32x2*)(HST + (size_t)(bh * 16 + sc) * 16384 + e) = S; S = S * D[sc] + L[sc]; }
    }
}
constexpr int HC_RAWF = 0, HC_RAWQ = 4096, HC_QH = 8192, HC_KT = HC_QH + 4352, HC_V = HC_KT + 4352, HC_G = HC_V + 4608, HC_DK = HC_G + 4352, HC_PART = HC_DK + 512, HC_SET = HC_PART + 512;
#define PASSC_ITER(ITR, D) do { const int itr = (ITR); \
            if (mfw) { \
                if (itr >= 1 && itr <= 32) { const int st = itr - 1; const LAS unsigned char* set = F.lds + (st & 3) * HC_SET; \
                    float tot = 0.f; \
                _Pragma("unroll") \
                    for (int ww = 0; ww < 8; ++ww) tot += *(const LAS float*)(set + HC_PART + (ww * 16 + i) * 4); \
                    const float rs = 1.0f / sqrtf(tot * (1.f / 128) + EPS); \
                _Pragma("unroll") \
                    for (int u = 0; u < 2; ++u) { const int vt = 2 * w + u; \
                        const u32x2 gi = *(const LAS u32x2*)(set + HC_G + i * 272 + (16 * vt + 4 * g) * 2); \
                        u32x2 o; o.x = gm::cvt_pk_bf16(oT[u][0] * rs * gain[u][0] * bflo(gi.x), oT[u][1] * rs * gain[u][1] * bfhi(gi.x)); o.y = gm::cvt_pk_bf16(oT[u][2] * rs * gain[u][2] * bflo(gi.y), oT[u][3] * rs * gain[u][3] * bfhi(gi.y)); \
                        *(u32x2*)((bf16*)(F.ws + WS_MIX) + (rowbase + st * 16 + i) * DM + h * 128 + 16 * vt + 4 * g) = o; } } \
                if (itr >= 0 && itr < 32) { LAS unsigned char* set = F.lds + (itr & 3) * HC_SET; \
                    bf16x8 qf[4]; \
                    f32x4 pT = (f32x4){0.f, 0.f, 0.f, 0.f}; \
                _Pragma("unroll") \
                    for (int ks = 0; ks < 4; ++ks) { \
                        qf[ks] = cat8(*(const LAS s16x4*)(set + HC_QH + i * 272 + (32 * ks + 4 * g) * 2), *(const LAS s16x4*)(set + HC_QH + i * 272 + (32 * ks + 16 + 4 * g) * 2)); \
                        const bf16x8 kf = cat8(*(const LAS s16x4*)(set + HC_KT + i * 272 + (32 * ks + 4 * g) * 2), *(const LAS s16x4*)(set + HC_KT + i * 272 + (32 * ks + 16 + 4 * g) * 2)); \
                        pT = MFMA16(kf, qf[ks], pT); } \
                _Pragma("unroll") \
                    for (int r = 0; r < 4; ++r) pT[r] = (4 * g + r <= i) ? pT[r] : 0.f; \
                    const s16x4 z4 = (s16x4){0, 0, 0, 0}; \
                    const bf16x8 pf = pack8(pT, (f32x4){0.f, 0.f, 0.f, 0.f}); \
                    bf16x8 vf[2]; \
                _Pragma("unroll") \
                    for (int u = 0; u < 2; ++u) { const int vt = 2 * w + u; \
                        vf[u] = cat8(tr_read(set + HC_V + (4 * g + (i >> 2)) * 288 + (16 * vt + 4 * (i & 3)) * 2), z4); \
                        oT[u] = MFMA16(vf[u], pf, ((f32x4){0.f, 0.f, 0.f, 0.f})); \
                _Pragma("unroll") \
                        for (int ks = 0; ks < 4; ++ks) oT[u] = MFMA16(pack8(acc[u][2 * ks], acc[u][2 * ks + 1]), qf[ks], oT[u]); } \
                _Pragma("unroll") \
                    for (int kt = 0; kt < 8; ++kt) { const bf16x8 ak = cat8(tr_read(set + HC_KT + (4 * g + (i >> 2)) * 272 + (16 * kt + 4 * (i & 3)) * 2), z4); \
                        const f32x4 dk = *(const LAS f32x4*)(set + HC_DK + (16 * kt + 4 * g) * 4); \
                _Pragma("unroll") \
                        for (int u = 0; u < 2; ++u) { acc[u][kt] = MFMA16(ak, vf[u], acc[u][kt]); acc[u][kt] = acc[u][kt] * dk; } } \
                _Pragma("unroll") \
                    for (int u = 0; u < 2; ++u) { float ssq = (oT[u][0] * oT[u][0] + oT[u][1] * oT[u][1]) + (oT[u][2] * oT[u][2] + oT[u][3] * oT[u][3]); \
                        ssq += __shfl_xor(ssq, 16); ssq += __shfl_xor(ssq, 32); \
                        if (g == 0) *(LAS float*)(set + HC_PART + ((2 * w + u) * 16 + i) * 4) = ssq; } } \
            } else { \
                if (itr + 1 >= 0 && itr + 1 < 32) { LAS unsigned char* set = F.lds + ((itr + 1) & 3) * HC_SET; \
                    float run = 0.f; \
                _Pragma("unroll") \
                    for (int s2 = 0; s2 < 16; ++s2) { const float lf = bf2f(*(const LAS unsigned short*)(set + HC_RAWF + s2 * 256 + k * 2)); run += lf; \
                        if ((s2 >> 3) == tq) { const float qv = bf2f(*(const LAS unsigned short*)(set + HC_RAWQ + s2 * 256 + k * 2)); \
                            *(LAS unsigned short*)(set + HC_QH + s2 * 272 + k * 2) = (unsigned short)f2bf(qv * __expf(run)); \
                            *(LAS unsigned short*)(set + HC_KT + s2 * 272 + k * 2) = (unsigned short)f2bf((1.0f - __expf(lf)) * __expf(fminf(-run, 80.f))); } } \
                    if (tq == 0) *(LAS float*)(set + HC_DK + k * 4) = __expf(run); } \
                if (itr + 2 < 32) { LAS unsigned char* set = F.lds + ((itr + 2) & 3) * HC_SET; \
                    *(LAS u32x4*)(set + HC_RAWF + row * 256 + chunk * 16) = pfq[D][0]; *(LAS u32x4*)(set + HC_RAWQ + row * 256 + chunk * 16) = pfq[D][1]; \
                    *(LAS u32x4*)(set + HC_V + row * 288 + chunk * 16) = pfq[D][2]; *(LAS u32x4*)(set + HC_G + row * 272 + chunk * 16) = pfq[D][3]; } \
            } \
            { const int pst = (itr + 5 < 32) ? itr + 5 : 31; const bf16* gq = gp + (size_t)pst * 16 * INC;     pfq[D][0] = *(const u32x4*)(gq + C_HF); pfq[D][1] = *(const u32x4*)(gq + C_HQ); pfq[D][2] = *(const u32x4*)(gq + C_HI); pfq[D][3] = *(const u32x4*)(gq + C_HG); } \
            __syncthreads(); } while (0)
__device__ __forceinline__ void hgrn_passC(Ctx& F) {
    bf16* PROJ = (bf16*)(F.ws + WS_PROJ);
    const float* HST = (const float*)(F.ws + WS_HST);
    const int i = F.lane & 15, g = F.lane >> 4, w = F.wave;
    const bool mfw = (w < 4);
    for (int it = F.bid; it < 256; it += F.G) {
        const int b = it >> 6, h = (it >> 4) & 3, sc = it & 15;
        const size_t rowbase = (size_t)b * SEQ + sc * 512;
        const int t = F.tid & 255, row = t >> 4, chunk = t & 15;
        const bf16* gp = PROJ + (rowbase + row) * INC + h * 128 + chunk * 8;
        u32x4 pfq[3][4];
#pragma unroll
        for (int d = 0; d < 3; ++d)
#pragma unroll
            for (int q = 0; q < 4; ++q) pfq[d][q] = (u32x4){0u, 0u, 0u, 0u};
        {
#pragma unroll
            for (int d = 0; d < 3; ++d) { const bf16* gq = gp + (size_t)d * 16 * INC; pfq[d][0] = *(const u32x4*)(gq + C_HF); pfq[d][1] = *(const u32x4*)(gq + C_HQ); pfq[d][2] = *(const u32x4*)(gq + C_HI); pfq[d][3] = *(const u32x4*)(gq + C_HG); } }
        f32x4 gain[2]; f32x4 acc[2][8]; f32x4 oT[2];
#pragma unroll
        for (int u = 0; u < 2; ++u) { gain[u] = *(const f32x4*)(F.hg_gain + h * 128 + 16 * ((2 * w + u) & 7) + 4 * g); oT[u] = (f32x4){0.f, 0.f, 0.f, 0.f};
#pragma unroll
            for (int kt = 0; kt < 8; ++kt) acc[u][kt] = (f32x4){0.f, 0.f, 0.f, 0.f}; }
        if (mfw) {
#pragma unroll
            for (int u = 0; u < 2; ++u)
#pragma unroll
                for (int kt = 0; kt < 8; ++kt) acc[u][kt] = *(const f32x4*)(HST + (size_t)it * 16384 + (((2 * w + u) * 8 + kt) * 64 + F.lane) * 4);
        }
        const int k = t & 127, tq = t >> 7;
        __syncthreads();
        for (int base = -2; base <= 32; base += 3) { PASSC_ITER(base, 0); PASSC_ITER(base + 1, 1); PASSC_ITER(base + 2, 2); }
    }
}
#undef PASSC_ITER

struct P3Pol {
    static constexpr bool PERM = true, FP8 = false, GATHER = false;
    const char* A; const char* B; const float* x; bf16* h1b; unsigned char* h1q; int G, c, flags;
    __device__ __forceinline__ bool next(int i, gm::Unit& u) const { int pm, pn; if (!gm::order_next(i, G, c, NTOK / 256, 4, pm, pn)) return false;
        u.pm = pm; u.pn = pn; u.A = A + (size_t)pm * 256 * 2048; u.B = B + (size_t)pn * 256 * 2048; u.e = 0; u.rows = 256; return true; }
    __device__ __forceinline__ void a_off(const gm::Unit&, int R0, int C0, int R1, int C1, unsigned (&vo)[2][2]) const {
        vo[0][0] = (unsigned)(R0 * 1024 + C0) * 2u; vo[0][1] = (unsigned)(R1 * 1024 + C1) * 2u; vo[1][0] = vo[0][0] + 128u * 2048u; vo[1][1] = vo[0][1] + 128u * 2048u; }
    __device__ __forceinline__ size_t koff(int t) const { return (size_t)t * 128; }
    __device__ __forceinline__ void acc_init(f32x4 (&acc)[2][2][4][2], const gm::Unit& u, int wr, int wc, int fr, int fq) const {
        const int row0 = u.pm * 256 + wr * 64 + fr, col0 = u.pn * 256 + wc * 32 + 8 * fq;
#pragma unroll
        for (int ai = 0; ai < 2; ++ai)
#pragma unroll
            for (int m = 0; m < 4; ++m) { const float* xp = x + (size_t)(row0 + ai * 128 + m * 16) * DM + col0;
#pragma unroll
                for (int bj = 0; bj < 2; ++bj) { acc[ai][bj][m][0] = *(const f32x4*)(xp + bj * 128); acc[ai][bj][m][1] = *(const f32x4*)(xp + bj * 128 + 4); } }
#pragma unroll
        for (int ai = 0; ai < 2; ++ai)
#pragma unroll
            for (int m = 0; m < 4; ++m)
#pragma unroll
                for (int bj = 0; bj < 2; ++bj) asm volatile("" : "+v"(acc[ai][bj][m][0]), "+v"(acc[ai][bj][m][1]));
    }
    __device__ __forceinline__ void meta_prefetch(const gm::Unit&, LAS unsigned char*, int, int) const {}
    __device__ __forceinline__ void epi(const f32x4 (&acc)[2][2][4][2], const gm::Unit& u, int wr, int wc, int fr, int fq, LAS unsigned char*, int) const {
        if (flags & 2) { if (acc[0][0][0][0][0] == 1.2345e-30f) h1q[0] = 1; return; }
        const int row0 = u.pm * 256 + wr * 64 + fr, col0 = u.pn * 256 + wc * 32 + 8 * fq;
#pragma unroll
        for (int ai = 0; ai < 2; ++ai)
#pragma unroll
            for (int m = 0; m < 4; ++m) { const size_t off = (size_t)(row0 + ai * 128 + m * 16) * DM + col0;
#pragma unroll
                for (int bj = 0; bj < 2; ++bj) { const f32x4 v0 = acc[ai][bj][m][0], v1 = acc[ai][bj][m][1];
                    u32x4 w; w.x = gm::cvt_pk_bf16(v0[0], v0[1]); w.y = gm::cvt_pk_bf16(v0[2], v0[3]); w.z = gm::cvt_pk_bf16(v1[0], v1[1]); w.w = gm::cvt_pk_bf16(v1[2], v1[3]);
                    *(u32x4*)(h1b + off + bj * 128) = w;
                    *(u32x2*)(h1q + off + bj * 128) = (u32x2){pk4_fp8(v0[0], v0[1], v0[2], v0[3]), pk4_fp8(v1[0], v1[1], v1[2], v1[3])}; } }
    }
};
__device__ __forceinline__ void phase3(Ctx& F) {
    P3Pol S{(const char*)(F.ws + WS_MIX), (const char*)(F.ws + WS_WOUT), F.x, (bf16*)(F.ws + WS_H1B), F.ws + WS_H1Q, F.G, F.vc, F.flags};
    gm::gemm_phase<P3Pol>(F.lds, S);
}

__device__ __forceinline__ void phase_router_fast(Ctx& F) {
    LAS float* W4 = (LAS float*)F.lds;
    LAS unsigned char* M = F.lds + MISC_OFF + 1024;
    LAS float* rsd = (LAS float*)M; LAS int* sel_e = (LAS int*)(M + 512); LAS float* sel_g = (LAS float*)(M + 2560); LAS int* lpos = (LAS int*)(M + 4608); LAS int* hist = (LAS int*)(M + 6656); LAS int* base = hist + 32;
    unsigned* cnt = (unsigned*)(F.ws + WS_CTL) + CW_CNT;
    int* STOK = (int*)(F.ws + WS_STOK); float* SGATE = (float*)(F.ws + WS_SGATE); float* SRSTD = (float*)(F.ws + WS_SRSTD);
    for (int idx = F.tid; idx < 1024 * NE; idx += NTHR) { const int k = idx >> 5, e = idx & 31; W4[((k >> 2) * 32 + e) * 4 + (k & 3)] = F.w_router[idx] * F.ffn_gain[k]; }
    for (int tb = F.bid; tb < NTOK / 128; tb += F.G) {
        const int tok0 = tb * 128;
        __syncthreads();
        if (F.tid < 32) hist[F.tid] = 0;
        if (F.wave < 4) {
            const int j = F.lane & 31, h = F.lane >> 5, tok = tok0 + F.wave * 32 + j;
            const bf16* hp = (const bf16*)(F.ws + WS_H1B) + (size_t)tok * DM + 4 * h;
            f32x16 acc;
#pragma unroll
            for (int r = 0; r < 16; ++r) acc[r] = 0.f;
            float ssq = 0.f;
            u32x2 pre[8];
#pragma unroll
            for (int q = 0; q < 8; ++q) pre[q] = *(const u32x2*)(hp + 8 * q);
            for (int m0 = 0; m0 < 128; m0 += 8) {
                u32x2 cur[8];
#pragma unroll
                for (int q = 0; q < 8; ++q) cur[q] = pre[q];
                if (m0 + 8 < 128) {
#pragma unroll
                    for (int q = 0; q < 8; ++q) pre[q] = *(const u32x2*)(hp + 8 * (m0 + 8 + q));
                }
#pragma unroll
                for (int q = 0; q < 8; ++q) { const f32x4 wv = *(const LAS f32x4*)(W4 + ((2 * (m0 + q) + h) * 32 + j) * 4); const f32x4 a = (f32x4){bflo(cur[q].x), bfhi(cur[q].x), bflo(cur[q].y), bfhi(cur[q].y)};
                    ssq += (a[0] * a[0] + a[1] * a[1]) + (a[2] * a[2] + a[3] * a[3]);
#pragma unroll
                    for (int c = 0; c < 4; ++c) acc = __builtin_amdgcn_mfma_f32_32x32x2f32(wv[c], a[c], acc, 0, 0, 0); }
            }
            ssq += __shfl_xor(ssq, 32);
            const float rstd = 1.0f / sqrtf(ssq * (1.f / DM) + EPS);
            float lg[16];
#pragma unroll
            for (int r = 0; r < 16; ++r) lg[r] = acc[r] * rstd + F.b_router[(r & 3) + 8 * (r >> 2) + 4 * h];
            float v[8]; int id[8]; unsigned used = 0u;
#pragma unroll
            for (int k = 0; k < 4; ++k) { float best = -3.0e38f; int bi = 0, br = 0;
#pragma unroll
                for (int r = 0; r < 16; ++r) { const bool c = !((used >> r) & 1u) && lg[r] > best; best = c ? lg[r] : best; bi = c ? ((r & 3) + 8 * (r >> 2) + 4 * h) : bi; br = c ? r : br; }
                used |= 1u << br; v[k] = best; id[k] = bi; }
#pragma unroll
            for (int k = 0; k < 4; ++k) { v[4 + k] = __shfl_xor(v[k], 32); id[4 + k] = __shfl_xor(id[k], 32); }
            float tv[4]; int ti[4]; unsigned u2 = 0u;
#pragma unroll
            for (int k = 0; k < 4; ++k) { float best = -3.0e38f; int bi = 1 << 30, bc = 0;
#pragma unroll
                for (int c8 = 0; c8 < 8; ++c8) { const bool c = !((u2 >> c8) & 1u) && (v[c8] > best || (v[c8] == best && id[c8] < bi)); best = c ? v[c8] : best; bi = c ? id[c8] : bi; bc = c ? c8 : bc; }
                u2 |= 1u << bc; tv[k] = best; ti[k] = bi; }
            float den = 0.f, pr[4];
#pragma unroll
            for (int k = 0; k < 4; ++k) { pr[k] = __expf(tv[k] - tv[0]); den += pr[k]; }
            const float rden = 1.0f / den;
            if (h == 0) { const int tl = F.wave * 32 + j; rsd[tl] = rstd;
#pragma unroll
                for (int k = 0; k < 4; ++k) { sel_e[tl * 4 + k] = ti[k]; sel_g[tl * 4 + k] = pr[k] * rden; } }
        }
        __syncthreads();
        if (F.tid < 128) {
#pragma unroll
            for (int k = 0; k < 4; ++k) lpos[F.tid * 4 + k] = atomicAdd((int*)&hist[sel_e[F.tid * 4 + k]], 1); }
        __syncthreads();
        if (F.tid < 32) base[F.tid] = (int)__hip_atomic_fetch_add(&cnt[64 * F.tid], (unsigned)hist[F.tid], __ATOMIC_RELAXED, __HIP_MEMORY_SCOPE_AGENT);
        __syncthreads();
        if (F.tid < 128) {
#pragma unroll
            for (int k = 0; k < 4; ++k) { const int e = sel_e[F.tid * 4 + k]; const size_t sl = (size_t)e * ECAP + base[e] + lpos[F.tid * 4 + k];
                STOK[sl] = (tok0 + F.tid) * 4 + k; SGATE[sl] = sel_g[F.tid * 4 + k]; SRSTD[sl] = rsd[F.tid]; } }
    }
    __syncthreads();
}

struct RbTab { LAS int* e; LAS int* start; LAS int* rows; LAS int* off; int nrb; };
__device__ __forceinline__ RbTab build_rbtab(Ctx& F) {
    RbTab T; LAS int* m = (LAS int*)(F.lds + MISC_OFF + 1024);
    T.e = m; T.start = m + 640; T.rows = m + 1280; T.off = m + 1920;
    LAS int* nrbp = m + 1920 + 64;
    const unsigned* cnt = (const unsigned*)(F.ws + WS_CTL) + CW_CNT;
    __syncthreads();
    if (F.tid == 0) { int off = 0, rb = 0;
        for (int e = 0; e < NE; ++e) { const int c = (int)__hip_atomic_load(&cnt[64 * e], __ATOMIC_RELAXED, __HIP_MEMORY_SCOPE_AGENT); T.off[e] = off;
            for (int i = 0; i * 256 < c; ++i) { T.e[rb] = e; T.start[rb] = i * 256; T.rows[rb] = (c - i * 256) < 256 ? (c - i * 256) : 256; ++rb; }
            off += c; }
        T.off[NE] = off; *nrbp = rb; }
    __syncthreads();
    T.nrb = *nrbp;
    return T;
}

__device__ __forceinline__ float swiglu_(float hg, float hu) {
    hg = fminf(hg, SW_LIMIT); hu = fminf(fmaxf(hu, -SW_LIMIT), SW_LIMIT);
    return (hu + 1.0f) * (hg * sigmoidf_(SW_ALPHA * hg));
}
struct P4Pol {
    static constexpr bool PERM = true, FP8 = true, GATHER = true;
    const char* A; const char* B; unsigned char* hid; const int* stok; const float* srstd; const float* bg; const float* bu; RbTab T; int G, c, flags;
    __device__ __forceinline__ bool next(int i, gm::Unit& u) const { int pm, pn; if (!gm::order_next(i, G, c, T.nrb, 8, pm, pn)) return false;
        u.pm = pm; u.pn = pn; u.e = __builtin_amdgcn_readfirstlane(T.e[pm]); u.rows = __builtin_amdgcn_readfirstlane(T.rows[pm]); u.A = A; u.B = B + ((size_t)(u.e * 8 + pn) * 256) * 1024; return true; }
    __device__ __forceinline__ void a_off(const gm::Unit& u, int R0, int C0, int R1, int C1, unsigned (&vo)[2][2]) const {
        const int* lst = stok + (size_t)u.e * ECAP + T.start[u.pm];
#pragma unroll
        for (int h = 0; h < 2; ++h) { int r0 = R0 + 128 * h, r1 = R1 + 128 * h; r0 = r0 < u.rows ? r0 : 0; r1 = r1 < u.rows ? r1 : 0;
            vo[h][0] = (unsigned)(lst[r0] >> 2) * 1024u + (unsigned)C0 * 2u; vo[h][1] = (unsigned)(lst[r1] >> 2) * 1024u + (unsigned)C1 * 2u; }
    }
    __device__ __forceinline__ void idx_prefetch(const gm::Unit& u, LAS unsigned char* lds, int wid) const {
        if (wid < 4) { const int* lst = stok + (size_t)u.e * ECAP + __builtin_amdgcn_readfirstlane(T.start[u.pm]) + wid * 64 + (threadIdx.x & 63);
            __builtin_amdgcn_global_load_lds((const unsigned*)lst, (LAS unsigned*)(lds + IDX_OFF + wid * 256), 4, 0, 0); } }
    __device__ __forceinline__ void a_off_lds(const gm::Unit& u, int, int, int, int, LAS unsigned char* lds, unsigned (&vo)[2][2]) const {
        const LAS int* ib = (const LAS int*)(lds + IDX_OFF);
        int tq = threadIdx.x; asm volatile("" : "+v"(tq));
        int R0, C0, R1, C1; gm::stage_rc(tq * 16, R0, C0); gm::stage_rc(tq * 16 + 8192, R1, C1);
#pragma unroll
        for (int h = 0; h < 2; ++h) { int r0 = R0 + 128 * h, r1 = R1 + 128 * h; r0 = r0 < u.rows ? r0 : 0; r1 = r1 < u.rows ? r1 : 0;
            vo[h][0] = (unsigned)(ib[r0] >> 2) * 1024u + (unsigned)C0 * 2u; vo[h][1] = (unsigned)(ib[r1] >> 2) * 1024u + (unsigned)C1 * 2u; }
    }
    __device__ __forceinline__ size_t koff(int t) const { return (size_t)t * 128; }
    __device__ __forceinline__ void acc_init(f32x4 (&acc)[2][2][4][2], const gm::Unit&, int, int, int, int) const { gm::acc_zero(acc); }
    __device__ __forceinline__ void meta_prefetch(const gm::Unit& u, LAS unsigned char* lds, int wid, int ui) const {
        LAS unsigned char* mb = lds + META_OFF + (ui & 1) * META_BYTES; const int ln = threadIdx.x & 63;
        const float* src = (wid < 4) ? srstd + (size_t)u.e * ECAP + __builtin_amdgcn_readfirstlane(T.start[u.pm]) + wid * 64 + ln
                                     : ((wid < 6) ? bg : bu) + u.e * DFF + u.pn * 128 + (wid & 1) * 64 + ln;
        __builtin_amdgcn_global_load_lds((const unsigned*)src, (LAS unsigned*)(mb + wid * 256), 4, 0, 0);
    }
    __device__ __forceinline__ void epi(const f32x4 (&acc)[2][2][4][2], const gm::Unit& u, int wr, int wc, int fr, int fq, LAS unsigned char* lds, int ui) const {
        if (flags & 4) { if (acc[0][0][0][0][0] == 1.2345e-30f) hid[0] = 1; return; }
        const LAS unsigned char* mb = lds + META_OFF + (ui & 1) * META_BYTES;
        const size_t grow = (size_t)T.off[u.e] + T.start[u.pm];
        const int jl = wc * 32 + 8 * fq, j0 = u.pn * 128 + jl;
        const f32x4 bg0 = *(const LAS f32x4*)(mb + 1024 + jl * 4), bg1 = *(const LAS f32x4*)(mb + 1024 + jl * 4 + 16), bu0 = *(const LAS f32x4*)(mb + 1536 + jl * 4), bu1 = *(const LAS f32x4*)(mb + 1536 + jl * 4 + 16);
#pragma unroll
        for (int ai = 0; ai < 2; ++ai)
#pragma unroll
            for (int m = 0; m < 4; ++m) { const int r = ai * 128 + wr * 64 + m * 16 + fr;
                if (r < u.rows) { const float rs = *(const LAS float*)(mb + r * 4) * W8_INV;
                    const f32x4 g0 = acc[ai][0][m][0] * rs + bg0, g1 = acc[ai][0][m][1] * rs + bg1, u0 = acc[ai][1][m][0] * rs + bu0, u1 = acc[ai][1][m][1] * rs + bu1;
                    *(u32x2*)(hid + (grow + r) * DFF + j0) = (u32x2){pk4_fp8(swiglu_(g0[0], u0[0]), swiglu_(g0[1], u0[1]), swiglu_(g0[2], u0[2]), swiglu_(g0[3], u0[3])),
                                                                     pk4_fp8(swiglu_(g1[0], u1[0]), swiglu_(g1[1], u1[1]), swiglu_(g1[2], u1[2]), swiglu_(g1[3], u1[3]))}; } }
    }
};
__device__ __forceinline__ void phase_gateup(Ctx& F) {
    RbTab T = build_rbtab(F);
    P4Pol S{(const char*)(F.ws + WS_H1Q), (const char*)(F.ws + WS_WGU), F.ws + WS_HID, (const int*)(F.ws + WS_STOK), (const float*)(F.ws + WS_SRSTD), F.b_gate, F.b_up, T, F.G, F.vc, F.flags};
    gm::gemm_phase<P4Pol>(F.lds, S);
}

struct P5Pol {
    static constexpr bool PERM = true, FP8 = true, GATHER = false;
    const char* A; const char* B; const int* stok; const float* sgate; const float* bd; unsigned char* y; int* tslot; RbTab T; int G, c, flags;
    __device__ __forceinline__ bool next(int i, gm::Unit& u) const { int pm, pn; if (!gm::order_next(i, G, c, T.nrb, 4, pm, pn)) return false;
        u.pm = pm; u.pn = pn; u.e = __builtin_amdgcn_readfirstlane(T.e[pm]); u.rows = __builtin_amdgcn_readfirstlane(T.rows[pm]);
        const int grow = __builtin_amdgcn_readfirstlane(T.off[u.e] + T.start[pm]); u.A = A + (size_t)grow * 1024; u.B = B + ((size_t)u.e * 1024 + pn * 256) * 1024; return true; }
    __device__ __forceinline__ void a_off(const gm::Unit&, int R0, int C0, int R1, int C1, unsigned (&vo)[2][2]) const {
        vo[0][0] = (unsigned)(R0 * 1024 + C0 * 2); vo[0][1] = (unsigned)(R1 * 1024 + C1 * 2); vo[1][0] = vo[0][0] + 128u * 1024u; vo[1][1] = vo[0][1] + 128u * 1024u; }
    __device__ __forceinline__ size_t koff(int t) const { return (size_t)t * 128; }
    __device__ __forceinline__ void acc_init(f32x4 (&acc)[2][2][4][2], const gm::Unit&, int, int, int, int) const { gm::acc_zero(acc); }
    __device__ __forceinline__ void meta_prefetch(const gm::Unit& u, LAS unsigned char* lds, int wid, int ui) const {
        LAS unsigned char* mb = lds + META_OFF + (ui & 1) * META_BYTES; const int ln = threadIdx.x & 63;
        const size_t sb = (size_t)u.e * ECAP + __builtin_amdgcn_readfirstlane(T.start[u.pm]) + (wid & 3) * 64 + ln;
        const unsigned* src = (wid < 4) ? (const unsigned*)(stok + sb) : (const unsigned*)(sgate + sb);
        __builtin_amdgcn_global_load_lds(src, (LAS unsigned*)(mb + wid * 256), 4, 0, 0);
        if (wid < 4) __builtin_amdgcn_global_load_lds((const unsigned*)(bd + u.e * DM + u.pn * 256 + wid * 64 + ln), (LAS unsigned*)(mb + 2048 + wid * 256), 4, 0, 0);
    }
    __device__ __forceinline__ void epi(const f32x4 (&acc)[2][2][4][2], const gm::Unit& u, int wr, int wc, int fr, int fq, LAS unsigned char* lds, int ui) const {
        if (flags & 8) { if (acc[0][0][0][0][0] == 1.2345e-30f) y[0] = 1; return; }
        const LAS unsigned char* mb = lds + META_OFF + (ui & 1) * META_BYTES;
        const int cl = wc * 32 + 8 * fq, col0 = u.pn * 256 + cl; const size_t grow = (size_t)T.off[u.e] + T.start[u.pm];
        f32x4 bv[2][2];
#pragma unroll
        for (int bj = 0; bj < 2; ++bj) { bv[bj][0] = *(const LAS f32x4*)(mb + 2048 + (bj * 128 + cl) * 4); bv[bj][1] = *(const LAS f32x4*)(mb + 2048 + (bj * 128 + cl) * 4 + 16); }
#pragma unroll
        for (int ai = 0; ai < 2; ++ai)
#pragma unroll
            for (int m = 0; m < 4; ++m) { const int r = ai * 128 + wr * 64 + m * 16 + fr;
                if (r < u.rows) { const int tr = *(const LAS int*)(mb + r * 4); const float gt = *(const LAS float*)(mb + 1024 + r * 4) * Y8_SCALE, gw = gt * W8_INV;
                    unsigned char* p = y + (grow + r) * DM + col0;
                    if (u.pn == 0 && wc == 0 && fq == 0) tslot[tr] = (int)(grow + r);
#pragma unroll
                    for (int bj = 0; bj < 2; ++bj) { const f32x4 v0 = acc[ai][bj][m][0] * gw + bv[bj][0] * gt, v1 = acc[ai][bj][m][1] * gw + bv[bj][1] * gt;
                        *(u32x2*)(p + bj * 128) = (u32x2){pk4_fp8(v0[0], v0[1], v0[2], v0[3]), pk4_fp8(v1[0], v1[1], v1[2], v1[3])}; } } }
    }
};
__device__ __forceinline__ void phase_down(Ctx& F) {
    RbTab T = build_rbtab(F);
    P5Pol S{(const char*)(F.ws + WS_HID), (const char*)(F.ws + WS_WDN), (const int*)(F.ws + WS_STOK), (const float*)(F.ws + WS_SGATE), F.b_down, F.ws + WS_Y, (int*)(F.ws + WS_TSLOT), T, F.G, F.vc, F.flags};
    gm::gemm_phase<P5Pol>(F.lds, S);
}

__device__ __forceinline__ void phase_final(Ctx& F) {
    const int gw = F.bid * NWAVES + F.wave, NGW = F.G * NWAVES;
    const unsigned char* Y = F.ws + WS_Y; const int* TS = (const int*)(F.ws + WS_TSLOT);
    for (int m = gw; m < NTOK; m += NGW) {
        f32x4* xr = (f32x4*)(F.out + (size_t)m * DM) + F.lane; const f32x4* gr = (const f32x4*)F.fin_gain + F.lane;
        const u32x2* hr = (const u32x2*)((const bf16*)(F.ws + WS_H1B) + (size_t)m * DM) + F.lane;
        const int s0 = __builtin_amdgcn_readfirstlane(TS[m * 4]), s1 = __builtin_amdgcn_readfirstlane(TS[m * 4 + 1]), s2 = __builtin_amdgcn_readfirstlane(TS[m * 4 + 2]), s3 = __builtin_amdgcn_readfirstlane(TS[m * 4 + 3]);
        const unsigned* y0 = (const unsigned*)(Y + (size_t)s0 * DM) + F.lane; const unsigned* y1 = (const unsigned*)(Y + (size_t)s1 * DM) + F.lane;
        const unsigned* y2 = (const unsigned*)(Y + (size_t)s2 * DM) + F.lane; const unsigned* y3 = (const unsigned*)(Y + (size_t)s3 * DM) + F.lane;
        f32x4 v[4]; float s = 0.f;
#pragma unroll
        for (int j = 0; j < 4; ++j) { const u32x2 hb = hr[64 * j]; v[j] = (f32x4){bflo(hb.x), bfhi(hb.x), bflo(hb.y), bfhi(hb.y)}; const unsigned a = y0[64 * j], b = y1[64 * j], c = y2[64 * j], d = y3[64 * j];
            const f32x2 al = __builtin_amdgcn_cvt_pk_f32_fp8((int)a, false), ah = __builtin_amdgcn_cvt_pk_f32_fp8((int)a, true), bl = __builtin_amdgcn_cvt_pk_f32_fp8((int)b, false), bh = __builtin_amdgcn_cvt_pk_f32_fp8((int)b, true);
            const f32x2 cl = __builtin_amdgcn_cvt_pk_f32_fp8((int)c, false), ch = __builtin_amdgcn_cvt_pk_f32_fp8((int)c, true), dl = __builtin_amdgcn_cvt_pk_f32_fp8((int)d, false), dh = __builtin_amdgcn_cvt_pk_f32_fp8((int)d, true);
            v[j].x += ((al[0] + bl[0]) + (cl[0] + dl[0])) * Y8_INV; v[j].y += ((al[1] + bl[1]) + (cl[1] + dl[1])) * Y8_INV;
            v[j].z += ((ah[0] + bh[0]) + (ch[0] + dh[0])) * Y8_INV; v[j].w += ((ah[1] + bh[1]) + (ch[1] + dh[1])) * Y8_INV;
            s += (v[j].x * v[j].x + v[j].y * v[j].y) + (v[j].z * v[j].z + v[j].w * v[j].w); }
        const float rstd = 1.0f / sqrtf(wave_sum(s) * (1.f / DM) + EPS);
#pragma unroll
        for (int j = 0; j < 4; ++j) xr[64 * j] = v[j] * rstd * gr[64 * j];
    }
}

struct Args { const float* in[17]; float* out; unsigned char* ws; int ph_lo, ph_hi, flags, pad; };
constexpr int NPHASE = 9;
__global__ void __launch_bounds__(NTHR, 2) fwd_kernel(Args args) {
    extern __shared__ __attribute__((aligned(16))) unsigned char lds_raw[];
    Ctx F;
    F.x = args.in[0]; F.w_in = args.in[1]; F.w_out = args.in[2]; F.lb_logits = args.in[3]; F.hg_gain = args.in[4]; F.sb_gain = args.in[5]; F.mix_gain = args.in[6]; F.ffn_gain = args.in[7];
    F.w_router = args.in[8]; F.b_router = args.in[9]; F.w_gate = args.in[10]; F.b_gate = args.in[11]; F.w_up = args.in[12]; F.b_up = args.in[13]; F.w_down = args.in[14]; F.b_down = args.in[15]; F.fin_gain = args.in[16];
    F.out = args.out; F.ws = args.ws; F.lds = (LAS unsigned char*)lds_raw;
    F.tid = threadIdx.x; F.lane = F.tid & 63; F.wave = __builtin_amdgcn_readfirstlane(F.tid >> 6); F.G = gridDim.x; F.bid = blockIdx.x; F.flags = args.flags;
    volatile LAS unsigned* MISC = (volatile LAS unsigned*)(F.lds + MISC_OFF);
    if (F.tid < 64) MISC[F.tid] = 0u;
    __syncthreads();
    const int lo = args.ph_lo, hi = args.ph_hi;
    XcdBarrier bar; bar.bar = (unsigned*)(F.ws + WS_CTL) + CW_BAR; bar.x = 0; bar.st = nullptr;
    if (hi - lo > 1) bar = xcd_barrier_post((unsigned*)(F.ws + WS_CTL) + CW_BAR, MISC + 8);
#ifdef TEST_PHASE
#define IN(k) ((k) == TEST_PHASE && lo <= (k))
#else
#define IN(k) (lo <= (k) && (k) < hi)
#endif
#define SEAM(k) do { if (IN(k) && IN((k) + 1)) xcd_barrier(bar); } while (0)
    if (IN(0)) { phase0(F); } SEAM(0);
    F.vc = F.bid;
    if (hi - lo > 1 && IN(0)) {
        if (F.tid == 0) { bool ok = (F.G % 8 == 0); unsigned* bw = (unsigned*)(F.ws + WS_CTL) + CW_BAR;
            for (unsigned j = 0; j < 16; ++j) { const unsigned c = xb_ld(&bw[XB_XCNT(j)]); ok = ok && (j < 8 ? c == (unsigned)F.G / 8 : c == 0u); }
            MISC[3] = ok ? (MISC[10] * 8u + bar.x) : (unsigned)F.bid; }
        __syncthreads();
        F.vc = __builtin_amdgcn_readfirstlane((int)MISC[3]);
    }
    if (IN(1)) { phase1(F); } SEAM(1);
    if (IN(2)) { hgrn_passA(F);
        if (F.tid < 256) *(LAS f32x4*)(F.lds + 122880 + F.tid * 16) = *(const f32x4*)(F.ffn_gain + F.tid * 4);
        __syncthreads();
        if (F.wave < 4) sb_attn_fast(F);
        moe_convert_jobs(F, (LAS float*)(F.lds + 32768 + F.wave * 10240), (const LAS float*)(F.lds + 122880));
        } SEAM(2);
    if (IN(3)) { hgrn_passB(F); if (hi - lo > 1) xcd_barrier(bar); hgrn_passC(F); } SEAM(3);
    if (IN(4)) { phase3(F); } SEAM(4);
    if (IN(5)) { phase_router_fast(F); } SEAM(5);
    if (IN(6)) { phase_gateup(F); } SEAM(6);
    if (IN(7)) { phase_down(F); } SEAM(7);
    if (IN(8)) { phase_final(F); }
#undef IN
#undef SEAM
}

extern "C" void kernel_launch(void* const* d_in, const int* in_sizes, int n_in, void* d_out, int out_size, void* d_ws, size_t ws_size, hipStream_t stream) {
    static int grid = 0;
    if (grid == 0) {
        if (n_in != 17 || in_sizes[0] != NTOK * DM || out_size != NTOK * DM || ws_size < WS_END2) {
            fprintf(stderr, "kernel_launch: unexpected shapes / workspace (n_in %d, in0 %d, out %d, ws %zu, need %zu); nothing launched\n", n_in, n_in > 0 ? in_sizes[0] : -1, out_size, ws_size, (size_t)WS_END); grid = -1; return; }
        int dev = 0, cus = 0;
        if (hipGetDevice(&dev) != hipSuccess || hipDeviceGetAttribute(&cus, hipDeviceAttributeMultiprocessorCount, dev) != hipSuccess) { grid = -1; return; }
        if (hipFuncSetAttribute((const void*)fwd_kernel, hipFuncAttributeMaxDynamicSharedMemorySize, LDS_BYTES) != hipSuccess) { fprintf(stderr, "kernel_launch: hipFuncSetAttribute failed\n"); grid = -1; return; }
        int per_cu = 0;
        if (hipOccupancyMaxActiveBlocksPerMultiprocessor(&per_cu, (const void*)fwd_kernel, NTHR, LDS_BYTES) != hipSuccess || per_cu < 1) fprintf(stderr, "kernel_launch: occupancy query reports %d\n", per_cu);
        (void)hipGetLastError();
        grid = cus;
    }
    if (grid < 0) return;
    (void)hipMemsetAsync((char*)d_ws + WS_CTL, 0, CTL_BYTES, stream);
    Args a{};
    for (int i = 0; i < 17; ++i) a.in[i] = (const float*)d_in[i];
    a.out = (float*)d_out; a.ws = (unsigned char*)d_ws;
#if N_LAUNCH_MODE == 1
#ifdef PROBE_K
    a.ph_lo = 0; a.ph_hi = PROBE_K; a.flags = PROBE_FLAGS;
    hipLaunchKernelGGL(fwd_kernel, dim3(grid), dim3(NTHR), LDS_BYTES, stream, a);
    (void)hipMemsetAsync((char*)d_ws + WS_CTL, 0, CTL_BYTES, stream);
#endif
    a.ph_lo = 0; a.ph_hi = NPHASE; a.flags = 0;
    hipLaunchKernelGGL(fwd_kernel, dim3(grid), dim3(NTHR), LDS_BYTES, stream, a);
#else
    for (int p = 0; p < NPHASE; ++p) { a.ph_lo = p; a.ph_hi = p + 1; hipLaunchKernelGGL(fwd_kernel, dim3(grid), dim3(NTHR), LDS_BYTES, stream, a); }
#endif
}
```

```cpp
#include <hip/hip_runtime.h>
#include <cstdio>
#include <cstdint>

#ifndef PROBE_FLAGS
#define PROBE_FLAGS 0
#endif
#ifndef N_LAUNCH_MODE
#define N_LAUNCH_MODE 1
#endif

#define LAS __attribute__((address_space(3)))
typedef unsigned short bf16;
typedef short bf16x8 __attribute__((ext_vector_type(8)));
typedef float f32x2 __attribute__((ext_vector_type(2)));
typedef float f32x4 __attribute__((ext_vector_type(4)));
typedef float f32x16 __attribute__((ext_vector_type(16)));
typedef unsigned u32x2 __attribute__((ext_vector_type(2)));
typedef unsigned u32x4 __attribute__((ext_vector_type(4)));

constexpr int NTOK = 32768, DM = 1024, SEQ = 8192, NBATCH = 4;
constexpr int INC = 3584;
constexpr int C_HQ = 0, C_HF = 512, C_HI = 1024, C_HG = 1536, C_SQ = 2048, C_SK = 2560, C_SV = 3072;
constexpr int NE = 32, TOPK = 4, DFF = 1024, NK = NTOK * TOPK;
constexpr int ECAP = NTOK;
constexpr float EPS = 1e-5f, SW_LIMIT = 7.0f, SW_ALPHA = 1.702f;
constexpr float W8_SCALE = 64.0f, W8_INV = 1.0f / 64.0f;
constexpr float SB_PEXIT = 1.0e-30f;

constexpr size_t WS_WDN = 0;
constexpr size_t WS_WGU = WS_WDN + 67108864;
constexpr size_t WS_C = WS_WGU + 134217728;
constexpr size_t C_BYTES = (size_t)(NK + 256) * 2048;
constexpr size_t WS_D = WS_C + C_BYTES;
constexpr size_t WS_E = WS_D + 67108864;
constexpr size_t WS_H1B = WS_C;
constexpr size_t WS_MIX = WS_D;
constexpr size_t WS_H1Q = WS_WDN + 33554432;
constexpr size_t WS_PROJ = WS_C;
constexpr size_t WS_WIN = WS_PROJ + (size_t)NTOK * INC * 2;
constexpr size_t WS_WOUT = WS_WIN + (size_t)INC * 1024 * 2;
constexpr size_t WS_HST = WS_WOUT + (size_t)1024 * 1024 * 2;
constexpr size_t WS_HDEC = WS_HST + (size_t)256 * 65536;
static_assert(WS_HDEC + 256 * 128 * 4 <= WS_C + C_BYTES, "C region");
constexpr size_t WS_CTL = WS_E;
constexpr size_t CTL_BYTES = 1u << 20;
constexpr size_t WS_RSTD = WS_CTL + CTL_BYTES;
constexpr size_t WS_STOK = WS_RSTD + (size_t)NTOK * 4;
constexpr size_t WS_SGATE = WS_STOK + (size_t)NE * ECAP * 4;
constexpr size_t WS_SRSTD = WS_SGATE + (size_t)NE * ECAP * 4;
constexpr size_t WS_END = WS_SRSTD + (size_t)NE * ECAP * 4;
constexpr size_t HID_BYTES = (size_t)(NK + 256) * 1024;
constexpr size_t WS_HID = WS_C + C_BYTES - HID_BYTES;
constexpr size_t WS_Y = WS_WGU;
static_assert(WS_Y + (size_t)NK * DM <= WS_HID, "y vs hidden");
constexpr float Y8_SCALE = 16.0f, Y8_INV = 1.0f / 16.0f;
constexpr size_t WS_TSLOT = WS_END;
constexpr size_t WS_END2 = WS_TSLOT + (size_t)NTOK * 4 * 4;
constexpr int CW_JOB = 32;
constexpr int CW_CNT = 64;
constexpr int CW_BAR = 4096;

constexpr int RING_BYTES = 131072;
constexpr int MISC_OFF = RING_BYTES;
constexpr int IDX_OFF = MISC_OFF + 9216;
constexpr int META_OFF = MISC_OFF + 10240, META_BYTES = 3072;
constexpr int LDS_BYTES = 147456;
constexpr int NWAVES = 8, NTHR = 512;

__device__ __forceinline__ unsigned f2bf(float f) { unsigned u = __builtin_bit_cast(unsigned, f); return (u + 0x7fffu + ((u >> 16) & 1u)) >> 16; }
__device__ __forceinline__ unsigned pk2(float lo, float hi) { return f2bf(lo) | (f2bf(hi) << 16); }
__device__ __forceinline__ unsigned pk4_fp8(float a, float b, float c, float d) { int w = __builtin_amdgcn_cvt_pk_fp8_f32(a, b, 0, false); w = __builtin_amdgcn_cvt_pk_fp8_f32(c, d, w, true); return (unsigned)w; }
__device__ __forceinline__ float bf2f(unsigned b) { return __builtin_bit_cast(float, b << 16); }
__device__ __forceinline__ float bflo(unsigned w) { return __builtin_bit_cast(float, w << 16); }
__device__ __forceinline__ float bfhi(unsigned w) { return __builtin_bit_cast(float, w & 0xffff0000u); }
__device__ __forceinline__ float wave_sum(float v) {
#pragma unroll
    for (int o = 1; o < 64; o <<= 1) v += __shfl_xor(v, o);
    return v;
}
__device__ __forceinline__ float sigmoidf_(float x) { return __builtin_amdgcn_rcpf(1.0f + __builtin_amdgcn_exp2f(-1.44269504f * x)); }
__device__ __forceinline__ float siluf_(float x) { return x * sigmoidf_(x); }
__device__ __forceinline__ float softplusf_(float z) { return fmaxf(z, 0.f) + __logf(1.0f + __expf(-fabsf(z))); }
#define LDS_WAIT() asm volatile("s_waitcnt lgkmcnt(0)" ::: "memory")
#define VM_WAIT() asm volatile("s_waitcnt vmcnt(0)" ::: "memory")

struct Ctx {
    const float *x, *w_in, *w_out, *lb_logits, *hg_gain, *sb_gain, *mix_gain, *ffn_gain, *w_router, *b_router, *w_gate, *b_gate, *w_up, *b_up, *w_down, *b_down, *fin_gain;
    float* out; unsigned char* ws;
    LAS unsigned char* lds;
    int tid, lane, wave, G, bid, flags, vc;
};

#define XB_TMO      128
#define XB_XCNT(j)  (256  + 64 * (j))
#define XB_XSUB(j)  (1280 + 64 * (j))
#define XB_XGEN(j)  (2304 + 64 * (j))
#define XB_TOP      3328
#define XB_TOPGEN   3392
#define XCD_BAR_WORDS 3456
#define XB_SPIN_CAP (1u << 22)
__device__ __forceinline__ unsigned xb_ld(unsigned* p)              { return __hip_atomic_load(p, __ATOMIC_RELAXED, __HIP_MEMORY_SCOPE_AGENT); }
__device__ __forceinline__ unsigned xb_add(unsigned* p, unsigned v) { return __hip_atomic_fetch_add(p, v, __ATOMIC_RELAXED, __HIP_MEMORY_SCOPE_AGENT); }
__device__ __forceinline__ unsigned xb_xcc_id() { return (unsigned)__builtin_amdgcn_s_getreg((3 << 11) | 20) & 0xFu; }
#define XB_SPIN(cond, bar) do { unsigned _sp = 0; while (cond) { __builtin_amdgcn_s_sleep(1); \
    if ((++_sp & 255u) == 0u) { if (xb_ld(&(bar)[XB_TMO])) break; if (_sp > XB_SPIN_CAP) { atomicAdd(&(bar)[XB_TMO], 1u); break; } } } } while (0)
struct XcdBarrier { unsigned* bar; unsigned x; volatile LAS unsigned* st; };
__device__ __forceinline__ XcdBarrier xcd_barrier_post(unsigned* bar, volatile LAS unsigned* st) {
    XcdBarrier b; b.bar = bar; b.x = xb_xcc_id(); b.st = st;
    if (threadIdx.x == 0) st[2] = xb_add(&bar[XB_XCNT(b.x)], 1u);
    return b;
}
__device__ __forceinline__ void xcd_barrier_complete(unsigned* bar, unsigned x, unsigned& nloc, unsigned& nx) {
    const unsigned G = gridDim.x * gridDim.y * gridDim.z;
    unsigned sum, cnt, mine, sp = 0u;
    for (;;) {
        sum = 0u; cnt = 0u; mine = 0u;
#pragma unroll
        for (unsigned j = 0; j < 16; ++j) { const unsigned c = xb_ld(&bar[XB_XCNT(j)]); sum += c; cnt += (c > 0u) ? 1u : 0u; mine = (j == x) ? c : mine; }
        if (sum == G) break;
        __builtin_amdgcn_s_sleep(1);
        if ((++sp & 255u) == 0u) { if (xb_ld(&bar[XB_TMO])) break; if (sp > XB_SPIN_CAP) { atomicAdd(&bar[XB_TMO], 1u); break; } }
    }
    nloc = mine > 0u ? mine : 1u; nx = cnt > 0u ? cnt : 1u;
}
__device__ __forceinline__ void xcd_barrier(const XcdBarrier& b) {
    asm volatile("s_waitcnt vmcnt(0)" ::: "memory");
    __syncthreads();
    if (threadIdx.x == 0) {
        unsigned* bar = b.bar;
        __builtin_amdgcn_s_waitcnt(0);
        unsigned nloc = b.st[0], nx = b.st[1];
        if (nloc == 0u) { xcd_barrier_complete(bar, b.x, nloc, nx); b.st[0] = nloc; b.st[1] = nx; }
        const unsigned old = xb_add(&bar[XB_XSUB(b.x)], 1u);
        const unsigned gen = old / nloc;
        if (old + 1u == (gen + 1u) * nloc) {
            __builtin_amdgcn_fence(__ATOMIC_RELEASE, "agent");
            asm volatile("s_waitcnt vmcnt(0)" ::: "memory");
            const unsigned og = xb_add(&bar[XB_TOP], 1u);
            const unsigned tg = og / nx;
            if (og + 1u == (tg + 1u) * nx) xb_add(&bar[XB_TOPGEN], 1u);
            else XB_SPIN(xb_ld(&bar[XB_TOPGEN]) == tg, bar);
            __builtin_amdgcn_fence(__ATOMIC_ACQUIRE, "agent");
            xb_add(&bar[XB_XGEN(b.x)], 1u);
            asm volatile("s_waitcnt vmcnt(0)" ::: "memory");
        } else {
            XB_SPIN(xb_ld(&bar[XB_XGEN(b.x)]) == gen, bar);
            __builtin_amdgcn_fence(__ATOMIC_ACQUIRE, "agent");
            asm volatile("s_waitcnt vmcnt(0)" ::: "memory");
        }
    }
    __syncthreads();
}

namespace gm {
constexpr int BM = 256, BK = 64, HALF = 128, HTB = HALF * BK * 2, NXCD = 8, WGM = 8;
typedef int v8i32 __attribute__((ext_vector_type(8)));
__device__ __forceinline__ int lds_byte(int r, int c) { const int st = (r >> 4) * 2 + (c >> 5), rr = r & 15, cc = c & 31, ob = rr * 64 + cc * 2; return st * 1024 + (ob ^ (((ob >> 9) & 1) << 5)); }
__device__ __forceinline__ void stage_rc(int b, int& R, int& C) { const int st = b / 1024, sb = b % 1024, swz = sb ^ (((sb >> 9) & 1) << 5); R = (st >> 1) * 16 + swz / 64; C = (st & 1) * 32 + (swz % 64) / 2; }
__device__ __forceinline__ int perm32(int rho) { const int n = rho >> 4, i = rho & 15; return 8 * (i >> 2) + 4 * n + (i & 3); }
__device__ __forceinline__ unsigned cvt_pk_bf16(float lo, float hi) { unsigned r; asm volatile("v_cvt_pk_bf16_f32 %0, %1, %2" : "=v"(r) : "v"(lo), "v"(hi)); return r; }

struct Unit { const char* A; const char* B; int pm, pn, e, rows; };

__device__ __forceinline__ bool order_next(int i, int G, int c, int nM, int nN, int& pm, int& pn) {
    const int nwg = nM * nN; const long L = (long)i * G + c; if (L >= nwg) return false;
    int wgid = (int)L; { const int q = nwg / NXCD, r = nwg % NXCD, xcd = wgid % NXCD, off = wgid / NXCD; wgid = (xcd < r ? xcd * (q + 1) : r * (q + 1) + (xcd - r) * q) + off; }
    const int nig = WGM * nN, gid = wgid / nig, fm = gid * WGM, gsz = (nM - fm) < WGM ? (nM - fm) : WGM;
    pm = fm + ((wgid % nig) % gsz); pn = (wgid % nig) / gsz; return true;
}

__device__ __forceinline__ void acc_zero(f32x4 (&acc)[2][2][4][2]) {
#pragma unroll
    for (int a = 0; a < 2; ++a)
#pragma unroll
        for (int b = 0; b < 2; ++b)
#pragma unroll
            for (int m = 0; m < 4; ++m)
#pragma unroll
                for (int n = 0; n < 2; ++n) acc[a][b][m][n] = (f32x4){0.f, 0.f, 0.f, 0.f};
}
template <class P>
__device__ __forceinline__ void gemm_phase(LAS unsigned char* lds, const P& S) {
    const int tid = threadIdx.x, wid = __builtin_amdgcn_readfirstlane(tid >> 6), lane = tid & 63, wr = wid >> 2, wc = wid & 3, fr = lane & 15, fq = lane >> 4;
    constexpr int NT = P::FP8 ? 8 : 16, KB = P::FP8 ? 1024 : 2048;
    int R0, C0, R1, C1; stage_rc(tid * 16, R0, C0); stage_rc(tid * 16 + 8192, R1, C1);
    unsigned voffB[2];
    { const int Rb0 = P::PERM ? ((R0 & ~31) + perm32(R0 & 31)) : R0, Rb1 = P::PERM ? ((R1 & ~31) + perm32(R1 & 31)) : R1;
      voffB[0] = (unsigned)(Rb0 * KB + C0 * 2); voffB[1] = (unsigned)(Rb1 * KB + C1 * 2); }
    const size_t kstep = (size_t)(BK * 2), hstepB = (size_t)HALF * KB;
    const unsigned ldsw = (unsigned)wid * 1024u;
    const int aoff = lds_byte(wr * 64 + fr, fq * 8), boff = lds_byte(wc * 32 + fr, fq * 8);
#define G_SA(b, h) (((b) * 2 + (h)) * HTB)
#define G_SB(b, h) ((4 + (b) * 2 + (h)) * HTB)
#define G_STAGEB(bufoff, gbase) do { const char* _gb = (gbase); asm volatile("" : "+s"(_gb)); _Pragma("unroll") for (int _i = 0; _i < 2; ++_i) \
        __builtin_amdgcn_global_load_lds((const unsigned*)(_gb + voffB[_i]), (LAS unsigned*)(lds + (bufoff) + ldsw + _i * 8192), 16, 0, 0); } while (0)
#define G_STAGEA(bufoff, gbase, vo, h) do { const char* _gb = (gbase); asm volatile("" : "+s"(_gb)); _Pragma("unroll") for (int _i = 0; _i < 2; ++_i) \
        __builtin_amdgcn_global_load_lds((const unsigned*)(_gb + (vo)[h][_i]), (LAS unsigned*)(lds + (bufoff) + ldsw + _i * 8192), 16, 0, 0); } while (0)
#define G_LD16(off) (*(const LAS bf16x8*)(lds + (off)))
#define G_CAT2(lo, hi) __builtin_bit_cast(v8i32, __builtin_shufflevector(lo, hi, 0, 1, 2, 3, 4, 5, 6, 7, 8, 9, 10, 11, 12, 13, 14, 15))
#define G_LDA(dst, b, h) do { _Pragma("unroll") for (int m = 0; m < 4; ++m) { if constexpr (P::FP8) dst##8[m] = G_CAT2(G_LD16(G_SA(b, h) + aoff + m * 2048), G_LD16(G_SA(b, h) + aoff + m * 2048 + 1024)); \
        else { _Pragma("unroll") for (int k = 0; k < 2; ++k) dst[m][k] = G_LD16(G_SA(b, h) + aoff + m * 2048 + k * 1024); } } } while (0)
#define G_LDB(dst, b, h) do { _Pragma("unroll") for (int n = 0; n < 2; ++n) { if constexpr (P::FP8) dst##8[n] = G_CAT2(G_LD16(G_SB(b, h) + boff + n * 2048), G_LD16(G_SB(b, h) + boff + n * 2048 + 1024)); \
        else { _Pragma("unroll") for (int k = 0; k < 2; ++k) dst[n][k] = G_LD16(G_SB(b, h) + boff + n * 2048 + k * 1024); } } } while (0)
#define G_MMA(ai, bj, At, Bt) do { __builtin_amdgcn_s_setprio(1); _Pragma("unroll") for (int m = 0; m < 4; ++m) _Pragma("unroll") for (int n = 0; n < 2; ++n) { \
        if constexpr (P::FP8) asm volatile("v_mfma_f32_16x16x128_f8f6f4 %0, %1, %2, %0" : "+v"(acc[ai][bj][m][n]) : "v"(Bt##8[n]), "v"(At##8[m])); \
        else { _Pragma("unroll") for (int k = 0; k < 2; ++k) acc[ai][bj][m][n] = __builtin_amdgcn_mfma_f32_16x16x32_bf16(Bt[n][k], At[m][k], acc[ai][bj][m][n], 0, 0, 0); } } \
        __builtin_amdgcn_s_setprio(0); } while (0)
#define G_MMA_TAIL() do { if constexpr (P::FP8) asm volatile("s_nop 15" ::: "memory"); } while (0)
#define G_WAIT_V(n) asm volatile("s_waitcnt vmcnt(" #n ")" ::: "memory")
#define G_WAIT_L(n) asm volatile("s_waitcnt lgkmcnt(" #n ")" ::: "memory")
#define G_BAR __builtin_amdgcn_s_barrier()
#define G_SCHED __builtin_amdgcn_sched_barrier(0)
    Unit cur, nxt; int ui = 0;
    if (!S.next(0, cur)) return;
    f32x4 acc[2][2][4][2];
    S.acc_init(acc, cur, wr, wc, fr, fq);
    bf16x8 At[4][2], B0[2][2], B1[2][2]; v8i32 At8[4], B08[2], B18[2];
    unsigned voA[2][2];
    S.a_off(cur, R0, C0, R1, C1, voA);
    const char* cA = cur.A; const char* cB = cur.B;
    G_STAGEB(G_SB(0, 0), cB); G_STAGEB(G_SB(0, 1), cB + hstepB); G_STAGEA(G_SA(0, 0), cA + S.koff(0), voA, 0); G_STAGEA(G_SA(0, 1), cA + S.koff(0), voA, 1);
    if (wr == 1) G_BAR;
    G_WAIT_V(2); G_BAR;
    G_STAGEB(G_SB(1, 0), cB + kstep); G_STAGEA(G_SA(1, 0), cA + S.koff(1), voA, 0); G_STAGEB(G_SB(1, 1), cB + hstepB + kstep);
    G_WAIT_V(6); G_BAR;
    for (;;) {
        const bool has_next = S.next(ui + 1, nxt);
        const char* nA = has_next ? nxt.A : cA; const char* nB = has_next ? nxt.B : cB;
        S.meta_prefetch(cur, lds, wid, ui);
        if constexpr (P::GATHER) { if (has_next) S.idx_prefetch(nxt, lds, wid); }
#pragma unroll 1
        for (int t = 0; t < NT; t += 2) {
            const bool last = (t == NT - 2);
            const char* a1 = cA + S.koff(t + 1);
            const char* a2 = last ? nA + S.koff(0) : cA + S.koff(t + 2); const char* b2 = last ? nB : cB + (size_t)(t + 2) * kstep;
            const char* a3 = last ? nA + S.koff(1) : cA + S.koff(t + 3); const char* b3 = b2 + kstep;
            G_LDB(B0, 0, 0); G_LDB(B1, 0, 1); G_SCHED; G_LDA(At, 0, 0); G_STAGEA(G_SA(1, 1), a1, voA, 1);
            if constexpr (P::GATHER) { if (last && has_next) S.a_off_lds(nxt, R0, C0, R1, C1, lds, voA); }
            G_WAIT_V(8); G_WAIT_L(0); G_BAR; G_MMA(0, 0, At, B0); G_MMA(0, 1, At, B1); G_MMA_TAIL(); G_BAR; G_SCHED;
            G_LDA(At, 0, 1); G_STAGEB(G_SB(0, 0), b2); G_STAGEB(G_SB(0, 1), b2 + hstepB); G_STAGEA(G_SA(0, 0), a2, voA, 0);
            G_WAIT_V(8); G_WAIT_L(0); G_BAR; G_MMA(1, 0, At, B0); G_MMA(1, 1, At, B1); G_MMA_TAIL(); G_BAR; G_SCHED;
            G_LDB(B0, 1, 0); G_LDB(B1, 1, 1); G_SCHED; G_LDA(At, 1, 0); G_STAGEA(G_SA(0, 1), a2, voA, 1);
            G_WAIT_V(8); G_WAIT_L(0); G_BAR; G_MMA(0, 0, At, B0); G_MMA(0, 1, At, B1); G_MMA_TAIL(); G_BAR; G_SCHED;
            G_LDA(At, 1, 1); G_STAGEB(G_SB(1, 0), b3); G_STAGEB(G_SB(1, 1), b3 + hstepB); G_STAGEA(G_SA(1, 0), a3, voA, 0);
            G_WAIT_V(8); G_WAIT_L(0); G_BAR; G_MMA(1, 0, At, B0); G_MMA(1, 1, At, B1); G_MMA_TAIL(); G_BAR; G_SCHED;
        }
        if (wr == 0) G_BAR;
        S.epi(acc, cur, wr, wc, fr, fq, lds, ui);
        if (!has_next) break;
        S.acc_init(acc, nxt, wr, wc, fr, fq);
        cur = nxt; cA = nA; cB = nB; ++ui;
        if (wr == 1) G_BAR;
    }
    G_WAIT_V(0);
    G_BAR;
#undef G_SA
#undef G_SB
#undef G_STAGEA
#undef G_STAGEB
#undef G_LDA
#undef G_LDB
#undef G_MMA
#undef G_MMA_TAIL
#undef G_CAT2
#undef G_LD16
#undef G_WAIT_V
#undef G_WAIT_L
#undef G_BAR
#undef G_SCHED
}
}

template <bool FP8> __device__ __forceinline__ void p0_tile(const f32x4 (&rg)[8], unsigned (&o)[16], int k0, const LAS float* kscale, float mult, LAS float* scr, int lane) {
    const int kr = lane >> 4, c16 = lane & 15;
    asm volatile("" ::: "memory");
#pragma unroll
    for (int j = 0; j < 8; ++j) *(LAS f32x4*)(scr + (4 * j + kr) * 68 + 4 * c16) = rg[j];
    asm volatile("" ::: "memory");
    float v[32];
#pragma unroll
    for (int k = 0; k < 32; ++k) v[k] = scr[k * 68 + lane] * mult;
    if (kscale) {
#pragma unroll
        for (int q = 0; q < 8; ++q) { const f32x4 g = *(const LAS f32x4*)(kscale + k0 + 4 * q); v[4 * q] *= g[0]; v[4 * q + 1] *= g[1]; v[4 * q + 2] *= g[2]; v[4 * q + 3] *= g[3]; }
    }
    if constexpr (FP8) {
#pragma unroll
        for (int q = 0; q < 8; ++q) o[q] = pk4_fp8(v[4 * q], v[4 * q + 1], v[4 * q + 2], v[4 * q + 3]);
    } else {
#pragma unroll
        for (int q = 0; q < 16; ++q) o[q] = pk2(v[2 * q], v[2 * q + 1]);
    }
    asm volatile("" ::: "memory");
}
template <bool FP8> __device__ __forceinline__ void p0_job(const float* W, int N, unsigned char* WT, int n0, int kq, long drow0, const LAS float* kscale, float mult, LAS float* scr, int lane) {
    const int kr = lane >> 4, c16 = lane & 15;
    const float* src = W + (size_t)(kq * 256 + kr) * N + n0 + 4 * c16;
    f32x4 rr[3][8];
#pragma unroll
    for (int j = 0; j < 8; ++j) rr[0][j] = *(const f32x4*)(src + (size_t)(4 * j) * N);
#pragma unroll
    for (int j = 0; j < 8; ++j) rr[1][j] = *(const f32x4*)(src + (size_t)(32 + 4 * j) * N);
#pragma unroll
    for (int j = 0; j < 8; ++j) rr[2][j] = *(const f32x4*)(src + (size_t)(64 + 4 * j) * N);
    unsigned char* drow = WT + (size_t)(drow0 + lane) * (FP8 ? 1024 : 2048) + (size_t)kq * 256 * (FP8 ? 1 : 2);
    unsigned line[32];
#pragma unroll
    for (int t = 0; t < 8; ++t) {
        f32x4 cur[8];
#pragma unroll
        for (int j = 0; j < 8; ++j) cur[j] = rr[t % 3][j];
        if (t + 3 < 8) {
#pragma unroll
            for (int j = 0; j < 8; ++j) rr[t % 3][j] = *(const f32x4*)(src + (size_t)(32 * (t + 3) + 4 * j) * N);
        }
        unsigned o[16];
        p0_tile<FP8>(cur, o, kq * 256 + 32 * t, kscale, mult, scr, lane);
        if constexpr (FP8) {
#pragma unroll
            for (int q = 0; q < 8; ++q) line[8 * (t & 3) + q] = o[q];
            if ((t & 3) == 3) {
#pragma unroll
                for (int q = 0; q < 8; ++q) *(u32x4*)(drow + 128 * (t >> 2) + 16 * q) = (u32x4){line[4 * q], line[4 * q + 1], line[4 * q + 2], line[4 * q + 3]};
            }
        } else {
#pragma unroll
            for (int q = 0; q < 16; ++q) line[16 * (t & 1) + q] = o[q];
            if ((t & 1) == 1) {
#pragma unroll
                for (int q = 0; q < 8; ++q) *(u32x4*)(drow + 128 * (t >> 1) + 16 * q) = (u32x4){line[4 * q], line[4 * q + 1], line[4 * q + 2], line[4 * q + 3]};
            }
        }
    }
}
__device__ __forceinline__ void moe_one_job(Ctx& F, int r, LAS float* scr, const LAS float* gainl) {
    unsigned char* WGU = F.ws + WS_WGU; unsigned char* WDN = F.ws + WS_WDN;
    constexpr int J_E = 16 * 4;
    const int e = r / (3 * J_E), q = r % (3 * J_E), which = q / J_E, rr = q % J_E, nb = rr & 15, kq = rr >> 4, n0 = nb * 64;
    if (which == 0) p0_job<true>(F.w_gate + (size_t)e * 1048576, 1024, WGU, n0, kq, (long)(e * 8 + (n0 >> 7)) * 256 + (n0 & 127), gainl, W8_SCALE, scr, F.lane);
    else if (which == 1) p0_job<true>(F.w_up + (size_t)e * 1048576, 1024, WGU, n0, kq, (long)(e * 8 + (n0 >> 7)) * 256 + 128 + (n0 & 127), gainl, W8_SCALE, scr, F.lane);
    else p0_job<true>(F.w_down + (size_t)e * 1048576, 1024, WDN, n0, kq, (long)e * 1024 + n0, nullptr, W8_SCALE, scr, F.lane);
}
__device__ __forceinline__ void moe_convert_jobs(Ctx& F, LAS float* scr, const LAS float* gainl) {
    unsigned* ctr = (unsigned*)(F.ws + WS_CTL) + CW_JOB;
    constexpr int NJ = NE * 3 * 64;
    const int nstatic = (F.G * 16 <= NJ) ? F.G * 16 : 0;
    if (F.wave >= 4 && nstatic) { const int j0 = F.bid * 16 + (F.wave - 4);
        for (int r = j0; r < j0 + 16; r += 4) moe_one_job(F, r, scr, gainl); }
    for (;;) {
        unsigned tk = 0; if (F.lane == 0) tk = __hip_atomic_fetch_add(ctr, 2u, __ATOMIC_RELAXED, __HIP_MEMORY_SCOPE_AGENT);
        const int j0 = nstatic + __builtin_amdgcn_readfirstlane((int)tk);
        if (j0 >= NJ) break;
        for (int r = j0; r < j0 + 2; ++r) moe_one_job(F, r, scr, gainl);
    }
}
__device__ __forceinline__ void phase0(Ctx& F) {
    LAS float* scr = (LAS float*)(F.lds + F.wave * 16384);
    const int gw = F.bid * NWAVES + F.wave, NGW = F.G * NWAVES;
    unsigned char* WIN = F.ws + WS_WIN; unsigned char* WOUT = F.ws + WS_WOUT;
    constexpr int J_IN = (INC / 64) * 4, J_OUT = 16 * 4;
    constexpr int NJOBS = J_IN + J_OUT;
    for (int it = gw; it < NJOBS; it += NGW) {
        int r = it;
        if (r < J_IN) { const int nb = r >> 2, kq = r & 3; p0_job<false>(F.w_in, INC, WIN, nb * 64, kq, nb * 64, nullptr, 1.0f, scr, F.lane); continue; } r -= J_IN;
        { const int nb = r >> 2, kq = r & 3; p0_job<false>(F.w_out, 1024, WOUT, nb * 64, kq, nb * 64, nullptr, 1.0f, scr, F.lane); }
    }
    bf16* U = (bf16*)(F.ws + WS_D);
    const f32x4* gr = (const f32x4*)F.mix_gain + F.lane;
    f32x4 g[4];
#pragma unroll
    for (int j = 0; j < 4; ++j) g[j] = gr[64 * j];
    f32x4 nv[4];
    if (gw < NTOK) {
#pragma unroll
        for (int j = 0; j < 4; ++j) nv[j] = ((const f32x4*)(F.x + (size_t)gw * DM) + F.lane)[64 * j];
    }
    for (int m = gw; m < NTOK; m += NGW) {
        f32x4 v[4]; float s = 0.f;
#pragma unroll
        for (int j = 0; j < 4; ++j) v[j] = nv[j];
        if (m + NGW < NTOK) {
#pragma unroll
            for (int j = 0; j < 4; ++j) nv[j] = ((const f32x4*)(F.x + (size_t)(m + NGW) * DM) + F.lane)[64 * j];
        }
#pragma unroll
        for (int j = 0; j < 4; ++j) s += (v[j].x * v[j].x + v[j].y * v[j].y) + (v[j].z * v[j].z + v[j].w * v[j].w);
        const float rstd = 1.0f / sqrtf(wave_sum(s) * (1.f / DM) + EPS);
        unsigned long long* o8 = (unsigned long long*)(U + (size_t)m * DM) + F.lane;
#pragma unroll
        for (int j = 0; j < 4; ++j)
            o8[64 * j] = (unsigned long long)pk2(v[j].x * rstd * g[j].x, v[j].y * rstd * g[j].y) | ((unsigned long long)pk2(v[j].z * rstd * g[j].z, v[j].w * rstd * g[j].w) << 32);
    }
}

struct P1Pol {
    static constexpr bool PERM = true, FP8 = false, GATHER = false;
    const char* A; const char* B; bf16* O; const float* lbl; int G, c, flags;
    __device__ __forceinline__ bool next(int i, gm::Unit& u) const { int pm, pn; if (!gm::order_next(i, G, c, NTOK / 256, INC / 256, pm, pn)) return false;
        u.pm = pm; u.pn = pn; u.A = A + (size_t)pm * 256 * 2048; u.B = B + (size_t)pn * 256 * 2048; u.e = 0; u.rows = 256; return true; }
    __device__ __forceinline__ void a_off(const gm::Unit&, int R0, int C0, int R1, int C1, unsigned (&vo)[2][2]) const {
        vo[0][0] = (unsigned)(R0 * 1024 + C0) * 2u; vo[0][1] = (unsigned)(R1 * 1024 + C1) * 2u; vo[1][0] = vo[0][0] + 128u * 2048u; vo[1][1] = vo[0][1] + 128u * 2048u; }
    __device__ __forceinline__ size_t koff(int t) const { return (size_t)t * 128; }
    template <int TYPE> __device__ __forceinline__ void epi_t(const f32x4 (&acc)[2][2][4][2], const gm::Unit& u, int wr, int wc, int fr, int fq) const {
        const int row0 = u.pm * 256 + wr * 64 + fr, col0 = u.pn * 256 + wc * 32 + 8 * fq;
        f32x4 lbv[2][2];
        if constexpr (TYPE == 1) {
#pragma unroll
            for (int bj = 0; bj < 2; ++bj)
#pragma unroll
                for (int n = 0; n < 2; ++n) { const int c = col0 + bj * 128 + 4 * n - C_HF; const f32x4 a0 = *(const f32x4*)(lbl + c), a1 = *(const f32x4*)(lbl + 512 + c);
#pragma unroll
                    for (int j = 0; j < 4; ++j) lbv[bj][n][j] = sigmoidf_(a0[j] - a1[j]); }
        }
#pragma unroll
        for (int ai = 0; ai < 2; ++ai)
#pragma unroll
            for (int m = 0; m < 4; ++m) { bf16* rowp = O + (size_t)(row0 + ai * 128 + m * 16) * INC + col0;
#pragma unroll
                for (int bj = 0; bj < 2; ++bj) { f32x4 v[2];
#pragma unroll
                    for (int n = 0; n < 2; ++n)
#pragma unroll
                        for (int j = 0; j < 4; ++j) { const float x = acc[ai][bj][m][n][j];
                            if constexpr (TYPE == 0) v[n][j] = x * sigmoidf_(x);
                            else if constexpr (TYPE == 1) { const float lb = lbv[bj][n][j]; v[n][j] = __logf(lb + (1.0f - lb) * sigmoidf_(x)); }
                            else if constexpr (TYPE == 4) v[n][j] = x * 0.125f;
                            else v[n][j] = x; }
                    u32x4 w; w.x = gm::cvt_pk_bf16(v[0][0], v[0][1]); w.y = gm::cvt_pk_bf16(v[0][2], v[0][3]); w.z = gm::cvt_pk_bf16(v[1][0], v[1][1]); w.w = gm::cvt_pk_bf16(v[1][2], v[1][3]);
                    *(u32x4*)(rowp + bj * 128) = w; } }
    }
    __device__ __forceinline__ void acc_init(f32x4 (&acc)[2][2][4][2], const gm::Unit&, int, int, int, int) const { gm::acc_zero(acc); }
    __device__ __forceinline__ void meta_prefetch(const gm::Unit&, LAS unsigned char*, int, int) const {}
    __device__ __forceinline__ void epi(const f32x4 (&acc)[2][2][4][2], const gm::Unit& u, int wr, int wc, int fr, int fq, LAS unsigned char*, int) const {
        if (flags & 1) { if (acc[0][0][0][0][0] == 1.2345e-30f) O[0] = 1; return; }
        const int type = u.pn >> 1;
        if (type == 0 || type == 3) epi_t<0>(acc, u, wr, wc, fr, fq);
        else if (type == 1) epi_t<1>(acc, u, wr, wc, fr, fq);
        else if (type == 4) epi_t<4>(acc, u, wr, wc, fr, fq);
        else epi_t<2>(acc, u, wr, wc, fr, fq);
    }
};
__device__ __forceinline__ void phase1(Ctx& F) {
    P1Pol S{(const char*)(F.ws + WS_D), (const char*)(F.ws + WS_WIN), (bf16*)(F.ws + WS_PROJ), F.lb_logits, F.G, F.vc, F.flags};
    gm::gemm_phase<P1Pol>(F.lds, S);
}

typedef short s16x4 __attribute__((ext_vector_type(4)));
__device__ __forceinline__ s16x4 tr_read(LAS const unsigned char* p) { return __builtin_bit_cast(s16x4, __builtin_amdgcn_ds_read_tr16_b64_v4i16((LAS s16x4*)p)); }
__device__ __forceinline__ bf16x8 cat8(s16x4 a, s16x4 b) { return (bf16x8){a[0], a[1], a[2], a[3], b[0], b[1], b[2], b[3]}; }
__device__ __forceinline__ bf16x8 pack8(f32x4 a, f32x4 b) { u32x4 w; w.x = gm::cvt_pk_bf16(a[0], a[1]); w.y = gm::cvt_pk_bf16(a[2], a[3]); w.z = gm::cvt_pk_bf16(b[0], b[1]); w.w = gm::cvt_pk_bf16(b[2], b[3]); return __builtin_bit_cast(bf16x8, w); }
#define MFMA16(a, b, c) __builtin_amdgcn_mfma_f32_16x16x32_bf16((a), (b), (c), 0, 0, 0)
#define MFMA32(a, b, c) __builtin_amdgcn_mfma_f32_32x32x16_bf16((a), (b), (c), 0, 0, 0)
constexpr int SBV_PITCH = 192, SBV_BYTES = 32 * SBV_PITCH;
__device__ __forceinline__ void sb_attn_fast(Ctx& F) {
    bf16* PROJ = (bf16*)(F.ws + WS_PROJ);
    LAS unsigned char* VT = F.lds + F.wave * SBV_BYTES;
    const int l = F.lane, c = l & 31, hh = l >> 5, i = l & 15, sub = (l >> 4) & 1;
    const int gw = F.bid * 4 + F.wave, NGW = F.G * 4;
    const bool xl = (F.G == 256);
    const int xcd = F.vc & 7, wx = (F.vc >> 3) * 4 + F.wave;
    for (int n = 0; ; ++n) {
        int qt, bh;
        if (xl) { if (n >= 8) break; bh = xcd + 8 * (n >> 1); qt = wx + 128 * (n & 1); }
        else { const int item = gw + n * NGW; if (item >= NBATCH * 8 * (SEQ / 32)) break; qt = item & 255; bh = item >> 8; }
        const int b = bh >> 3, h = bh & 7, t0 = qt * 32;
        const size_t tokbase = (size_t)b * SEQ;
        const bf16* qp = PROJ + (tokbase + t0 + c) * INC + C_SQ + h * 64;
        bf16* mixp = (bf16*)(F.ws + WS_MIX) + (tokbase + t0 + c) * DM + 512 + h * 64;
        bf16x8 qfr[4];
#pragma unroll
        for (int ks = 0; ks < 4; ++ks) qfr[ks] = *(const bf16x8*)(qp + 16 * ks + 8 * hh);
        const bf16* kb = PROJ + tokbase * INC + C_SK + h * 64 + 8 * hh;
        const bf16* vb = PROJ + tokbase * INC + C_SV + h * 64 + (l & 7) * 8;
        f32x16 O0, O1;
#pragma unroll
        for (int r = 0; r < 16; ++r) { O0[r] = 0.f; O1[r] = 0.f; }
        float prun = 1.0f;
        bf16x8 kn[3][4]; u32x4 vn[3][4];
#pragma unroll
        for (int d = 0; d < 3; ++d) { const int sd = (t0 - 32 * d) > 0 ? (t0 - 32 * d) : 0;
#pragma unroll
            for (int ks = 0; ks < 4; ++ks) kn[d][ks] = *(const bf16x8*)(kb + (size_t)(sd + c) * INC + 16 * ks);
#pragma unroll
            for (int q = 0; q < 4; ++q) vn[d][q] = *(const u32x4*)(vb + (size_t)(sd + 8 * q + (l >> 3)) * INC);
            asm volatile("" ::: "memory");
        }
#define ATT_TILE(SV, D) { \
            const int s_ = (SV); const int sn_ = (s_ - 96) > 0 ? (s_ - 96) : 0; \
            asm volatile("" ::: "memory"); \
            _Pragma("unroll") for (int q = 0; q < 4; ++q) *(LAS u32x4*)(VT + (8 * q + (l >> 3)) * SBV_PITCH + (l & 7) * 16) = vn[D][q]; \
            asm volatile("" ::: "memory"); \
            f32x16 z; \
            _Pragma("unroll") for (int r = 0; r < 16; ++r) z[r] = 0.f; \
            _Pragma("unroll") for (int ks = 0; ks < 4; ++ks) z = MFMA32(kn[D][ks], qfr[ks], z); \
            __builtin_amdgcn_sched_barrier(0); \
            _Pragma("unroll") for (int ks = 0; ks < 4; ++ks) kn[D][ks] = *(const bf16x8*)(kb + (size_t)(sn_ + c) * INC + 16 * ks); \
            _Pragma("unroll") for (int q = 0; q < 4; ++q) vn[D][q] = *(const u32x4*)(vb + (size_t)(sn_ + 8 * q + (l >> 3)) * INC); \
              \
            float sg[16], om[16]; \
            _Pragma("unroll") for (int r = 0; r < 16; ++r) { const float e = __builtin_amdgcn_exp2f(-fmaxf(z[r] * 1.44269504f, -120.f)); \
                sg[r] = __builtin_amdgcn_rcpf(1.0f + e); om[r] = e * sg[r]; } \
            if (s_ == t0) {                    \
                _Pragma("unroll") for (int r = 0; r < 16; ++r) { const bool ok = ((r & 3) + 8 * (r >> 2) + 4 * hh) < c; sg[r] = ok ? sg[r] : 0.f; om[r] = ok ? om[r] : 1.0f; } } \
            float gs[4], pg[4]; \
            _Pragma("unroll") for (int q = 0; q < 4; ++q) { gs[q] = (om[4 * q] * om[4 * q + 1]) * (om[4 * q + 2] * om[4 * q + 3]); pg[q] = __shfl_xor(gs[q], 32); } \
            float lgq[4]; float tail = 1.0f; \
            _Pragma("unroll") for (int q = 3; q >= 0; --q) { lgq[q] = tail * (hh == 0 ? pg[q] : 1.0f); tail *= gs[q] * pg[q]; } \
            f32x4 a4[4]; \
            _Pragma("unroll") for (int q = 0; q < 4; ++q) { const float w3 = prun * lgq[q], w2 = w3 * om[4 * q + 3], w1 = w2 * om[4 * q + 2], w0 = w1 * om[4 * q + 1]; \
                a4[q] = (f32x4){sg[4 * q] * w0, sg[4 * q + 1] * w1, sg[4 * q + 2] * w2, sg[4 * q + 3] * w3}; } \
            prun *= tail; \
            const bf16x8 p0 = pack8(a4[0], a4[1]), p1 = pack8(a4[2], a4[3]); \
            asm volatile("" ::: "memory"); \
            _Pragma("unroll") for (int s2 = 0; s2 < 2; ++s2) { const bf16x8 pf = s2 ? p1 : p0; \
                LAS const unsigned char* vr = VT + (16 * s2 + 4 * hh + (i >> 2)) * SBV_PITCH + (16 * sub + 4 * (i & 3)) * 2; \
                const bf16x8 v0 = cat8(tr_read(vr), tr_read(vr + 8 * SBV_PITCH)); \
                const bf16x8 v1 = cat8(tr_read(vr + 64), tr_read(vr + 8 * SBV_PITCH + 64)); \
                O0 = MFMA32(v0, pf, O0); O1 = MFMA32(v1, pf, O1); } \
            asm volatile("" ::: "memory"); }
        for (int s0 = t0; ; s0 -= 96) {
            ATT_TILE(s0, 0)
            if (s0 < 32 || __ballot(prun >= SB_PEXIT) == 0ull) break;
            ATT_TILE(s0 - 32, 1)
            if (s0 < 64 || __ballot(prun >= SB_PEXIT) == 0ull) break;
            ATT_TILE(s0 - 64, 2)
            if (s0 < 96 || __ballot(prun >= SB_PEXIT) == 0ull) break;
        }
#undef ATT_TILE
        float ssq = 0.f;
#pragma unroll
        for (int r = 0; r < 16; ++r) ssq += O0[r] * O0[r] + O1[r] * O1[r];
        ssq += __shfl_xor(ssq, 32);
        const float rn = 1.0f / sqrtf(ssq * (1.f / 64) + EPS);
#pragma unroll
        for (int dt = 0; dt < 2; ++dt)
#pragma unroll
            for (int q = 0; q < 4; ++q) { const int d0 = 32 * dt + 8 * q + 4 * hh; const f32x4 gn = *(const f32x4*)(F.sb_gain + h * 64 + d0);
                const float o0 = (dt ? O1[4 * q] : O0[4 * q]) * rn * gn[0], o1 = (dt ? O1[4 * q + 1] : O0[4 * q + 1]) * rn * gn[1], o2 = (dt ? O1[4 * q + 2] : O0[4 * q + 2]) * rn * gn[2], o3 = (dt ? O1[4 * q + 3] : O0[4 * q + 3]) * rn * gn[3];
                *(u32x2*)(mixp + d0) = (u32x2){gm::cvt_pk_bf16(o0, o1), gm::cvt_pk_bf16(o2, o3)}; }
    }
}
constexpr int HA_SET = 8192 + 9216 + 9216;
__device__ __forceinline__ void hgrn_passA(Ctx& F) {
    const bf16* PROJ = (const bf16*)(F.ws + WS_PROJ);
    float* HST = (float*)(F.ws + WS_HST); float* HDEC = (float*)(F.ws + WS_HDEC);
    const int i = F.lane & 15, g = F.lane >> 4, w = F.wave;
    for (int it = F.bid; it < 256; it += F.G) {
        const int b = it >> 6, h = (it >> 4) & 3, sc = it & 15;
        const size_t rowbase = (size_t)b * SEQ + sc * 512;
        const int row = F.tid >> 4, chunk = F.tid & 15;
        const bf16* gp = PROJ + (rowbase + row) * INC + h * 128 + chunk * 8;
        f32x4 acc[8];
#pragma unroll
        for (int kt = 0; kt < 8; ++kt) acc[kt] = (f32x4){0.f, 0.f, 0.f, 0.f};
        float run = 0.f;
        const int k = F.tid & 127, tq = F.tid >> 7;
        u32x4 nf = *(const u32x4*)(gp + (size_t)15 * 32 * INC + C_HF), nv = *(const u32x4*)(gp + (size_t)15 * 32 * INC + C_HI);
        __syncthreads();
        for (int tl = 15; tl >= 0; --tl) {
            LAS unsigned char* set = F.lds + (tl & 1) * HA_SET;
            LAS unsigned char* RAWF = set; LAS unsigned char* KH = set + 8192; LAS unsigned char* VI = set + 8192 + 9216;
            *(LAS u32x4*)(RAWF + row * 256 + chunk * 16) = nf; *(LAS u32x4*)(VI + row * 288 + chunk * 16) = nv;
            if (tl > 0) { nf = *(const u32x4*)(gp + (size_t)(tl - 1) * 32 * INC + C_HF); nv = *(const u32x4*)(gp + (size_t)(tl - 1) * 32 * INC + C_HI); }
            __syncthreads();
#pragma unroll
            for (int s = 31; s >= 0; --s) { const float lf = bf2f(*(const LAS unsigned short*)(RAWF + s * 256 + k * 2));
                if ((s >> 3) == tq) *(LAS unsigned short*)(KH + s * 288 + k * 2) = (unsigned short)f2bf((1.0f - __expf(lf)) * __expf(run));
                run += lf; }
            __syncthreads();
            const bf16x8 bv = cat8(tr_read(VI + (4 * g + (i >> 2)) * 288 + (16 * w + 4 * (i & 3)) * 2), tr_read(VI + (16 + 4 * g + (i >> 2)) * 288 + (16 * w + 4 * (i & 3)) * 2));
#pragma unroll
            for (int kt = 0; kt < 8; ++kt) {
                const bf16x8 av = cat8(tr_read(KH + (4 * g + (i >> 2)) * 288 + (16 * kt + 4 * (i & 3)) * 2), tr_read(KH + (16 + 4 * g + (i >> 2)) * 288 + (16 * kt + 4 * (i & 3)) * 2));
                acc[kt] = MFMA16(av, bv, acc[kt]); }
        }
        float* hp = HST + (size_t)it * 16384;
#pragma unroll
        for (int kt = 0; kt < 8; ++kt) *(f32x4*)(hp + ((w * 8 + kt) * 64 + F.lane) * 4) = acc[kt];
        if (tq == 0) HDEC[it * 128 + k] = __expf(run);
        __syncthreads();
    }
}
__device__ __forceinline__ void hgrn_passB(Ctx& F) {
    float* HST = (float*)(F.ws + WS_HST); const float* HDEC = (const float*)(F.ws + WS_HDEC);
    for (int u = F.bid; u < 256; u += F.G) {
        const int bh = u >> 4, part = u & 15;
        const int e = part * 1024 + F.tid * 2;
        const int kk = 16 * ((e >> 8) & 7) + 4 * (((e >> 2) & 63) >> 4) + (e & 3);
        f32x2 L[16]; f32x2 D[16];
#pragma unroll
        for (int sc = 0; sc < 16; ++sc) { L[sc] = *(const f32x2*)(HST + (size_t)(bh * 16 + sc) * 16384 + e); D[sc] = *(const f32x2*)(HDEC + (bh * 16 + sc) * 128 + kk); }
        f32x2 S = (f32x2){0.f, 0.f};
#pragma unroll
        for (int sc = 0; sc < 16; ++sc) { *(f32x2*)(HST + (size_t)(bh * 16 + sc) * 16384 + e) = S; S = S * D[sc] + L[sc]; }
    }
}
constexpr int HC_RAWF = 0, HC_RAWQ = 4096, HC_QH = 8192, HC_KT = HC_QH + 4352, HC_V = HC_KT + 4352, HC_G = HC_V + 4608, HC_DK = HC_G + 4352, HC_PART = HC_DK + 512, HC_SET = HC_PART + 512;
#define PASSC_ITER(ITR, D) do { const int itr = (ITR); \
            if (mfw) { \
                if (itr >= 1 && itr <= 32) { const int st = itr - 1; const LAS unsigned char* set = F.lds + (st & 3) * HC_SET; \
                    float tot = 0.f; \
                _Pragma("unroll") \
                    for (int ww = 0; ww < 8; ++ww) tot += *(const LAS float*)(set + HC_PART + (ww * 16 + i) * 4); \
                    const float rs = 1.0f / sqrtf(tot * (1.f / 128) + EPS); \
                _Pragma("unroll") \
                    for (int u = 0; u < 2; ++u) { const int vt = 2 * w + u; \
                        const u32x2 gi = *(const LAS u32x2*)(set + HC_G + i * 272 + (16 * vt + 4 * g) * 2); \
                        u32x2 o; o.x = gm::cvt_pk_bf16(oT[u][0] * rs * gain[u][0] * bflo(gi.x), oT[u][1] * rs * gain[u][1] * bfhi(gi.x)); o.y = gm::cvt_pk_bf16(oT[u][2] * rs * gain[u][2] * bflo(gi.y), oT[u][3] * rs * gain[u][3] * bfhi(gi.y)); \
                        *(u32x2*)((bf16*)(F.ws + WS_MIX) + (rowbase + st * 16 + i) * DM + h * 128 + 16 * vt + 4 * g) = o; } } \
                if (itr >= 0 && itr < 32) { LAS unsigned char* set = F.lds + (itr & 3) * HC_SET; \
                    bf16x8 qf[4]; \
                    f32x4 pT = (f32x4){0.f, 0.f, 0.f, 0.f}; \
                _Pragma("unroll") \
                    for (int ks = 0; ks < 4; ++ks) { \
                        qf[ks] = cat8(*(const LAS s16x4*)(set + HC_QH + i * 272 + (32 * ks + 4 * g) * 2), *(const LAS s16x4*)(set + HC_QH + i * 272 + (32 * ks + 16 + 4 * g) * 2)); \
                        const bf16x8 kf = cat8(*(const LAS s16x4*)(set + HC_KT + i * 272 + (32 * ks + 4 * g) * 2), *(const LAS s16x4*)(set + HC_KT + i * 272 + (32 * ks + 16 + 4 * g) * 2)); \
                        pT = MFMA16(kf, qf[ks], pT); } \
                _Pragma("unroll") \
                    for (int r = 0; r < 4; ++r) pT[r] = (4 * g + r <= i) ? pT[r] : 0.f; \
                    const s16x4 z4 = (s16x4){0, 0, 0, 0}; \
                    const bf16x8 pf = pack8(pT, (f32x4){0.f, 0.f, 0.f, 0.f}); \
                    bf16x8 vf[2]; \
                _Pragma("unroll") \
                    for (int u = 0; u < 2; ++u) { const int vt = 2 * w + u; \
                        vf[u] = cat8(tr_read(set + HC_V + (4 * g + (i >> 2)) * 288 + (16 * vt + 4 * (i & 3)) * 2), z4); \
                        oT[u] = MFMA16(vf[u], pf, ((f32x4){0.f, 0.f, 0.f, 0.f})); \
                _Pragma("unroll") \
                        for (int ks = 0; ks < 4; ++ks) oT[u] = MFMA16(pack8(acc[u][2 * ks], acc[u][2 * ks + 1]), qf[ks], oT[u]); } \
                _Pragma("unroll") \
                    for (int kt = 0; kt < 8; ++kt) { const bf16x8 ak = cat8(tr_read(set + HC_KT + (4 * g + (i >> 2)) * 272 + (16 * kt + 4 * (i & 3)) * 2), z4); \
                        const f32x4 dk = *(const LAS f32x4*)(set + HC_DK + (16 * kt + 4 * g) * 4); \
                _Pragma("unroll") \
                        for (int u = 0; u < 2; ++u) { acc[u][kt] = MFMA16(ak, vf[u], acc[u][kt]); acc[u][kt] = acc[u][kt] * dk; } } \
                _Pragma("unroll") \
                    for (int u = 0; u < 2; ++u) { float ssq = (oT[u][0] * oT[u][0] + oT[u][1] * oT[u][1]) + (oT[u][2] * oT[u][2] + oT[u][3] * oT[u][3]); \
                        ssq += __shfl_xor(ssq, 16); ssq += __shfl_xor(ssq, 32); \
                        if (g == 0) *(LAS float*)(set + HC_PART + ((2 * w + u) * 16 + i) * 4) = ssq; } } \
            } else { \
                if (itr + 1 >= 0 && itr + 1 < 32) { LAS unsigned char* set = F.lds + ((itr + 1) & 3) * HC_SET; \
                    float run = 0.f; \
                _Pragma("unroll") \
                    for (int s2 = 0; s2 < 16; ++s2) { const float lf = bf2f(*(const LAS unsigned short*)(set + HC_RAWF + s2 * 256 + k * 2)); run += lf; \
                        if ((s2 >> 3) == tq) { const float qv = bf2f(*(const LAS unsigned short*)(set + HC_RAWQ + s2 * 256 + k * 2)); \
                            *(LAS unsigned short*)(set + HC_QH + s2 * 272 + k * 2) = (unsigned short)f2bf(qv * __expf(run)); \
                            *(LAS unsigned short*)(set + HC_KT + s2 * 272 + k * 2) = (unsigned short)f2bf((1.0f - __expf(lf)) * __expf(fminf(-run, 80.f))); } } \
                    if (tq == 0) *(LAS float*)(set + HC_DK + k * 4) = __expf(run); } \
                if (itr + 2 < 32) { LAS unsigned char* set = F.lds + ((itr + 2) & 3) * HC_SET; \
                    *(LAS u32x4*)(set + HC_RAWF + row * 256 + chunk * 16) = pfq[D][0]; *(LAS u32x4*)(set + HC_RAWQ + row * 256 + chunk * 16) = pfq[D][1]; \
                    *(LAS u32x4*)(set + HC_V + row * 288 + chunk * 16) = pfq[D][2]; *(LAS u32x4*)(set + HC_G + row * 272 + chunk * 16) = pfq[D][3]; } \
            } \
            { const int pst = (itr + 5 < 32) ? itr + 5 : 31; const bf16* gq = gp + (size_t)pst * 16 * INC;     pfq[D][0] = *(const u32x4*)(gq + C_HF); pfq[D][1] = *(const u32x4*)(gq + C_HQ); pfq[D][2] = *(const u32x4*)(gq + C_HI); pfq[D][3] = *(const u32x4*)(gq + C_HG); } \
            __syncthreads(); } while (0)
__device__ __forceinline__ void hgrn_passC(Ctx& F) {
    bf16* PROJ = (bf16*)(F.ws + WS_PROJ);
    const float* HST = (const float*)(F.ws + WS_HST);
    const int i = F.lane & 15, g = F.lane >> 4, w = F.wave;
    const bool mfw = (w < 4);
    for (int it = F.bid; it < 256; it += F.G) {
        const int b = it >> 6, h = (it >> 4) & 3, sc = it & 15;
        const size_t rowbase = (size_t)b * SEQ + sc * 512;
        const int t = F.tid & 255, row = t >> 4, chunk = t & 15;
        const bf16* gp = PROJ + (rowbase + row) * INC + h * 128 + chunk * 8;
        u32x4 pfq[3][4];
#pragma unroll
        for (int d = 0; d < 3; ++d)
#pragma unroll
            for (int q = 0; q < 4; ++q) pfq[d][q] = (u32x4){0u, 0u, 0u, 0u};
        {
#pragma unroll
            for (int d = 0; d < 3; ++d) { const bf16* gq = gp + (size_t)d * 16 * INC; pfq[d][0] = *(const u32x4*)(gq + C_HF); pfq[d][1] = *(const u32x4*)(gq + C_HQ); pfq[d][2] = *(const u32x4*)(gq + C_HI); pfq[d][3] = *(const u32x4*)(gq + C_HG); } }
        f32x4 gain[2]; f32x4 acc[2][8]; f32x4 oT[2];
#pragma unroll
        for (int u = 0; u < 2; ++u) { gain[u] = *(const f32x4*)(F.hg_gain + h * 128 + 16 * ((2 * w + u) & 7) + 4 * g); oT[u] = (f32x4){0.f, 0.f, 0.f, 0.f};
#pragma unroll
            for (int kt = 0; kt < 8; ++kt) acc[u][kt] = (f32x4){0.f, 0.f, 0.f, 0.f}; }
        if (mfw) {
#pragma unroll
            for (int u = 0; u < 2; ++u)
#pragma unroll
                for (int kt = 0; kt < 8; ++kt) acc[u][kt] = *(const f32x4*)(HST + (size_t)it * 16384 + (((2 * w + u) * 8 + kt) * 64 + F.lane) * 4);
        }
        const int k = t & 127, tq = t >> 7;
        __syncthreads();
        for (int base = -2; base <= 32; base += 3) { PASSC_ITER(base, 0); PASSC_ITER(base + 1, 1); PASSC_ITER(base + 2, 2); }
    }
}
#undef PASSC_ITER

struct P3Pol {
    static constexpr bool PERM = true, FP8 = false, GATHER = false;
    const char* A; const char* B; const float* x; bf16* h1b; unsigned char* h1q; int G, c, flags;
    __device__ __forceinline__ bool next(int i, gm::Unit& u) const { int pm, pn; if (!gm::order_next(i, G, c, NTOK / 256, 4, pm, pn)) return false;
        u.pm = pm; u.pn = pn; u.A = A + (size_t)pm * 256 * 2048; u.B = B + (size_t)pn * 256 * 2048; u.e = 0; u.rows = 256; return true; }
    __device__ __forceinline__ void a_off(const gm::Unit&, int R0, int C0, int R1, int C1, unsigned (&vo)[2][2]) const {
        vo[0][0] = (unsigned)(R0 * 1024 + C0) * 2u; vo[0][1] = (unsigned)(R1 * 1024 + C1) * 2u; vo[1][0] = vo[0][0] + 128u * 2048u; vo[1][1] = vo[0][1] + 128u * 2048u; }
    __device__ __forceinline__ size_t koff(int t) const { return (size_t)t * 128; }
    __device__ __forceinline__ void acc_init(f32x4 (&acc)[2][2][4][2], const gm::Unit& u, int wr, int wc, int fr, int fq) const {
        const int row0 = u.pm * 256 + wr * 64 + fr, col0 = u.pn * 256 + wc * 32 + 8 * fq;
#pragma unroll
        for (int ai = 0; ai < 2; ++ai)
#pragma unroll
            for (int m = 0; m < 4; ++m) { const float* xp = x + (size_t)(row0 + ai * 128 + m * 16) * DM + col0;
#pragma unroll
                for (int bj = 0; bj < 2; ++bj) { acc[ai][bj][m][0] = *(const f32x4*)(xp + bj * 128); acc[ai][bj][m][1] = *(const f32x4*)(xp + bj * 128 + 4); } }
#pragma unroll
        for (int ai = 0; ai < 2; ++ai)
#pragma unroll
            for (int m = 0; m < 4; ++m)
#pragma unroll
                for (int bj = 0; bj < 2; ++bj) asm volatile("" : "+v"(acc[ai][bj][m][0]), "+v"(acc[ai][bj][m][1]));
    }
    __device__ __forceinline__ void meta_prefetch(const gm::Unit&, LAS unsigned char*, int, int) const {}
    __device__ __forceinline__ void epi(const f32x4 (&acc)[2][2][4][2], const gm::Unit& u, int wr, int wc, int fr, int fq, LAS unsigned char*, int) const {
        if (flags & 2) { if (acc[0][0][0][0][0] == 1.2345e-30f) h1q[0] = 1; return; }
        const int row0 = u.pm * 256 + wr * 64 + fr, col0 = u.pn * 256 + wc * 32 + 8 * fq;
#pragma unroll
        for (int ai = 0; ai < 2; ++ai)
#pragma unroll
            for (int m = 0; m < 4; ++m) { const size_t off = (size_t)(row0 + ai * 128 + m * 16) * DM + col0;
#pragma unroll
                for (int bj = 0; bj < 2; ++bj) { const f32x4 v0 = acc[ai][bj][m][0], v1 = acc[ai][bj][m][1];
                    u32x4 w; w.x = gm::cvt_pk_bf16(v0[0], v0[1]); w.y = gm::cvt_pk_bf16(v0[2], v0[3]); w.z = gm::cvt_pk_bf16(v1[0], v1[1]); w.w = gm::cvt_pk_bf16(v1[2], v1[3]);
                    *(u32x4*)(h1b + off + bj * 128) = w;
                    *(u32x2*)(h1q + off + bj * 128) = (u32x2){pk4_fp8(v0[0], v0[1], v0[2], v0[3]), pk4_fp8(v1[0], v1[1], v1[2], v1[3])}; } }
    }
};
__device__ __forceinline__ void phase3(Ctx& F) {
    P3Pol S{(const char*)(F.ws + WS_MIX), (const char*)(F.ws + WS_WOUT), F.x, (bf16*)(F.ws + WS_H1B), F.ws + WS_H1Q, F.G, F.vc, F.flags};
    gm::gemm_phase<P3Pol>(F.lds, S);
}

__device__ __forceinline__ void phase_router_fast(Ctx& F) {
    LAS float* W4 = (LAS float*)F.lds;
    LAS unsigned char* M = F.lds + MISC_OFF + 1024;
    LAS float* rsd = (LAS float*)M; LAS int* sel_e = (LAS int*)(M + 512); LAS float* sel_g = (LAS float*)(M + 2560); LAS int* lpos = (LAS int*)(M + 4608); LAS int* hist = (LAS int*)(M + 6656); LAS int* base = hist + 32;
    unsigned* cnt = (unsigned*)(F.ws + WS_CTL) + CW_CNT;
    int* STOK = (int*)(F.ws + WS_STOK); float* SGATE = (float*)(F.ws + WS_SGATE); float* SRSTD = (float*)(F.ws + WS_SRSTD);
    for (int idx = F.tid; idx < 1024 * NE; idx += NTHR) { const int k = idx >> 5, e = idx & 31; W4[((k >> 2) * 32 + e) * 4 + (k & 3)] = F.w_router[idx] * F.ffn_gain[k]; }
    for (int tb = F.bid; tb < NTOK / 128; tb += F.G) {
        const int tok0 = tb * 128;
        __syncthreads();
        if (F.tid < 32) hist[F.tid] = 0;
        if (F.wave < 4) {
            const int j = F.lane & 31, h = F.lane >> 5, tok = tok0 + F.wave * 32 + j;
            const bf16* hp = (const bf16*)(F.ws + WS_H1B) + (size_t)tok * DM + 4 * h;
            f32x16 acc;
#pragma unroll
            for (int r = 0; r < 16; ++r) acc[r] = 0.f;
            float ssq = 0.f;
            u32x2 pre[8];
#pragma unroll
            for (int q = 0; q < 8; ++q) pre[q] = *(const u32x2*)(hp + 8 * q);
            for (int m0 = 0; m0 < 128; m0 += 8) {
                u32x2 cur[8];
#pragma unroll
                for (int q = 0; q < 8; ++q) cur[q] = pre[q];
                if (m0 + 8 < 128) {
#pragma unroll
                    for (int q = 0; q < 8; ++q) pre[q] = *(const u32x2*)(hp + 8 * (m0 + 8 + q));
                }
#pragma unroll
                for (int q = 0; q < 8; ++q) { const f32x4 wv = *(const LAS f32x4*)(W4 + ((2 * (m0 + q) + h) * 32 + j) * 4); const f32x4 a = (f32x4){bflo(cur[q].x), bfhi(cur[q].x), bflo(cur[q].y), bfhi(cur[q].y)};
                    ssq += (a[0] * a[0] + a[1] * a[1]) + (a[2] * a[2] + a[3] * a[3]);
#pragma unroll
                    for (int c = 0; c < 4; ++c) acc = __builtin_amdgcn_mfma_f32_32x32x2f32(wv[c], a[c], acc, 0, 0, 0); }
            }
            ssq += __shfl_xor(ssq, 32);
            const float rstd = 1.0f / sqrtf(ssq * (1.f / DM) + EPS);
            float lg[16];
#pragma unroll
            for (int r = 0; r < 16; ++r) lg[r] = acc[r] * rstd + F.b_router[(r & 3) + 8 * (r >> 2) + 4 * h];
            float v[8]; int id[8]; unsigned used = 0u;
#pragma unroll
            for (int k = 0; k < 4; ++k) { float best = -3.0e38f; int bi = 0, br = 0;
#pragma unroll
                for (int r = 0; r < 16; ++r) { const bool c = !((used >> r) & 1u) && lg[r] > best; best = c ? lg[r] : best; bi = c ? ((r & 3) + 8 * (r >> 2) + 4 * h) : bi; br = c ? r : br; }
                used |= 1u << br; v[k] = best; id[k] = bi; }
#pragma unroll
            for (int k = 0; k < 4; ++k) { v[4 + k] = __shfl_xor(v[k], 32); id[4 + k] = __shfl_xor(id[k], 32); }
            float tv[4]; int ti[4]; unsigned u2 = 0u;
#pragma unroll
            for (int k = 0; k < 4; ++k) { float best = -3.0e38f; int bi = 1 << 30, bc = 0;
#pragma unroll
                for (int c8 = 0; c8 < 8; ++c8) { const bool c = !((u2 >> c8) & 1u) && (v[c8] > best || (v[c8] == best && id[c8] < bi)); best = c ? v[c8] : best; bi = c ? id[c8] : bi; bc = c ? c8 : bc; }
                u2 |= 1u << bc; tv[k] = best; ti[k] = bi; }
            float den = 0.f, pr[4];
#pragma unroll
            for (int k = 0; k < 4; ++k) { pr[k] = __expf(tv[k] - tv[0]); den += pr[k]; }
            const float rden = 1.0f / den;
            if (h == 0) { const int tl = F.wave * 32 + j; rsd[tl] = rstd;
#pragma unroll
                for (int k = 0; k < 4; ++k) { sel_e[tl * 4 + k] = ti[k]; sel_g[tl * 4 + k] = pr[k] * rden; } }
        }
        __syncthreads();
        if (F.tid < 128) {
#pragma unroll
            for (int k = 0; k < 4; ++k) lpos[F.tid * 4 + k] = atomicAdd((int*)&hist[sel_e[F.tid * 4 + k]], 1); }
        __syncthreads();
        if (F.tid < 32) base[F.tid] = (int)__hip_atomic_fetch_add(&cnt[64 * F.tid], (unsigned)hist[F.tid], __ATOMIC_RELAXED, __HIP_MEMORY_SCOPE_AGENT);
        __syncthreads();
        if (F.tid < 128) {
#pragma unroll
            for (int k = 0; k < 4; ++k) { const int e = sel_e[F.tid * 4 + k]; const size_t sl = (size_t)e * ECAP + base[e] + lpos[F.tid * 4 + k];
                STOK[sl] = (tok0 + F.tid) * 4 + k; SGATE[sl] = sel_g[F.tid * 4 + k]; SRSTD[sl] = rsd[F.tid]; } }
    }
    __syncthreads();
}

struct RbTab { LAS int* e; LAS int* start; LAS int* rows; LAS int* off; int nrb; };
__device__ __forceinline__ RbTab build_rbtab(Ctx& F) {
    RbTab T; LAS int* m = (LAS int*)(F.lds + MISC_OFF + 1024);
    T.e = m; T.start = m + 640; T.rows = m + 1280; T.off = m + 1920;
    LAS int* nrbp = m + 1920 + 64;
    const unsigned* cnt = (const unsigned*)(F.ws + WS_CTL) + CW_CNT;
    __syncthreads();
    if (F.tid == 0) { int off = 0, rb = 0;
        for (int e = 0; e < NE; ++e) { const int c = (int)__hip_atomic_load(&cnt[64 * e], __ATOMIC_RELAXED, __HIP_MEMORY_SCOPE_AGENT); T.off[e] = off;
            for (int i = 0; i * 256 < c; ++i) { T.e[rb] = e; T.start[rb] = i * 256; T.rows[rb] = (c - i * 256) < 256 ? (c - i * 256) : 256; ++rb; }
            off += c; }
        T.off[NE] = off; *nrbp = rb; }
    __syncthreads();
    T.nrb = *nrbp;
    return T;
}

__device__ __forceinline__ float swiglu_(float hg, float hu) {
    hg = fminf(hg, SW_LIMIT); hu = fminf(fmaxf(hu, -SW_LIMIT), SW_LIMIT);
    return (hu + 1.0f) * (hg * sigmoidf_(SW_ALPHA * hg));
}
struct P4Pol {
    static constexpr bool PERM = true, FP8 = true, GATHER = true;
    const char* A; const char* B; unsigned char* hid; const int* stok; const float* srstd; const float* bg; const float* bu; RbTab T; int G, c, flags;
    __device__ __forceinline__ bool next(int i, gm::Unit& u) const { int pm, pn; if (!gm::order_next(i, G, c, T.nrb, 8, pm, pn)) return false;
        u.pm = pm; u.pn = pn; u.e = __builtin_amdgcn_readfirstlane(T.e[pm]); u.rows = __builtin_amdgcn_readfirstlane(T.rows[pm]); u.A = A; u.B = B + ((size_t)(u.e * 8 + pn) * 256) * 1024; return true; }
    __device__ __forceinline__ void a_off(const gm::Unit& u, int R0, int C0, int R1, int C1, unsigned (&vo)[2][2]) const {
        const int* lst = stok + (size_t)u.e * ECAP + T.start[u.pm];
#pragma unroll
        for (int h = 0; h < 2; ++h) { int r0 = R0 + 128 * h, r1 = R1 + 128 * h; r0 = r0 < u.rows ? r0 : 0; r1 = r1 < u.rows ? r1 : 0;
            vo[h][0] = (unsigned)(lst[r0] >> 2) * 1024u + (unsigned)C0 * 2u; vo[h][1] = (unsigned)(lst[r1] >> 2) * 1024u + (unsigned)C1 * 2u; }
    }
    __device__ __forceinline__ void idx_prefetch(const gm::Unit& u, LAS unsigned char* lds, int wid) const {
        if (wid < 4) { const int* lst = stok + (size_t)u.e * ECAP + __builtin_amdgcn_readfirstlane(T.start[u.pm]) + wid * 64 + (threadIdx.x & 63);
            __builtin_amdgcn_global_load_lds((const unsigned*)lst, (LAS unsigned*)(lds + IDX_OFF + wid * 256), 4, 0, 0); } }
    __device__ __forceinline__ void a_off_lds(const gm::Unit& u, int, int, int, int, LAS unsigned char* lds, unsigned (&vo)[2][2]) const {
        const LAS int* ib = (const LAS int*)(lds + IDX_OFF);
        int tq = threadIdx.x; asm volatile("" : "+v"(tq));
        int R0, C0, R1, C1; gm::stage_rc(tq * 16, R0, C0); gm::stage_rc(tq * 16 + 8192, R1, C1);
#pragma unroll
        for (int h = 0; h < 2; ++h) { int r0 = R0 + 128 * h, r1 = R1 + 128 * h; r0 = r0 < u.rows ? r0 : 0; r1 = r1 < u.rows ? r1 : 0;
            vo[h][0] = (unsigned)(ib[r0] >> 2) * 1024u + (unsigned)C0 * 2u; vo[h][1] = (unsigned)(ib[r1] >> 2) * 1024u + (unsigned)C1 * 2u; }
    }
    __device__ __forceinline__ size_t koff(int t) const { return (size_t)t * 128; }
    __device__ __forceinline__ void acc_init(f32x4 (&acc)[2][2][4][2], const gm::Unit&, int, int, int, int) const { gm::acc_zero(acc); }
    __device__ __forceinline__ void meta_prefetch(const gm::Unit& u, LAS unsigned char* lds, int wid, int ui) const {
        LAS unsigned char* mb = lds + META_OFF + (ui & 1) * META_BYTES; const int ln = threadIdx.x & 63;
        const float* src = (wid < 4) ? srstd + (size_t)u.e * ECAP + __builtin_amdgcn_readfirstlane(T.start[u.pm]) + wid * 64 + ln
                                     : ((wid < 6) ? bg : bu) + u.e * DFF + u.pn * 128 + (wid & 1) * 64 + ln;
        __builtin_amdgcn_global_load_lds((const unsigned*)src, (LAS unsigned*)(mb + wid * 256), 4, 0, 0);
    }
    __device__ __forceinline__ void epi(const f32x4 (&acc)[2][2][4][2], const gm::Unit& u, int wr, int wc, int fr, int fq, LAS unsigned char* lds, int ui) const {
        if (flags & 4) { if (acc[0][0][0][0][0] == 1.2345e-30f) hid[0] = 1; return; }
        const LAS unsigned char* mb = lds + META_OFF + (ui & 1) * META_BYTES;
        const size_t grow = (size_t)T.off[u.e] + T.start[u.pm];
        const int jl = wc * 32 + 8 * fq, j0 = u.pn * 128 + jl;
        const f32x4 bg0 = *(const LAS f32x4*)(mb + 1024 + jl * 4), bg1 = *(const LAS f32x4*)(mb + 1024 + jl * 4 + 16), bu0 = *(const LAS f32x4*)(mb + 1536 + jl * 4), bu1 = *(const LAS f32x4*)(mb + 1536 + jl * 4 + 16);
#pragma unroll
        for (int ai = 0; ai < 2; ++ai)
#pragma unroll
            for (int m = 0; m < 4; ++m) { const int r = ai * 128 + wr * 64 + m * 16 + fr;
                if (r < u.rows) { const float rs = *(const LAS float*)(mb + r * 4) * W8_INV;
                    const f32x4 g0 = acc[ai][0][m][0] * rs + bg0, g1 = acc[ai][0][m][1] * rs + bg1, u0 = acc[ai][1][m][0] * rs + bu0, u1 = acc[ai][1][m][1] * rs + bu1;
                    *(u32x2*)(hid + (grow + r) * DFF + j0) = (u32x2){pk4_fp8(swiglu_(g0[0], u0[0]), swiglu_(g0[1], u0[1]), swiglu_(g0[2], u0[2]), swiglu_(g0[3], u0[3])),
                                                                     pk4_fp8(swiglu_(g1[0], u1[0]), swiglu_(g1[1], u1[1]), swiglu_(g1[2], u1[2]), swiglu_(g1[3], u1[3]))}; } }
    }
};
__device__ __forceinline__ void phase_gateup(Ctx& F) {
    RbTab T = build_rbtab(F);
    P4Pol S{(const char*)(F.ws + WS_H1Q), (const char*)(F.ws + WS_WGU), F.ws + WS_HID, (const int*)(F.ws + WS_STOK), (const float*)(F.ws + WS_SRSTD), F.b_gate, F.b_up, T, F.G, F.vc, F.flags};
    gm::gemm_phase<P4Pol>(F.lds, S);
}

struct P5Pol {
    static constexpr bool PERM = true, FP8 = true, GATHER = false;
    const char* A; const char* B; const int* stok; const float* sgate; const float* bd; unsigned char* y; int* tslot; RbTab T; int G, c, flags;
    __device__ __forceinline__ bool next(int i, gm::Unit& u) const { int pm, pn; if (!gm::order_next(i, G, c, T.nrb, 4, pm, pn)) return false;
        u.pm = pm; u.pn = pn; u.e = __builtin_amdgcn_readfirstlane(T.e[pm]); u.rows = __builtin_amdgcn_readfirstlane(T.rows[pm]);
        const int grow = __builtin_amdgcn_readfirstlane(T.off[u.e] + T.start[pm]); u.A = A + (size_t)grow * 1024; u.B = B + ((size_t)u.e * 1024 + pn * 256) * 1024; return true; }
    __device__ __forceinline__ void a_off(const gm::Unit&, int R0, int C0, int R1, int C1, unsigned (&vo)[2][2]) const {
        vo[0][0] = (unsigned)(R0 * 1024 + C0 * 2); vo[0][1] = (unsigned)(R1 * 1024 + C1 * 2); vo[1][0] = vo[0][0] + 128u * 1024u; vo[1][1] = vo[0][1] + 128u * 1024u; }
    __device__ __forceinline__ size_t koff(int t) const { return (size_t)t * 128; }
    __device__ __forceinline__ void acc_init(f32x4 (&acc)[2][2][4][2], const gm::Unit&, int, int, int, int) const { gm::acc_zero(acc); }
    __device__ __forceinline__ void meta_prefetch(const gm::Unit& u, LAS unsigned char* lds, int wid, int ui) const {
        LAS unsigned char* mb = lds + META_OFF + (ui & 1) * META_BYTES; const int ln = threadIdx.x & 63;
        const size_t sb = (size_t)u.e * ECAP + __builtin_amdgcn_readfirstlane(T.start[u.pm]) + (wid & 3) * 64 + ln;
        const unsigned* src = (wid < 4) ? (const unsigned*)(stok + sb) : (const unsigned*)(sgate + sb);
        __builtin_amdgcn_global_load_lds(src, (LAS unsigned*)(mb + wid * 256), 4, 0, 0);
        if (wid < 4) __builtin_amdgcn_global_load_lds((const unsigned*)(bd + u.e * DM + u.pn * 256 + wid * 64 + ln), (LAS unsigned*)(mb + 2048 + wid * 256), 4, 0, 0);
    }
    __device__ __forceinline__ void epi(const f32x4 (&acc)[2][2][4][2], const gm::Unit& u, int wr, int wc, int fr, int fq, LAS unsigned char* lds, int ui) const {
        if (flags & 8) { if (acc[0][0][0][0][0] == 1.2345e-30f) y[0] = 1; return; }
        const LAS unsigned char* mb = lds + META_OFF + (ui & 1) * META_BYTES;
        const int cl = wc * 32 + 8 * fq, col0 = u.pn * 256 + cl; const size_t grow = (size_t)T.off[u.e] + T.start[u.pm];
        f32x4 bv[2][2];
#pragma unroll
        for (int bj = 0; bj < 2; ++bj) { bv[bj][0] = *(const LAS f32x4*)(mb + 2048 + (bj * 128 + cl) * 4); bv[bj][1] = *(const LAS f32x4*)(mb + 2048 + (bj * 128 + cl) * 4 + 16); }
#pragma unroll
        for (int ai = 0; ai < 2; ++ai)
#pragma unroll
            for (int m = 0; m < 4; ++m) { const int r = ai * 128 + wr * 64 + m * 16 + fr;
                if (r < u.rows) { const int tr = *(const LAS int*)(mb + r * 4); const float gt = *(const LAS float*)(mb + 1024 + r * 4) * Y8_SCALE, gw = gt * W8_INV;
                    unsigned char* p = y + (grow + r) * DM + col0;
                    if (u.pn == 0 && wc == 0 && fq == 0) tslot[tr] = (int)(grow + r);
#pragma unroll
                    for (int bj = 0; bj < 2; ++bj) { const f32x4 v0 = acc[ai][bj][m][0] * gw + bv[bj][0] * gt, v1 = acc[ai][bj][m][1] * gw + bv[bj][1] * gt;
                        *(u32x2*)(p + bj * 128) = (u32x2){pk4_fp8(v0[0], v0[1], v0[2], v0[3]), pk4_fp8(v1[0], v1[1], v1[2], v1[3])}; } } }
    }
};
__device__ __forceinline__ void phase_down(Ctx& F) {
    RbTab T = build_rbtab(F);
    P5Pol S{(const char*)(F.ws + WS_HID), (const char*)(F.ws + WS_WDN), (const int*)(F.ws + WS_STOK), (const float*)(F.ws + WS_SGATE), F.b_down, F.ws + WS_Y, (int*)(F.ws + WS_TSLOT), T, F.G, F.vc, F.flags};
    gm::gemm_phase<P5Pol>(F.lds, S);
}

__device__ __forceinline__ void phase_final(Ctx& F) {
    const int gw = F.bid * NWAVES + F.wave, NGW = F.G * NWAVES;
    const unsigned char* Y = F.ws + WS_Y; const int* TS = (const int*)(F.ws + WS_TSLOT);
    for (int m = gw; m < NTOK; m += NGW) {
        f32x4* xr = (f32x4*)(F.out + (size_t)m * DM) + F.lane; const f32x4* gr = (const f32x4*)F.fin_gain + F.lane;
        const u32x2* hr = (const u32x2*)((const bf16*)(F.ws + WS_H1B) + (size_t)m * DM) + F.lane;
        const int s0 = __builtin_amdgcn_readfirstlane(TS[m * 4]), s1 = __builtin_amdgcn_readfirstlane(TS[m * 4 + 1]), s2 = __builtin_amdgcn_readfirstlane(TS[m * 4 + 2]), s3 = __builtin_amdgcn_readfirstlane(TS[m * 4 + 3]);
        const unsigned* y0 = (const unsigned*)(Y + (size_t)s0 * DM) + F.lane; const unsigned* y1 = (const unsigned*)(Y + (size_t)s1 * DM) + F.lane;
        const unsigned* y2 = (const unsigned*)(Y + (size_t)s2 * DM) + F.lane; const unsigned* y3 = (const unsigned*)(Y + (size_t)s3 * DM) + F.lane;
        f32x4 v[4]; float s = 0.f;
#pragma unroll
        for (int j = 0; j < 4; ++j) { const u32x2 hb = hr[64 * j]; v[j] = (f32x4){bflo(hb.x), bfhi(hb.x), bflo(hb.y), bfhi(hb.y)}; const unsigned a = y0[64 * j], b = y1[64 * j], c = y2[64 * j], d = y3[64 * j];
            const f32x2 al = __builtin_amdgcn_cvt_pk_f32_fp8((int)a, false), ah = __builtin_amdgcn_cvt_pk_f32_fp8((int)a, true), bl = __builtin_amdgcn_cvt_pk_f32_fp8((int)b, false), bh = __builtin_amdgcn_cvt_pk_f32_fp8((int)b, true);
            const f32x2 cl = __builtin_amdgcn_cvt_pk_f32_fp8((int)c, false), ch = __builtin_amdgcn_cvt_pk_f32_fp8((int)c, true), dl = __builtin_amdgcn_cvt_pk_f32_fp8((int)d, false), dh = __builtin_amdgcn_cvt_pk_f32_fp8((int)d, true);
            v[j].x += ((al[0] + bl[0]) + (cl[0] + dl[0])) * Y8_INV; v[j].y += ((al[1] + bl[1]) + (cl[1] + dl[1])) * Y8_INV;
            v[j].z += ((ah[0] + bh[0]) + (ch[0] + dh[0])) * Y8_INV; v[j].w += ((ah[1] + bh[1]) + (ch[1] + dh[1])) * Y8_INV;
            s += (v[j].x * v[j].x + v[j].y * v[j].y) + (v[j].z * v[j].z + v[j].w * v[j].w); }
        const float rstd = 1.0f / sqrtf(wave_sum(s) * (1.f / DM) + EPS);
#pragma unroll
        for (int j = 0; j < 4; ++j) xr[64 * j] = v[j] * rstd * gr[64 * j];
    }
}

struct Args { const float* in[17]; float* out; unsigned char* ws; int ph_lo, ph_hi, flags, pad; };
constexpr int NPHASE = 9;
__global__ void __launch_bounds__(NTHR, 2) fwd_kernel(Args args) {
    extern __shared__ __attribute__((aligned(16))) unsigned char lds_raw[];
    Ctx F;
    F.x = args.in[0]; F.w_in = args.in[1]; F.w_out = args.in[2]; F.lb_logits = args.in[3]; F.hg_gain = args.in[4]; F.sb_gain = args.in[5]; F.mix_gain = args.in[6]; F.ffn_gain = args.in[7];
    F.w_router = args.in[8]; F.b_router = args.in[9]; F.w_gate = args.in[10]; F.b_gate = args.in[11]; F.w_up = args.in[12]; F.b_up = args.in[13]; F.w_down = args.in[14]; F.b_down = args.in[15]; F.fin_gain = args.in[16];
    F.out = args.out; F.ws = args.ws; F.lds = (LAS unsigned char*)lds_raw;
    F.tid = threadIdx.x; F.lane = F.tid & 63; F.wave = __builtin_amdgcn_readfirstlane(F.tid >> 6); F.G = gridDim.x; F.bid = blockIdx.x; F.flags = args.flags;
    volatile LAS unsigned* MISC = (volatile LAS unsigned*)(F.lds + MISC_OFF);
    if (F.tid < 64) MISC[F.tid] = 0u;
    __syncthreads();
    const int lo = args.ph_lo, hi = args.ph_hi;
    XcdBarrier bar; bar.bar = (unsigned*)(F.ws + WS_CTL) + CW_BAR; bar.x = 0; bar.st = nullptr;
    if (hi - lo > 1) bar = xcd_barrier_post((unsigned*)(F.ws + WS_CTL) + CW_BAR, MISC + 8);
#ifdef TEST_PHASE
#define IN(k) ((k) == TEST_PHASE && lo <= (k))
#else
#define IN(k) (lo <= (k) && (k) < hi)
#endif
#define SEAM(k) do { if (IN(k) && IN((k) + 1)) xcd_barrier(bar); } while (0)
    if (IN(0)) { phase0(F); } SEAM(0);
    F.vc = F.bid;
    if (hi - lo > 1 && IN(0)) {
        if (F.tid == 0) { bool ok = (F.G % 8 == 0); unsigned* bw = (unsigned*)(F.ws + WS_CTL) + CW_BAR;
            for (unsigned j = 0; j < 16; ++j) { const unsigned c = xb_ld(&bw[XB_XCNT(j)]); ok = ok && (j < 8 ? c == (unsigned)F.G / 8 : c == 0u); }
            MISC[3] = ok ? (MISC[10] * 8u + bar.x) : (unsigned)F.bid; }
        __syncthreads();
        F.vc = __builtin_amdgcn_readfirstlane((int)MISC[3]);
    }
    if (IN(1)) { phase1(F); } SEAM(1);
    if (IN(2)) { hgrn_passA(F);
        if (F.tid < 256) *(LAS f32x4*)(F.lds + 122880 + F.tid * 16) = *(const f32x4*)(F.ffn_gain + F.tid * 4);
        __syncthreads();
        if (F.wave < 4) sb_attn_fast(F);
        moe_convert_jobs(F, (LAS float*)(F.lds + 32768 + F.wave * 10240), (const LAS float*)(F.lds + 122880));
        } SEAM(2);
    if (IN(3)) { hgrn_passB(F); if (hi - lo > 1) xcd_barrier(bar); hgrn_passC(F); } SEAM(3);
    if (IN(4)) { phase3(F); } SEAM(4);
    if (IN(5)) { phase_router_fast(F); } SEAM(5);
    if (IN(6)) { phase_gateup(F); } SEAM(6);
    if (IN(7)) { phase_down(F); } SEAM(7);
    if (IN(8)) { phase_final(F); }
#undef IN
#undef SEAM
}

extern "C" void kernel_launch(void* const* d_in, const int* in_sizes, int n_in, void* d_out, int out_size, void* d_ws, size_t ws_size, hipStream_t stream) {
    static int grid = 0;
    if (grid == 0) {
        if (n_in != 17 || in_sizes[0] != NTOK * DM || out_size != NTOK * DM || ws_size < WS_END2) {
            fprintf(stderr, "kernel_launch: unexpected shapes / workspace (n_in %d, in0 %d, out %d, ws %zu, need %zu); nothing launched\n", n_in, n_in > 0 ? in_sizes[0] : -1, out_size, ws_size, (size_t)WS_END); grid = -1; return; }
        int dev = 0, cus = 0;
        if (hipGetDevice(&dev) != hipSuccess || hipDeviceGetAttribute(&cus, hipDeviceAttributeMultiprocessorCount, dev) != hipSuccess) { grid = -1; return; }
        if (hipFuncSetAttribute((const void*)fwd_kernel, hipFuncAttributeMaxDynamicSharedMemorySize, LDS_BYTES) != hipSuccess) { fprintf(stderr, "kernel_launch: hipFuncSetAttribute failed\n"); grid = -1; return; }
        int per_cu = 0;
        if (hipOccupancyMaxActiveBlocksPerMultiprocessor(&per_cu, (const void*)fwd_kernel, NTHR, LDS_BYTES) != hipSuccess || per_cu < 1) fprintf(stderr, "kernel_launch: occupancy query reports %d\n", per_cu);
        (void)hipGetLastError();
        grid = cus;
    }
    if (grid < 0) return;
    (void)hipMemsetAsync((char*)d_ws + WS_CTL, 0, CTL_BYTES, stream);
    Args a{};
    for (int i = 0; i < 17; ++i) a.in[i] = (const float*)d_in[i];
    a.out = (float*)d_out; a.ws = (unsigned char*)d_ws;
#if N_LAUNCH_MODE == 1
#ifdef PROBE_K
    a.ph_lo = 0; a.ph_hi = PROBE_K; a.flags = PROBE_FLAGS;
    hipLaunchKernelGGL(fwd_kernel, dim3(grid), dim3(NTHR), LDS_BYTES, stream, a);
    (void)hipMemsetAsync((char*)d_ws + WS_CTL, 0, CTL_BYTES, stream);
#endif
    a.ph_lo = 0; a.ph_hi = NPHASE; a.flags = 0;
    hipLaunchKernelGGL(fwd_kernel, dim3(grid), dim3(NTHR), LDS_BYTES, stream, a);
#else
    for (int p = 0; p < NPHASE; ++p) { a.ph_lo = p; a.ph_hi = p + 1; hipLaunchKernelGGL(fwd_kernel, dim3(grid), dim3(NTHR), LDS_BYTES, stream, a); }
#endif
}
```

```cpp
#include <hip/hip_runtime.h>
#include <cstdio>
#include <cstdint>

#ifndef PROBE_FLAGS
#define PROBE_FLAGS 0
#endif
#ifndef N_LAUNCH_MODE
#define N_LAUNCH_MODE 1
#endif

#define LAS __attribute__((address_space(3)))
typedef unsigned short bf16;
typedef short bf16x8 __attribute__((ext_vector_type(8)));
typedef float f32x2 __attribute__((ext_vector_type(2)));
typedef float f32x4 __attribute__((ext_vector_type(4)));
typedef float f32x16 __attribute__((ext_vector_type(16)));
typedef unsigned u32x2 __attribute__((ext_vector_type(2)));
typedef unsigned u32x4 __attribute__((ext_vector_type(4)));

constexpr int NTOK = 32768, DM = 1024, SEQ = 8192, NBATCH = 4;
constexpr int INC = 3584;
constexpr int C_HQ = 0, C_HF = 512, C_HI = 1024, C_HG = 1536, C_SQ = 2048, C_SK = 2560, C_SV = 3072;
constexpr int NE = 32, TOPK = 4, DFF = 1024, NK = NTOK * TOPK;
constexpr int ECAP = NTOK;
constexpr float EPS = 1e-5f, SW_LIMIT = 7.0f, SW_ALPHA = 1.702f;
constexpr float W8_SCALE = 64.0f, W8_INV = 1.0f / 64.0f;
constexpr float SB_PEXIT = 1.0e-30f;

constexpr size_t WS_WDN = 0;
constexpr size_t WS_WGU = WS_WDN + 67108864;
constexpr size_t WS_C = WS_WGU + 134217728;
constexpr size_t C_BYTES = (size_t)(NK + 256) * 2048;
constexpr size_t WS_D = WS_C + C_BYTES;
constexpr size_t WS_E = WS_D + 67108864;
constexpr size_t WS_H1B = WS_C;
constexpr size_t WS_MIX = WS_D;
constexpr size_t WS_H1Q = WS_WDN + 33554432;
constexpr size_t WS_PROJ = WS_C;
constexpr size_t WS_WIN = WS_PROJ + (size_t)NTOK * INC * 2;
constexpr size_t WS_WOUT = WS_WIN + (size_t)INC * 1024 * 2;
constexpr size_t WS_HST = WS_WOUT + (size_t)1024 * 1024 * 2;
constexpr size_t WS_HDEC = WS_HST + (size_t)256 * 65536;
static_assert(WS_HDEC + 256 * 128 * 4 <= WS_C + C_BYTES, "C region");
constexpr size_t WS_CTL = WS_E;
constexpr size_t CTL_BYTES = 1u << 20;
constexpr size_t WS_RSTD = WS_CTL + CTL_BYTES;
constexpr size_t WS_STOK = WS_RSTD + (size_t)NTOK * 4;
constexpr size_t WS_SGATE = WS_STOK + (size_t)NE * ECAP * 4;
constexpr size_t WS_SRSTD = WS_SGATE + (size_t)NE * ECAP * 4;
constexpr size_t WS_END = WS_SRSTD + (size_t)NE * ECAP * 4;
constexpr size_t HID_BYTES = (size_t)(NK + 256) * 1024;
constexpr size_t WS_HID = WS_C + C_BYTES - HID_BYTES;
constexpr size_t WS_Y = WS_WGU;
static_assert(WS_Y + (size_t)NK * DM <= WS_HID, "y vs hidden");
constexpr float Y8_SCALE = 16.0f, Y8_INV = 1.0f / 16.0f;
constexpr size_t WS_TSLOT = WS_END;
constexpr size_t WS_END2 = WS_TSLOT + (size_t)NTOK * 4 * 4;
constexpr int CW_JOB = 32;
constexpr int CW_CNT = 64;
constexpr int CW_BAR = 4096;

constexpr int RING_BYTES = 131072;
constexpr int MISC_OFF = RING_BYTES;
constexpr int IDX_OFF = MISC_OFF + 9216;
constexpr int META_OFF = MISC_OFF + 10240, META_BYTES = 3072;
constexpr int LDS_BYTES = 147456;
constexpr int NWAVES = 8, NTHR = 512;

__device__ __forceinline__ unsigned f2bf(float f) { unsigned u = __builtin_bit_cast(unsigned, f); return (u + 0x7fffu + ((u >> 16) & 1u)) >> 16; }
__device__ __forceinline__ unsigned pk2(float lo, float hi) { return f2bf(lo) | (f2bf(hi) << 16); }
__device__ __forceinline__ unsigned pk4_fp8(float a, float b, float c, float d) { int w = __builtin_amdgcn_cvt_pk_fp8_f32(a, b, 0, false); w = __builtin_amdgcn_cvt_pk_fp8_f32(c, d, w, true); return (unsigned)w; }
__device__ __forceinline__ float bf2f(unsigned b) { return __builtin_bit_cast(float, b << 16); }
__device__ __forceinline__ float bflo(unsigned w) { return __builtin_bit_cast(float, w << 16); }
__device__ __forceinline__ float bfhi(unsigned w) { return __builtin_bit_cast(float, w & 0xffff0000u); }
__device__ __forceinline__ float wave_sum(float v) {
#pragma unroll
    for (int o = 1; o < 64; o <<= 1) v += __shfl_xor(v, o);
    return v;
}
__device__ __forceinline__ float sigmoidf_(float x) { return __builtin_amdgcn_rcpf(1.0f + __builtin_amdgcn_exp2f(-1.44269504f * x)); }
__device__ __forceinline__ float siluf_(float x) { return x * sigmoidf_(x); }
__device__ __forceinline__ float exp_raw(float x) { return __builtin_amdgcn_exp2f(1.44269504f * x); }
__device__ __forceinline__ float softplusf_(float z) { return fmaxf(z, 0.f) + __logf(1.0f + __expf(-fabsf(z))); }
#define LDS_WAIT() asm volatile("s_waitcnt lgkmcnt(0)" ::: "memory")
#define VM_WAIT() asm volatile("s_waitcnt vmcnt(0)" ::: "memory")

struct Ctx {
    const float *x, *w_in, *w_out, *lb_logits, *hg_gain, *sb_gain, *mix_gain, *ffn_gain, *w_router, *b_router, *w_gate, *b_gate, *w_up, *b_up, *w_down, *b_down, *fin_gain;
    float* out; unsigned char* ws;
    LAS unsigned char* lds;
    int tid, lane, wave, G, bid, flags, vc;
};

#define XB_TMO      128
#define XB_XCNT(j)  (256  + 64 * (j))
#define XB_XSUB(j)  (1280 + 64 * (j))
#define XB_XGEN(j)  (2304 + 64 * (j))
#define XB_TOP      3328
#define XB_TOPGEN   3392
#define XCD_BAR_WORDS 3456
#define XB_SPIN_CAP (1u << 22)
__device__ __forceinline__ unsigned xb_ld(unsigned* p)              { return __hip_atomic_load(p, __ATOMIC_RELAXED, __HIP_MEMORY_SCOPE_AGENT); }
__device__ __forceinline__ unsigned xb_add(unsigned* p, unsigned v) { return __hip_atomic_fetch_add(p, v, __ATOMIC_RELAXED, __HIP_MEMORY_SCOPE_AGENT); }
__device__ __forceinline__ unsigned xb_xcc_id() { return (unsigned)__builtin_amdgcn_s_getreg((3 << 11) | 20) & 0xFu; }
#define XB_SPIN(cond, bar) do { unsigned _sp = 0; while (cond) { __builtin_amdgcn_s_sleep(1); \
    if ((++_sp & 255u) == 0u) { if (xb_ld(&(bar)[XB_TMO])) break; if (_sp > XB_SPIN_CAP) { atomicAdd(&(bar)[XB_TMO], 1u); break; } } } } while (0)
struct XcdBarrier { unsigned* bar; unsigned x; volatile LAS unsigned* st; };
__device__ __forceinline__ XcdBarrier xcd_barrier_post(unsigned* bar, volatile LAS unsigned* st) {
    XcdBarrier b; b.bar = bar; b.x = xb_xcc_id(); b.st = st;
    if (threadIdx.x == 0) st[2] = xb_add(&bar[XB_XCNT(b.x)], 1u);
    return b;
}
__device__ __forceinline__ void xcd_barrier_complete(unsigned* bar, unsigned x, unsigned& nloc, unsigned& nx) {
    const unsigned G = gridDim.x * gridDim.y * gridDim.z;
    unsigned sum, cnt, mine, sp = 0u;
    for (;;) {
        sum = 0u; cnt = 0u; mine = 0u;
#pragma unroll
        for (unsigned j = 0; j < 16; ++j) { const unsigned c = xb_ld(&bar[XB_XCNT(j)]); sum += c; cnt += (c > 0u) ? 1u : 0u; mine = (j == x) ? c : mine; }
        if (sum == G) break;
        __builtin_amdgcn_s_sleep(1);
        if ((++sp & 255u) == 0u) { if (xb_ld(&bar[XB_TMO])) break; if (sp > XB_SPIN_CAP) { atomicAdd(&bar[XB_TMO], 1u); break; } }
    }
    nloc = mine > 0u ? mine : 1u; nx = cnt > 0u ? cnt : 1u;
}
__device__ __forceinline__ void xcd_barrier(const XcdBarrier& b) {
    asm volatile("s_waitcnt vmcnt(0)" ::: "memory");
    __syncthreads();
    if (threadIdx.x == 0) {
        unsigned* bar = b.bar;
        __builtin_amdgcn_s_waitcnt(0);
        unsigned nloc = b.st[0], nx = b.st[1];
        if (nloc == 0u) { xcd_barrier_complete(bar, b.x, nloc, nx); b.st[0] = nloc; b.st[1] = nx; }
        const unsigned old = xb_add(&bar[XB_XSUB(b.x)], 1u);
        const unsigned gen = old / nloc;
        if (old + 1u == (gen + 1u) * nloc) {
            __builtin_amdgcn_fence(__ATOMIC_RELEASE, "agent");
            asm volatile("s_waitcnt vmcnt(0)" ::: "memory");
            const unsigned og = xb_add(&bar[XB_TOP], 1u);
            const unsigned tg = og / nx;
            if (og + 1u == (tg + 1u) * nx) xb_add(&bar[XB_TOPGEN], 1u);
            else XB_SPIN(xb_ld(&bar[XB_TOPGEN]) == tg, bar);
            __builtin_amdgcn_fence(__ATOMIC_ACQUIRE, "agent");
            xb_add(&bar[XB_XGEN(b.x)], 1u);
            asm volatile("s_waitcnt vmcnt(0)" ::: "memory");
        } else {
            XB_SPIN(xb_ld(&bar[XB_XGEN(b.x)]) == gen, bar);
            __builtin_amdgcn_fence(__ATOMIC_ACQUIRE, "agent");
            asm volatile("s_waitcnt vmcnt(0)" ::: "memory");
        }
    }
    __syncthreads();
}

namespace gm {
constexpr int BM = 256, BK = 64, HALF = 128, HTB = HALF * BK * 2, NXCD = 8, WGM = 8;
typedef int v8i32 __attribute__((ext_vector_type(8)));
__device__ __forceinline__ int lds_byte(int r, int c) { const int st = (r >> 4) * 2 + (c >> 5), rr = r & 15, cc = c & 31, ob = rr * 64 + cc * 2; return st * 1024 + (ob ^ (((ob >> 9) & 1) << 5)); }
__device__ __forceinline__ void stage_rc(int b, int& R, int& C) { const int st = b / 1024, sb = b % 1024, swz = sb ^ (((sb >> 9) & 1) << 5); R = (st >> 1) * 16 + swz / 64; C = (st & 1) * 32 + (swz % 64) / 2; }
__device__ __forceinline__ int perm32(int rho) { const int n = rho >> 4, i = rho & 15; return 8 * (i >> 2) + 4 * n + (i & 3); }
__device__ __forceinline__ unsigned cvt_pk_bf16(float lo, float hi) { unsigned r; asm volatile("v_cvt_pk_bf16_f32 %0, %1, %2" : "=v"(r) : "v"(lo), "v"(hi)); return r; }

struct Unit { const char* A; const char* B; int pm, pn, e, rows; };

__device__ __forceinline__ bool order_next(int i, int G, int c, int nM, int nN, int& pm, int& pn) {
    const int nwg = nM * nN; const long L = (long)i * G + c; if (L >= nwg) return false;
    int wgid = (int)L; { const int q = nwg / NXCD, r = nwg % NXCD, xcd = wgid % NXCD, off = wgid / NXCD; wgid = (xcd < r ? xcd * (q + 1) : r * (q + 1) + (xcd - r) * q) + off; }
    const int nig = WGM * nN, gid = wgid / nig, fm = gid * WGM, gsz = (nM - fm) < WGM ? (nM - fm) : WGM;
    pm = fm + ((wgid % nig) % gsz); pn = (wgid % nig) / gsz; return true;
}

__device__ __forceinline__ void acc_zero(f32x4 (&acc)[2][2][4][2]) {
#pragma unroll
    for (int a = 0; a < 2; ++a)
#pragma unroll
        for (int b = 0; b < 2; ++b)
#pragma unroll
            for (int m = 0; m < 4; ++m)
#pragma unroll
                for (int n = 0; n < 2; ++n) acc[a][b][m][n] = (f32x4){0.f, 0.f, 0.f, 0.f};
}
template <class P>
__device__ __forceinline__ void gemm_phase(LAS unsigned char* lds, const P& S) {
    const int tid = threadIdx.x, wid = __builtin_amdgcn_readfirstlane(tid >> 6), lane = tid & 63, wr = wid >> 2, wc = wid & 3, fr = lane & 15, fq = lane >> 4;
    constexpr int NT = P::FP8 ? 8 : 16, KB = P::FP8 ? 1024 : 2048;
    int R0, C0, R1, C1; stage_rc(tid * 16, R0, C0); stage_rc(tid * 16 + 8192, R1, C1);
    unsigned voffB[2];
    { const int Rb0 = P::PERM ? ((R0 & ~31) + perm32(R0 & 31)) : R0, Rb1 = P::PERM ? ((R1 & ~31) + perm32(R1 & 31)) : R1;
      voffB[0] = (unsigned)(Rb0 * KB + C0 * 2); voffB[1] = (unsigned)(Rb1 * KB + C1 * 2); }
    const size_t kstep = (size_t)(BK * 2), hstepB = (size_t)HALF * KB;
    const unsigned ldsw = (unsigned)wid * 1024u;
    const int aoff = lds_byte(wr * 64 + fr, fq * 8), boff = lds_byte(wc * 32 + fr, fq * 8);
#define G_SA(b, h) (((b) * 2 + (h)) * HTB)
#define G_SB(b, h) ((4 + (b) * 2 + (h)) * HTB)
#define G_STAGEB(bufoff, gbase) do { const char* _gb = (gbase); asm volatile("" : "+s"(_gb)); _Pragma("unroll") for (int _i = 0; _i < 2; ++_i) \
        __builtin_amdgcn_global_load_lds((const unsigned*)(_gb + voffB[_i]), (LAS unsigned*)(lds + (bufoff) + ldsw + _i * 8192), 16, 0, 0); } while (0)
#define G_STAGEA(bufoff, gbase, vo, h) do { const char* _gb = (gbase); asm volatile("" : "+s"(_gb)); _Pragma("unroll") for (int _i = 0; _i < 2; ++_i) \
        __builtin_amdgcn_global_load_lds((const unsigned*)(_gb + (vo)[h][_i]), (LAS unsigned*)(lds + (bufoff) + ldsw + _i * 8192), 16, 0, 0); } while (0)
#define G_LD16(off) (*(const LAS bf16x8*)(lds + (off)))
#define G_CAT2(lo, hi) __builtin_bit_cast(v8i32, __builtin_shufflevector(lo, hi, 0, 1, 2, 3, 4, 5, 6, 7, 8, 9, 10, 11, 12, 13, 14, 15))
#define G_LDA(dst, b, h) do { _Pragma("unroll") for (int m = 0; m < 4; ++m) { if constexpr (P::FP8) dst##8[m] = G_CAT2(G_LD16(G_SA(b, h) + aoff + m * 2048), G_LD16(G_SA(b, h) + aoff + m * 2048 + 1024)); \
        else { _Pragma("unroll") for (int k = 0; k < 2; ++k) dst[m][k] = G_LD16(G_SA(b, h) + aoff + m * 2048 + k * 1024); } } } while (0)
#define G_LDB(dst, b, h) do { _Pragma("unroll") for (int n = 0; n < 2; ++n) { if constexpr (P::FP8) dst##8[n] = G_CAT2(G_LD16(G_SB(b, h) + boff + n * 2048), G_LD16(G_SB(b, h) + boff + n * 2048 + 1024)); \
        else { _Pragma("unroll") for (int k = 0; k < 2; ++k) dst[n][k] = G_LD16(G_SB(b, h) + boff + n * 2048 + k * 1024); } } } while (0)
#define G_MMA(ai, bj, At, Bt) do { __builtin_amdgcn_s_setprio(1); _Pragma("unroll") for (int m = 0; m < 4; ++m) _Pragma("unroll") for (int n = 0; n < 2; ++n) { \
        if constexpr (P::FP8) asm volatile("v_mfma_f32_16x16x128_f8f6f4 %0, %1, %2, %0" : "+v"(acc[ai][bj][m][n]) : "v"(Bt##8[n]), "v"(At##8[m])); \
        else { _Pragma("unroll") for (int k = 0; k < 2; ++k) acc[ai][bj][m][n] = __builtin_amdgcn_mfma_f32_16x16x32_bf16(Bt[n][k], At[m][k], acc[ai][bj][m][n], 0, 0, 0); } } \
        __builtin_amdgcn_s_setprio(0); } while (0)
#define G_MMA_TAIL() do { if constexpr (P::FP8) asm volatile("s_nop 15" ::: "memory"); } while (0)
#define G_WAIT_V(n) asm volatile("s_waitcnt vmcnt(" #n ")" ::: "memory")
#define G_WAIT_L(n) asm volatile("s_waitcnt lgkmcnt(" #n ")" ::: "memory")
#define G_BAR __builtin_amdgcn_s_barrier()
#define G_SCHED __builtin_amdgcn_sched_barrier(0)
    Unit cur, nxt; int ui = 0;
    if (!S.next(0, cur)) return;
    f32x4 acc[2][2][4][2];
    S.acc_init(acc, cur, wr, wc, fr, fq);
    bf16x8 At[4][2], B0[2][2], B1[2][2]; v8i32 At8[4], B08[2], B18[2];
    unsigned voA[2][2];
    S.a_off(cur, R0, C0, R1, C1, voA);
    const char* cA = cur.A; const char* cB = cur.B;
    G_STAGEB(G_SB(0, 0), cB); G_STAGEB(G_SB(0, 1), cB + hstepB); G_STAGEA(G_SA(0, 0), cA + S.koff(0), voA, 0); G_STAGEA(G_SA(0, 1), cA + S.koff(0), voA, 1);
    if (wr == 1) G_BAR;
    G_WAIT_V(2); G_BAR;
    G_STAGEB(G_SB(1, 0), cB + kstep); G_STAGEA(G_SA(1, 0), cA + S.koff(1), voA, 0); G_STAGEB(G_SB(1, 1), cB + hstepB + kstep);
    G_WAIT_V(6); G_BAR;
    for (;;) {
        const bool has_next = S.next(ui + 1, nxt);
        const char* nA = has_next ? nxt.A : cA; const char* nB = has_next ? nxt.B : cB;
        S.meta_prefetch(cur, lds, wid, ui);
        if constexpr (P::GATHER) { if (has_next) S.idx_prefetch(nxt, lds, wid); }
#pragma unroll 1
        for (int t = 0; t < NT; t += 2) {
            const bool last = (t == NT - 2);
            const char* a1 = cA + S.koff(t + 1);
            const char* a2 = last ? nA + S.koff(0) : cA + S.koff(t + 2); const char* b2 = last ? nB : cB + (size_t)(t + 2) * kstep;
            const char* a3 = last ? nA + S.koff(1) : cA + S.koff(t + 3); const char* b3 = b2 + kstep;
            G_LDB(B0, 0, 0); G_LDB(B1, 0, 1); G_SCHED; G_LDA(At, 0, 0); G_STAGEA(G_SA(1, 1), a1, voA, 1);
            if constexpr (P::GATHER) { if (last && has_next) S.a_off_lds(nxt, R0, C0, R1, C1, lds, voA); }
            G_WAIT_V(8); G_WAIT_L(0); G_BAR; G_MMA(0, 0, At, B0); G_MMA(0, 1, At, B1); G_MMA_TAIL(); G_BAR; G_SCHED;
            G_LDA(At, 0, 1); G_STAGEB(G_SB(0, 0), b2); G_STAGEB(G_SB(0, 1), b2 + hstepB); G_STAGEA(G_SA(0, 0), a2, voA, 0);
            G_WAIT_V(8); G_WAIT_L(0); G_BAR; G_MMA(1, 0, At, B0); G_MMA(1, 1, At, B1); G_MMA_TAIL(); G_BAR; G_SCHED;
            G_LDB(B0, 1, 0); G_LDB(B1, 1, 1); G_SCHED; G_LDA(At, 1, 0); G_STAGEA(G_SA(0, 1), a2, voA, 1);
            G_WAIT_V(8); G_WAIT_L(0); G_BAR; G_MMA(0, 0, At, B0); G_MMA(0, 1, At, B1); G_MMA_TAIL(); G_BAR; G_SCHED;
            G_LDA(At, 1, 1); G_STAGEB(G_SB(1, 0), b3); G_STAGEB(G_SB(1, 1), b3 + hstepB); G_STAGEA(G_SA(1, 0), a3, voA, 0);
            G_WAIT_V(8); G_WAIT_L(0); G_BAR; G_MMA(1, 0, At, B0); G_MMA(1, 1, At, B1); G_MMA_TAIL(); G_BAR; G_SCHED;
        }
        if (wr == 0) G_BAR;
        S.epi(acc, cur, wr, wc, fr, fq, lds, ui);
        if (!has_next) break;
        S.acc_init(acc, nxt, wr, wc, fr, fq);
        cur = nxt; cA = nA; cB = nB; ++ui;
        if (wr == 1) G_BAR;
    }
    G_WAIT_V(0);
    G_BAR;
#undef G_SA
#undef G_SB
#undef G_STAGEA
#undef G_STAGEB
#undef G_LDA
#undef G_LDB
#undef G_MMA
#undef G_MMA_TAIL
#undef G_CAT2
#undef G_LD16
#undef G_WAIT_V
#undef G_WAIT_L
#undef G_BAR
#undef G_SCHED
}
}

template <bool FP8> __device__ __forceinline__ void p0_tile(const f32x4 (&rg)[8], unsigned (&o)[16], int k0, const LAS float* kscale, float mult, LAS float* scr, int lane) {
    const int kr = lane >> 4, c16 = lane & 15;
    asm volatile("" ::: "memory");
#pragma unroll
    for (int j = 0; j < 8; ++j) *(LAS f32x4*)(scr + (4 * j + kr) * 68 + 4 * c16) = rg[j];
    asm volatile("" ::: "memory");
    float v[32];
#pragma unroll
    for (int k = 0; k < 32; ++k) v[k] = scr[k * 68 + lane] * mult;
    if (kscale) {
#pragma unroll
        for (int q = 0; q < 8; ++q) { const f32x4 g = *(const LAS f32x4*)(kscale + k0 + 4 * q); v[4 * q] *= g[0]; v[4 * q + 1] *= g[1]; v[4 * q + 2] *= g[2]; v[4 * q + 3] *= g[3]; }
    }
    if constexpr (FP8) {
#pragma unroll
        for (int q = 0; q < 8; ++q) o[q] = pk4_fp8(v[4 * q], v[4 * q + 1], v[4 * q + 2], v[4 * q + 3]);
    } else {
#pragma unroll
        for (int q = 0; q < 16; ++q) o[q] = pk2(v[2 * q], v[2 * q + 1]);
    }
    asm volatile("" ::: "memory");
}
template <bool FP8> __device__ __forceinline__ void p0_job(const float* W, int N, unsigned char* WT, int n0, int kq, long drow0, const LAS float* kscale, float mult, LAS float* scr, int lane) {
    const int kr = lane >> 4, c16 = lane & 15;
    const float* src = W + (size_t)(kq * 256 + kr) * N + n0 + 4 * c16;
    f32x4 rr[3][8];
#pragma unroll
    for (int j = 0; j < 8; ++j) rr[0][j] = *(const f32x4*)(src + (size_t)(4 * j) * N);
#pragma unroll
    for (int j = 0; j < 8; ++j) rr[1][j] = *(const f32x4*)(src + (size_t)(32 + 4 * j) * N);
#pragma unroll
    for (int j = 0; j < 8; ++j) rr[2][j] = *(const f32x4*)(src + (size_t)(64 + 4 * j) * N);
    unsigned char* drow = WT + (size_t)(drow0 + lane) * (FP8 ? 1024 : 2048) + (size_t)kq * 256 * (FP8 ? 1 : 2);
    unsigned line[32];
#pragma unroll
    for (int t = 0; t < 8; ++t) {
        f32x4 cur[8];
#pragma unroll
        for (int j = 0; j < 8; ++j) cur[j] = rr[t % 3][j];
        if (t + 3 < 8) {
#pragma unroll
            for (int j = 0; j < 8; ++j) rr[t % 3][j] = *(const f32x4*)(src + (size_t)(32 * (t + 3) + 4 * j) * N);
        }
        unsigned o[16];
        p0_tile<FP8>(cur, o, kq * 256 + 32 * t, kscale, mult, scr, lane);
        if constexpr (FP8) {
#pragma unroll
            for (int q = 0; q < 8; ++q) line[8 * (t & 3) + q] = o[q];
            if ((t & 3) == 3) {
#pragma unroll
                for (int q = 0; q < 8; ++q) *(u32x4*)(drow + 128 * (t >> 2) + 16 * q) = (u32x4){line[4 * q], line[4 * q + 1], line[4 * q + 2], line[4 * q + 3]};
            }
        } else {
#pragma unroll
            for (int q = 0; q < 16; ++q) line[16 * (t & 1) + q] = o[q];
            if ((t & 1) == 1) {
#pragma unroll
                for (int q = 0; q < 8; ++q) *(u32x4*)(drow + 128 * (t >> 1) + 16 * q) = (u32x4){line[4 * q], line[4 * q + 1], line[4 * q + 2], line[4 * q + 3]};
            }
        }
    }
}
__device__ __forceinline__ void moe_one_job(Ctx& F, int r, LAS float* scr, const LAS float* gainl) {
    unsigned char* WGU = F.ws + WS_WGU; unsigned char* WDN = F.ws + WS_WDN;
    constexpr int J_E = 16 * 4;
    const int e = r / (3 * J_E), q = r % (3 * J_E), which = q / J_E, rr = q % J_E, nb = rr & 15, kq = rr >> 4, n0 = nb * 64;
    if (which == 0) p0_job<true>(F.w_gate + (size_t)e * 1048576, 1024, WGU, n0, kq, (long)(e * 8 + (n0 >> 7)) * 256 + (n0 & 127), gainl, W8_SCALE, scr, F.lane);
    else if (which == 1) p0_job<true>(F.w_up + (size_t)e * 1048576, 1024, WGU, n0, kq, (long)(e * 8 + (n0 >> 7)) * 256 + 128 + (n0 & 127), gainl, W8_SCALE, scr, F.lane);
    else p0_job<true>(F.w_down + (size_t)e * 1048576, 1024, WDN, n0, kq, (long)e * 1024 + n0, nullptr, W8_SCALE, scr, F.lane);
}
__device__ __forceinline__ void moe_convert_jobs(Ctx& F, LAS float* scr, const LAS float* gainl) {
    unsigned* ctr = (unsigned*)(F.ws + WS_CTL) + CW_JOB;
    constexpr int NJ = NE * 3 * 64;
    const int nstatic = (F.G * 16 <= NJ) ? F.G * 16 : 0;
    if (F.wave >= 4 && nstatic) { const int j0 = F.bid * 16 + (F.wave - 4);
        for (int r = j0; r < j0 + 16; r += 4) moe_one_job(F, r, scr, gainl); }
    for (;;) {
        unsigned tk = 0; if (F.lane == 0) tk = __hip_atomic_fetch_add(ctr, 2u, __ATOMIC_RELAXED, __HIP_MEMORY_SCOPE_AGENT);
        const int j0 = nstatic + __builtin_amdgcn_readfirstlane((int)tk);
        if (j0 >= NJ) break;
        for (int r = j0; r < j0 + 2; ++r) moe_one_job(F, r, scr, gainl);
    }
}
__device__ __forceinline__ void phase0(Ctx& F) {
    LAS float* scr = (LAS float*)(F.lds + F.wave * 16384);
    const int gw = F.bid * NWAVES + F.wave, NGW = F.G * NWAVES;
    unsigned char* WIN = F.ws + WS_WIN; unsigned char* WOUT = F.ws + WS_WOUT;
    constexpr int J_IN = (INC / 64) * 4, J_OUT = 16 * 4;
    constexpr int NJOBS = J_IN + J_OUT;
    for (int it = gw; it < NJOBS; it += NGW) {
        int r = it;
        if (r < J_IN) { const int nb = r >> 2, kq = r & 3; p0_job<false>(F.w_in, INC, WIN, nb * 64, kq, nb * 64, nullptr, 1.0f, scr, F.lane); continue; } r -= J_IN;
        { const int nb = r >> 2, kq = r & 3; p0_job<false>(F.w_out, 1024, WOUT, nb * 64, kq, nb * 64, nullptr, 1.0f, scr, F.lane); }
    }
    bf16* U = (bf16*)(F.ws + WS_D);
    const f32x4* gr = (const f32x4*)F.mix_gain + F.lane;
    f32x4 g[4];
#pragma unroll
    for (int j = 0; j < 4; ++j) g[j] = gr[64 * j];
    f32x4 nv[4];
    if (gw < NTOK) {
#pragma unroll
        for (int j = 0; j < 4; ++j) nv[j] = ((const f32x4*)(F.x + (size_t)gw * DM) + F.lane)[64 * j];
    }
    for (int m = gw; m < NTOK; m += NGW) {
        f32x4 v[4]; float s = 0.f;
#pragma unroll
        for (int j = 0; j < 4; ++j) v[j] = nv[j];
        if (m + NGW < NTOK) {
#pragma unroll
            for (int j = 0; j < 4; ++j) nv[j] = ((const f32x4*)(F.x + (size_t)(m + NGW) * DM) + F.lane)[64 * j];
        }
#pragma unroll
        for (int j = 0; j < 4; ++j) s += (v[j].x * v[j].x + v[j].y * v[j].y) + (v[j].z * v[j].z + v[j].w * v[j].w);
        const float rstd = 1.0f / sqrtf(wave_sum(s) * (1.f / DM) + EPS);
        unsigned long long* o8 = (unsigned long long*)(U + (size_t)m * DM) + F.lane;
#pragma unroll
        for (int j = 0; j < 4; ++j)
            o8[64 * j] = (unsigned long long)pk2(v[j].x * rstd * g[j].x, v[j].y * rstd * g[j].y) | ((unsigned long long)pk2(v[j].z * rstd * g[j].z, v[j].w * rstd * g[j].w) << 32);
    }
}

struct P1Pol {
    static constexpr bool PERM = true, FP8 = false, GATHER = false;
    const char* A; const char* B; bf16* O; const float* lbl; int G, c, flags;
    __device__ __forceinline__ bool next(int i, gm::Unit& u) const { int pm, pn; if (!gm::order_next(i, G, c, NTOK / 256, INC / 256, pm, pn)) return false;
        u.pm = pm; u.pn = pn; u.A = A + (size_t)pm * 256 * 2048; u.B = B + (size_t)pn * 256 * 2048; u.e = 0; u.rows = 256; return true; }
    __device__ __forceinline__ void a_off(const gm::Unit&, int R0, int C0, int R1, int C1, unsigned (&vo)[2][2]) const {
        vo[0][0] = (unsigned)(R0 * 1024 + C0) * 2u; vo[0][1] = (unsigned)(R1 * 1024 + C1) * 2u; vo[1][0] = vo[0][0] + 128u * 2048u; vo[1][1] = vo[0][1] + 128u * 2048u; }
    __device__ __forceinline__ size_t koff(int t) const { return (size_t)t * 128; }
    template <int TYPE> __device__ __forceinline__ void epi_t(const f32x4 (&acc)[2][2][4][2], const gm::Unit& u, int wr, int wc, int fr, int fq) const {
        const int row0 = u.pm * 256 + wr * 64 + fr, col0 = u.pn * 256 + wc * 32 + 8 * fq;
        f32x4 lbv[2][2];
        if constexpr (TYPE == 1) {
#pragma unroll
            for (int bj = 0; bj < 2; ++bj)
#pragma unroll
                for (int n = 0; n < 2; ++n) { const int c = col0 + bj * 128 + 4 * n - C_HF; const f32x4 a0 = *(const f32x4*)(lbl + c), a1 = *(const f32x4*)(lbl + 512 + c);
#pragma unroll
                    for (int j = 0; j < 4; ++j) lbv[bj][n][j] = sigmoidf_(a0[j] - a1[j]); }
        }
#pragma unroll
        for (int ai = 0; ai < 2; ++ai)
#pragma unroll
            for (int m = 0; m < 4; ++m) { bf16* rowp = O + (size_t)(row0 + ai * 128 + m * 16) * INC + col0;
#pragma unroll
                for (int bj = 0; bj < 2; ++bj) { f32x4 v[2];
#pragma unroll
                    for (int n = 0; n < 2; ++n)
#pragma unroll
                        for (int j = 0; j < 4; ++j) { const float x = acc[ai][bj][m][n][j];
                            if constexpr (TYPE == 0) v[n][j] = x * sigmoidf_(x);
                            else if constexpr (TYPE == 1) { const float lb = lbv[bj][n][j]; v[n][j] = __logf(lb + (1.0f - lb) * sigmoidf_(x)); }
                            else if constexpr (TYPE == 4) v[n][j] = x * 0.125f;
                            else v[n][j] = x; }
                    u32x4 w; w.x = gm::cvt_pk_bf16(v[0][0], v[0][1]); w.y = gm::cvt_pk_bf16(v[0][2], v[0][3]); w.z = gm::cvt_pk_bf16(v[1][0], v[1][1]); w.w = gm::cvt_pk_bf16(v[1][2], v[1][3]);
                    *(u32x4*)(rowp + bj * 128) = w; } }
    }
    __device__ __forceinline__ void acc_init(f32x4 (&acc)[2][2][4][2], const gm::Unit&, int, int, int, int) const { gm::acc_zero(acc); }
    __device__ __forceinline__ void meta_prefetch(const gm::Unit&, LAS unsigned char*, int, int) const {}
    __device__ __forceinline__ void epi(const f32x4 (&acc)[2][2][4][2], const gm::Unit& u, int wr, int wc, int fr, int fq, LAS unsigned char*, int) const {
        if (flags & 1) { if (acc[0][0][0][0][0] == 1.2345e-30f) O[0] = 1; return; }
        const int type = u.pn >> 1;
        if (type == 0 || type == 3) epi_t<0>(acc, u, wr, wc, fr, fq);
        else if (type == 1) epi_t<1>(acc, u, wr, wc, fr, fq);
        else if (type == 4) epi_t<4>(acc, u, wr, wc, fr, fq);
        else epi_t<2>(acc, u, wr, wc, fr, fq);
    }
};
__device__ __forceinline__ void phase1(Ctx& F) {
    P1Pol S{(const char*)(F.ws + WS_D), (const char*)(F.ws + WS_WIN), (bf16*)(F.ws + WS_PROJ), F.lb_logits, F.G, F.vc, F.flags};
    gm::gemm_phase<P1Pol>(F.lds, S);
}

typedef short s16x4 __attribute__((ext_vector_type(4)));
__device__ __forceinline__ s16x4 tr_read(LAS const unsigned char* p) { return __builtin_bit_cast(s16x4, __builtin_amdgcn_ds_read_tr16_b64_v4i16((LAS s16x4*)p)); }
__device__ __forceinline__ bf16x8 cat8(s16x4 a, s16x4 b) { return (bf16x8){a[0], a[1], a[2], a[3], b[0], b[1], b[2], b[3]}; }
__device__ __forceinline__ bf16x8 pack8(f32x4 a, f32x4 b) { u32x4 w; w.x = gm::cvt_pk_bf16(a[0], a[1]); w.y = gm::cvt_pk_bf16(a[2], a[3]); w.z = gm::cvt_pk_bf16(b[0], b[1]); w.w = gm::cvt_pk_bf16(b[2], b[3]); return __builtin_bit_cast(bf16x8, w); }
#define MFMA16(a, b, c) __builtin_amdgcn_mfma_f32_16x16x32_bf16((a), (b), (c), 0, 0, 0)
#define MFMA32(a, b, c) __builtin_amdgcn_mfma_f32_32x32x16_bf16((a), (b), (c), 0, 0, 0)
constexpr int SBV_PITCH = 192, SBV_BYTES = 32 * SBV_PITCH;
__device__ __forceinline__ void sb_attn_fast(Ctx& F) {
    bf16* PROJ = (bf16*)(F.ws + WS_PROJ);
    LAS unsigned char* VT = F.lds + F.wave * SBV_BYTES;
    const int l = F.lane, c = l & 31, hh = l >> 5, i = l & 15, sub = (l >> 4) & 1;
    const int gw = F.bid * 4 + F.wave, NGW = F.G * 4;
    const bool xl = (F.G == 256);
    const int xcd = F.vc & 7, wx = (F.vc >> 3) * 4 + F.wave;
    for (int n = 0; ; ++n) {
        int qt, bh;
        if (xl) { if (n >= 8) break; bh = xcd + 8 * (n >> 1); qt = wx + 128 * (n & 1); }
        else { const int item = gw + n * NGW; if (item >= NBATCH * 8 * (SEQ / 32)) break; qt = item & 255; bh = item >> 8; }
        const int b = bh >> 3, h = bh & 7, t0 = qt * 32;
        const size_t tokbase = (size_t)b * SEQ;
        const bf16* qp = PROJ + (tokbase + t0 + c) * INC + C_SQ + h * 64;
        bf16* mixp = (bf16*)(F.ws + WS_MIX) + (tokbase + t0 + c) * DM + 512 + h * 64;
        bf16x8 qfr[4];
#pragma unroll
        for (int ks = 0; ks < 4; ++ks) qfr[ks] = *(const bf16x8*)(qp + 16 * ks + 8 * hh);
        const bf16* kb = PROJ + tokbase * INC + C_SK + h * 64 + 8 * hh;
        const bf16* vb = PROJ + tokbase * INC + C_SV + h * 64 + (l & 7) * 8;
        f32x16 O0, O1;
#pragma unroll
        for (int r = 0; r < 16; ++r) { O0[r] = 0.f; O1[r] = 0.f; }
        float prun = 1.0f;
        bf16x8 kn[3][4]; u32x4 vn[3][4];
#pragma unroll
        for (int d = 0; d < 3; ++d) { const int sd = (t0 - 32 * d) > 0 ? (t0 - 32 * d) : 0;
#pragma unroll
            for (int ks = 0; ks < 4; ++ks) kn[d][ks] = *(const bf16x8*)(kb + (size_t)(sd + c) * INC + 16 * ks);
#pragma unroll
            for (int q = 0; q < 4; ++q) vn[d][q] = *(const u32x4*)(vb + (size_t)(sd + 8 * q + (l >> 3)) * INC);
            asm volatile("" ::: "memory");
        }
#define ATT_TILE(SV, D) { \
            const int s_ = (SV); const int sn_ = (s_ - 96) > 0 ? (s_ - 96) : 0; \
            asm volatile("" ::: "memory"); \
            _Pragma("unroll") for (int q = 0; q < 4; ++q) *(LAS u32x4*)(VT + (8 * q + (l >> 3)) * SBV_PITCH + (l & 7) * 16) = vn[D][q]; \
            asm volatile("" ::: "memory"); \
            f32x16 z; \
            _Pragma("unroll") for (int r = 0; r < 16; ++r) z[r] = 0.f; \
            _Pragma("unroll") for (int ks = 0; ks < 4; ++ks) z = MFMA32(kn[D][ks], qfr[ks], z); \
            __builtin_amdgcn_sched_barrier(0); \
            _Pragma("unroll") for (int ks = 0; ks < 4; ++ks) kn[D][ks] = *(const bf16x8*)(kb + (size_t)(sn_ + c) * INC + 16 * ks); \
            _Pragma("unroll") for (int q = 0; q < 4; ++q) vn[D][q] = *(const u32x4*)(vb + (size_t)(sn_ + 8 * q + (l >> 3)) * INC); \
              \
            float sg[16], om[16]; \
            _Pragma("unroll") for (int r = 0; r < 16; ++r) { const float e = __builtin_amdgcn_exp2f(-fmaxf(z[r] * 1.44269504f, -120.f)); \
                sg[r] = __builtin_amdgcn_rcpf(1.0f + e); om[r] = e * sg[r]; } \
            if (s_ == t0) {                    \
                _Pragma("unroll") for (int r = 0; r < 16; ++r) { const bool ok = ((r & 3) + 8 * (r >> 2) + 4 * hh) < c; sg[r] = ok ? sg[r] : 0.f; om[r] = ok ? om[r] : 1.0f; } } \
            float gs[4], pg[4]; \
            _Pragma("unroll") for (int q = 0; q < 4; ++q) { gs[q] = (om[4 * q] * om[4 * q + 1]) * (om[4 * q + 2] * om[4 * q + 3]); pg[q] = __shfl_xor(gs[q], 32); } \
            float lgq[4]; float tail = 1.0f; \
            _Pragma("unroll") for (int q = 3; q >= 0; --q) { lgq[q] = tail * (hh == 0 ? pg[q] : 1.0f); tail *= gs[q] * pg[q]; } \
            f32x4 a4[4]; \
            _Pragma("unroll") for (int q = 0; q < 4; ++q) { const float w3 = prun * lgq[q], w2 = w3 * om[4 * q + 3], w1 = w2 * om[4 * q + 2], w0 = w1 * om[4 * q + 1]; \
                a4[q] = (f32x4){sg[4 * q] * w0, sg[4 * q + 1] * w1, sg[4 * q + 2] * w2, sg[4 * q + 3] * w3}; } \
            prun *= tail; \
            const bf16x8 p0 = pack8(a4[0], a4[1]), p1 = pack8(a4[2], a4[3]); \
            asm volatile("" ::: "memory"); \
            _Pragma("unroll") for (int s2 = 0; s2 < 2; ++s2) { const bf16x8 pf = s2 ? p1 : p0; \
                LAS const unsigned char* vr = VT + (16 * s2 + 4 * hh + (i >> 2)) * SBV_PITCH + (16 * sub + 4 * (i & 3)) * 2; \
                const bf16x8 v0 = cat8(tr_read(vr), tr_read(vr + 8 * SBV_PITCH)); \
                const bf16x8 v1 = cat8(tr_read(vr + 64), tr_read(vr + 8 * SBV_PITCH + 64)); \
                O0 = MFMA32(v0, pf, O0); O1 = MFMA32(v1, pf, O1); } \
            asm volatile("" ::: "memory"); }
        for (int s0 = t0; ; s0 -= 96) {
            ATT_TILE(s0, 0)
            if (s0 < 32 || __ballot(prun >= SB_PEXIT) == 0ull) break;
            ATT_TILE(s0 - 32, 1)
            if (s0 < 64 || __ballot(prun >= SB_PEXIT) == 0ull) break;
            ATT_TILE(s0 - 64, 2)
            if (s0 < 96 || __ballot(prun >= SB_PEXIT) == 0ull) break;
        }
#undef ATT_TILE
        float ssq = 0.f;
#pragma unroll
        for (int r = 0; r < 16; ++r) ssq += O0[r] * O0[r] + O1[r] * O1[r];
        ssq += __shfl_xor(ssq, 32);
        const float rn = 1.0f / sqrtf(ssq * (1.f / 64) + EPS);
#pragma unroll
        for (int dt = 0; dt < 2; ++dt)
#pragma unroll
            for (int q = 0; q < 4; ++q) { const int d0 = 32 * dt + 8 * q + 4 * hh; const f32x4 gn = *(const f32x4*)(F.sb_gain + h * 64 + d0);
                const float o0 = (dt ? O1[4 * q] : O0[4 * q]) * rn * gn[0], o1 = (dt ? O1[4 * q + 1] : O0[4 * q + 1]) * rn * gn[1], o2 = (dt ? O1[4 * q + 2] : O0[4 * q + 2]) * rn * gn[2], o3 = (dt ? O1[4 * q + 3] : O0[4 * q + 3]) * rn * gn[3];
                *(u32x2*)(mixp + d0) = (u32x2){gm::cvt_pk_bf16(o0, o1), gm::cvt_pk_bf16(o2, o3)}; }
    }
}
constexpr int HA_SET = 8192 + 9216 + 9216;
__device__ __forceinline__ void hgrn_passA(Ctx& F) {
    const bf16* PROJ = (const bf16*)(F.ws + WS_PROJ);
    float* HST = (float*)(F.ws + WS_HST); float* HDEC = (float*)(F.ws + WS_HDEC);
    const int i = F.lane & 15, g = F.lane >> 4, w = F.wave;
    for (int it = F.bid; it < 256; it += F.G) {
        const int b = it >> 6, h = (it >> 4) & 3, sc = it & 15;
        const size_t rowbase = (size_t)b * SEQ + sc * 512;
        const int row = F.tid >> 4, chunk = F.tid & 15;
        const bf16* gp = PROJ + (rowbase + row) * INC + h * 128 + chunk * 8;
        f32x4 acc[8];
#pragma unroll
        for (int kt = 0; kt < 8; ++kt) acc[kt] = (f32x4){0.f, 0.f, 0.f, 0.f};
        float run = 0.f;
        const int k = F.tid & 127, tq = F.tid >> 7, tqu = __builtin_amdgcn_readfirstlane(tq);
        u32x4 nf = *(const u32x4*)(gp + (size_t)15 * 32 * INC + C_HF), nv = *(const u32x4*)(gp + (size_t)15 * 32 * INC + C_HI);
        __syncthreads();
        for (int tl = 15; tl >= 0; --tl) {
            LAS unsigned char* set = F.lds + (tl & 1) * HA_SET;
            LAS unsigned char* RAWF = set; LAS unsigned char* KH = set + 8192; LAS unsigned char* VI = set + 8192 + 9216;
            *(LAS u32x4*)(RAWF + row * 256 + chunk * 16) = nf; *(LAS u32x4*)(VI + row * 288 + chunk * 16) = nv;
            if (tl > 0) { nf = *(const u32x4*)(gp + (size_t)(tl - 1) * 32 * INC + C_HF); nv = *(const u32x4*)(gp + (size_t)(tl - 1) * 32 * INC + C_HI); }
            __syncthreads();
            {
                float lfv[32];
#pragma unroll
                for (int s = 0; s < 32; ++s) lfv[s] = bf2f(*(const LAS unsigned short*)(RAWF + s * 256 + k * 2));
#define PA_Q(Q) { _Pragma("unroll") for (int s = 31; s >= 0; --s) { if ((s >> 3) == (Q)) *(LAS unsigned short*)(KH + s * 288 + k * 2) = (unsigned short)f2bf((1.0f - exp_raw(lfv[s])) * exp_raw(run)); run += lfv[s]; } }
                if (tqu == 0) PA_Q(0) else if (tqu == 1) PA_Q(1) else if (tqu == 2) PA_Q(2) else PA_Q(3)
#undef PA_Q
            }
            __syncthreads();
            const bf16x8 bv = cat8(tr_read(VI + (4 * g + (i >> 2)) * 288 + (16 * w + 4 * (i & 3)) * 2), tr_read(VI + (16 + 4 * g + (i >> 2)) * 288 + (16 * w + 4 * (i & 3)) * 2));
#pragma unroll
            for (int kt = 0; kt < 8; ++kt) {
                const bf16x8 av = cat8(tr_read(KH + (4 * g + (i >> 2)) * 288 + (16 * kt + 4 * (i & 3)) * 2), tr_read(KH + (16 + 4 * g + (i >> 2)) * 288 + (16 * kt + 4 * (i & 3)) * 2));
                acc[kt] = MFMA16(av, bv, acc[kt]); }
        }
        float* hp = HST + (size_t)it * 16384;
#pragma unroll
        for (int kt = 0; kt < 8; ++kt) *(f32x4*)(hp + ((w * 8 + kt) * 64 + F.lane) * 4) = acc[kt];
        if (tq == 0) HDEC[it * 128 + k] = __expf(run);
        __syncthreads();
    }
}
__device__ __forceinline__ void hgrn_passB(Ctx& F) {
    float* HST = (float*)(F.ws + WS_HST); const float* HDEC = (const float*)(F.ws + WS_HDEC);
    for (int u = F.bid; u < 256; u += F.G) {
        const int bh = u >> 4, part = u & 15;
        const int e = part * 1024 + F.tid * 2;
        const int kk = 16 * ((e >> 8) & 7) + 4 * (((e >> 2) & 63) >> 4) + (e & 3);
        f32x2 L[16]; f32x2 D[16];
#pragma unroll
        for (int sc = 0; sc < 16; ++sc) { L[sc] = *(const f32x2*)(HST + (size_t)(bh * 16 + sc) * 16384 + e); D[sc] = *(const f32x2*)(HDEC + (bh * 16 + sc) * 128 + kk); }
        f32x2 S = (f32x2){0.f, 0.f};
#pragma unroll
        for (int sc = 0; sc < 16; ++sc) { *(f32x2*)(HST + (size_t)(bh * 16 + sc) * 16384 + e) = S; S = S * D[sc] + L[sc]; }
    }
}
constexpr int HC_RAWF = 0, HC_RAWQ = 4096, HC_QH = 8192, HC_KT = HC_QH + 4352, HC_V = HC_KT + 4352, HC_G = HC_V + 4608, HC_DK = HC_G + 4352, HC_PART = HC_DK + 512, HC_SET = HC_PART + 512;
#define PASSC_ITER(ITR, D) do { const int itr = (ITR); \
            if (mfw) { \
                if (itr >= 1 && itr <= 32) { const int st = itr - 1; const LAS unsigned char* set = F.lds + (st & 3) * HC_SET; \
                    float tot = 0.f; \
                _Pragma("unroll") \
                    for (int ww = 0; ww < 8; ++ww) tot += *(const LAS float*)(set + HC_PART + (ww * 16 + i) * 4); \
                    const float rs = 1.0f / sqrtf(tot * (1.f / 128) + EPS); \
                _Pragma("unroll") \
                    for (int u = 0; u < 2; ++u) { const int vt = 2 * w + u; \
                        const u32x2 gi = *(const LAS u32x2*)(set + HC_G + i * 272 + (16 * vt + 4 * g) * 2); \
                        u32x2 o; o.x = gm::cvt_pk_bf16(oT[u][0] * rs * gain[u][0] * bflo(gi.x), oT[u][1] * rs * gain[u][1] * bfhi(gi.x)); o.y = gm::cvt_pk_bf16(oT[u][2] * rs * gain[u][2] * bflo(gi.y), oT[u][3] * rs * gain[u][3] * bfhi(gi.y)); \
                        *(u32x2*)((bf16*)(F.ws + WS_MIX) + (rowbase + st * 16 + i) * DM + h * 128 + 16 * vt + 4 * g) = o; } } \
                if (itr >= 0 && itr < 32) { LAS unsigned char* set = F.lds + (itr & 3) * HC_SET; \
                    bf16x8 qf[4]; \
                    f32x4 pT = (f32x4){0.f, 0.f, 0.f, 0.f}; \
                _Pragma("unroll") \
                    for (int ks = 0; ks < 4; ++ks) { \
                        qf[ks] = cat8(*(const LAS s16x4*)(set + HC_QH + i * 272 + (32 * ks + 4 * g) * 2), *(const LAS s16x4*)(set + HC_QH + i * 272 + (32 * ks + 16 + 4 * g) * 2)); \
                        const bf16x8 kf = cat8(*(const LAS s16x4*)(set + HC_KT + i * 272 + (32 * ks + 4 * g) * 2), *(const LAS s16x4*)(set + HC_KT + i * 272 + (32 * ks + 16 + 4 * g) * 2)); \
                        pT = MFMA16(kf, qf[ks], pT); } \
                _Pragma("unroll") \
                    for (int r = 0; r < 4; ++r) pT[r] = (4 * g + r <= i) ? pT[r] : 0.f; \
                    const s16x4 z4 = (s16x4){0, 0, 0, 0}; \
                    const bf16x8 pf = pack8(pT, (f32x4){0.f, 0.f, 0.f, 0.f}); \
                    bf16x8 vf[2]; \
                _Pragma("unroll") \
                    for (int u = 0; u < 2; ++u) { const int vt = 2 * w + u; \
                        vf[u] = cat8(tr_read(set + HC_V + (4 * g + (i >> 2)) * 288 + (16 * vt + 4 * (i & 3)) * 2), z4); \
                        oT[u] = MFMA16(vf[u], pf, ((f32x4){0.f, 0.f, 0.f, 0.f})); \
                _Pragma("unroll") \
                        for (int ks = 0; ks < 4; ++ks) oT[u] = MFMA16(pack8(acc[u][2 * ks], acc[u][2 * ks + 1]), qf[ks], oT[u]); } \
                _Pragma("unroll") \
                    for (int kt = 0; kt < 8; ++kt) { const bf16x8 ak = cat8(tr_read(set + HC_KT + (4 * g + (i >> 2)) * 272 + (16 * kt + 4 * (i & 3)) * 2), z4); \
                        const f32x4 dk = *(const LAS f32x4*)(set + HC_DK + (16 * kt + 4 * g) * 4); \
                _Pragma("unroll") \
                        for (int u = 0; u < 2; ++u) { acc[u][kt] = MFMA16(ak, vf[u], acc[u][kt]); acc[u][kt] = acc[u][kt] * dk; } } \
                _Pragma("unroll") \
                    for (int u = 0; u < 2; ++u) { float ssq = (oT[u][0] * oT[u][0] + oT[u][1] * oT[u][1]) + (oT[u][2] * oT[u][2] + oT[u][3] * oT[u][3]); \
                        ssq += __shfl_xor(ssq, 16); ssq += __shfl_xor(ssq, 32); \
                        if (g == 0) *(LAS float*)(set + HC_PART + ((2 * w + u) * 16 + i) * 4) = ssq; } } \
            } else { \
                if (itr + 1 >= 0 && itr + 1 < 32) { LAS unsigned char* set = F.lds + ((itr + 1) & 3) * HC_SET; \
                    float lfv[16], qv[8]; float run = 0.f;        \
                _Pragma("unroll") \
                    for (int s2 = 0; s2 < 16; ++s2) lfv[s2] = bf2f(*(const LAS unsigned short*)(set + HC_RAWF + s2 * 256 + k * 2)); \
                _Pragma("unroll") \
                    for (int j = 0; j < 8; ++j) qv[j] = bf2f(*(const LAS unsigned short*)(set + HC_RAWQ + (8 * tqu + j) * 256 + k * 2)); \
                    if (tqu == 0) { \
                _Pragma("unroll") \
                        for (int s2 = 0; s2 < 8; ++s2) { run += lfv[s2]; \
                            *(LAS unsigned short*)(set + HC_QH + s2 * 272 + k * 2) = (unsigned short)f2bf(qv[s2] * exp_raw(run)); \
                            *(LAS unsigned short*)(set + HC_KT + s2 * 272 + k * 2) = (unsigned short)f2bf((1.0f - exp_raw(lfv[s2])) * exp_raw(fminf(-run, 80.f))); } \
                _Pragma("unroll") \
                        for (int s2 = 8; s2 < 16; ++s2) run += lfv[s2]; \
                        *(LAS float*)(set + HC_DK + k * 4) = exp_raw(run); \
                    } else { \
                _Pragma("unroll") \
                        for (int s2 = 0; s2 < 8; ++s2) run += lfv[s2]; \
                _Pragma("unroll") \
                        for (int s2 = 8; s2 < 16; ++s2) { run += lfv[s2]; \
                            *(LAS unsigned short*)(set + HC_QH + s2 * 272 + k * 2) = (unsigned short)f2bf(qv[s2 - 8] * exp_raw(run)); \
                            *(LAS unsigned short*)(set + HC_KT + s2 * 272 + k * 2) = (unsigned short)f2bf((1.0f - exp_raw(lfv[s2])) * exp_raw(fminf(-run, 80.f))); } } } \
                if (itr + 2 < 32) { LAS unsigned char* set = F.lds + ((itr + 2) & 3) * HC_SET; \
                    *(LAS u32x4*)(set + HC_RAWF + row * 256 + chunk * 16) = pfq[D][0]; *(LAS u32x4*)(set + HC_RAWQ + row * 256 + chunk * 16) = pfq[D][1]; \
                    *(LAS u32x4*)(set + HC_V + row * 288 + chunk * 16) = pfq[D][2]; *(LAS u32x4*)(set + HC_G + row * 272 + chunk * 16) = pfq[D][3]; } \
            } \
            { const int pst = (itr + 5 < 32) ? itr + 5 : 31; const bf16* gq = gp + (size_t)pst * 16 * INC;     pfq[D][0] = *(const u32x4*)(gq + C_HF); pfq[D][1] = *(const u32x4*)(gq + C_HQ); pfq[D][2] = *(const u32x4*)(gq + C_HI); pfq[D][3] = *(const u32x4*)(gq + C_HG); } \
            __syncthreads(); } while (0)
__device__ __forceinline__ void hgrn_passC(Ctx& F) {
    bf16* PROJ = (bf16*)(F.ws + WS_PROJ);
    const float* HST = (const float*)(F.ws + WS_HST);
    const int i = F.lane & 15, g = F.lane >> 4, w = F.wave;
    const bool mfw = (w < 4);
    for (int it = F.bid; it < 256; it += F.G) {
        const int b = it >> 6, h = (it >> 4) & 3, sc = it & 15;
        const size_t rowbase = (size_t)b * SEQ + sc * 512;
        const int t = F.tid & 255, row = t >> 4, chunk = t & 15;
        const bf16* gp = PROJ + (rowbase + row) * INC + h * 128 + chunk * 8;
        u32x4 pfq[3][4];
#pragma unroll
        for (int d = 0; d < 3; ++d)
#pragma unroll
            for (int q = 0; q < 4; ++q) pfq[d][q] = (u32x4){0u, 0u, 0u, 0u};
        {
#pragma unroll
            for (int d = 0; d < 3; ++d) { const bf16* gq = gp + (size_t)d * 16 * INC; pfq[d][0] = *(const u32x4*)(gq + C_HF); pfq[d][1] = *(const u32x4*)(gq + C_HQ); pfq[d][2] = *(const u32x4*)(gq + C_HI); pfq[d][3] = *(const u32x4*)(gq + C_HG); } }
        f32x4 gain[2]; f32x4 acc[2][8]; f32x4 oT[2];
#pragma unroll
        for (int u = 0; u < 2; ++u) { gain[u] = *(const f32x4*)(F.hg_gain + h * 128 + 16 * ((2 * w + u) & 7) + 4 * g); oT[u] = (f32x4){0.f, 0.f, 0.f, 0.f};
#pragma unroll
            for (int kt = 0; kt < 8; ++kt) acc[u][kt] = (f32x4){0.f, 0.f, 0.f, 0.f}; }
        if (mfw) {
#pragma unroll
            for (int u = 0; u < 2; ++u)
#pragma unroll
                for (int kt = 0; kt < 8; ++kt) acc[u][kt] = *(const f32x4*)(HST + (size_t)it * 16384 + (((2 * w + u) * 8 + kt) * 64 + F.lane) * 4);
        }
        const int k = t & 127, tq = t >> 7, tqu = __builtin_amdgcn_readfirstlane(tq);
        __syncthreads();
        for (int base = -2; base <= 32; base += 3) { PASSC_ITER(base, 0); PASSC_ITER(base + 1, 1); PASSC_ITER(base + 2, 2); }
    }
}
#undef PASSC_ITER

struct P3Pol {
    static constexpr bool PERM = true, FP8 = false, GATHER = false;
    const char* A; const char* B; const float* x; bf16* h1b; unsigned char* h1q; int G, c, flags;
    __device__ __forceinline__ bool next(int i, gm::Unit& u) const { int pm, pn; if (!gm::order_next(i, G, c, NTOK / 256, 4, pm, pn)) return false;
        u.pm = pm; u.pn = pn; u.A = A + (size_t)pm * 256 * 2048; u.B = B + (size_t)pn * 256 * 2048; u.e = 0; u.rows = 256; return true; }
    __device__ __forceinline__ void a_off(const gm::Unit&, int R0, int C0, int R1, int C1, unsigned (&vo)[2][2]) const {
        vo[0][0] = (unsigned)(R0 * 1024 + C0) * 2u; vo[0][1] = (unsigned)(R1 * 1024 + C1) * 2u; vo[1][0] = vo[0][0] + 128u * 2048u; vo[1][1] = vo[0][1] + 128u * 2048u; }
    __device__ __forceinline__ size_t koff(int t) const { return (size_t)t * 128; }
    __device__ __forceinline__ void acc_init(f32x4 (&acc)[2][2][4][2], const gm::Unit& u, int wr, int wc, int fr, int fq) const {
        const int row0 = u.pm * 256 + wr * 64 + fr, col0 = u.pn * 256 + wc * 32 + 8 * fq;
#pragma unroll
        for (int ai = 0; ai < 2; ++ai)
#pragma unroll
            for (int m = 0; m < 4; ++m) { const float* xp = x + (size_t)(row0 + ai * 128 + m * 16) * DM + col0;
#pragma unroll
                for (int bj = 0; bj < 2; ++bj) { acc[ai][bj][m][0] = *(const f32x4*)(xp + bj * 128); acc[ai][bj][m][1] = *(const f32x4*)(xp + bj * 128 + 4); } }
#pragma unroll
        for (int ai = 0; ai < 2; ++ai)
#pragma unroll
            for (int m = 0; m < 4; ++m)
#pragma unroll
                for (int bj = 0; bj < 2; ++bj) asm volatile("" : "+v"(acc[ai][bj][m][0]), "+v"(acc[ai][bj][m][1]));
    }
    __device__ __forceinline__ void meta_prefetch(const gm::Unit&, LAS unsigned char*, int, int) const {}
    __device__ __forceinline__ void epi(const f32x4 (&acc)[2][2][4][2], const gm::Unit& u, int wr, int wc, int fr, int fq, LAS unsigned char*, int) const {
        if (flags & 2) { if (acc[0][0][0][0][0] == 1.2345e-30f) h1q[0] = 1; return; }
        const int row0 = u.pm * 256 + wr * 64 + fr, col0 = u.pn * 256 + wc * 32 + 8 * fq;
#pragma unroll
        for (int ai = 0; ai < 2; ++ai)
#pragma unroll
            for (int m = 0; m < 4; ++m) { const size_t off = (size_t)(row0 + ai * 128 + m * 16) * DM + col0;
#pragma unroll
                for (int bj = 0; bj < 2; ++bj) { const f32x4 v0 = acc[ai][bj][m][0], v1 = acc[ai][bj][m][1];
                    u32x4 w; w.x = gm::cvt_pk_bf16(v0[0], v0[1]); w.y = gm::cvt_pk_bf16(v0[2], v0[3]); w.z = gm::cvt_pk_bf16(v1[0], v1[1]); w.w = gm::cvt_pk_bf16(v1[2], v1[3]);
                    *(u32x4*)(h1b + off + bj * 128) = w;
                    *(u32x2*)(h1q + off + bj * 128) = (u32x2){pk4_fp8(v0[0], v0[1], v0[2], v0[3]), pk4_fp8(v1[0], v1[1], v1[2], v1[3])}; } }
    }
};
__device__ __forceinline__ void phase3(Ctx& F) {
    P3Pol S{(const char*)(F.ws + WS_MIX), (const char*)(F.ws + WS_WOUT), F.x, (bf16*)(F.ws + WS_H1B), F.ws + WS_H1Q, F.G, F.vc, F.flags};
    gm::gemm_phase<P3Pol>(F.lds, S);
}

__device__ __forceinline__ void phase_router_fast(Ctx& F) {
    LAS float* W4 = (LAS float*)F.lds;
    LAS unsigned char* M = F.lds + MISC_OFF + 1024;
    LAS float* rsd = (LAS float*)M; LAS int* sel_e = (LAS int*)(M + 512); LAS float* sel_g = (LAS float*)(M + 2560); LAS int* lpos = (LAS int*)(M + 4608); LAS int* hist = (LAS int*)(M + 6656); LAS int* base = hist + 32;
    unsigned* cnt = (unsigned*)(F.ws + WS_CTL) + CW_CNT;
    int* STOK = (int*)(F.ws + WS_STOK); float* SGATE = (float*)(F.ws + WS_SGATE); float* SRSTD = (float*)(F.ws + WS_SRSTD);
    for (int idx = F.tid; idx < 1024 * NE; idx += NTHR) { const int k = idx >> 5, e = idx & 31; W4[((k >> 2) * 32 + e) * 4 + (k & 3)] = F.w_router[idx] * F.ffn_gain[k]; }
    for (int tb = F.bid; tb < NTOK / 128; tb += F.G) {
        const int tok0 = tb * 128;
        __syncthreads();
        if (F.tid < 32) hist[F.tid] = 0;
        if (F.wave < 4) {
            const int j = F.lane & 31, h = F.lane >> 5, tok = tok0 + F.wave * 32 + j;
            const bf16* hp = (const bf16*)(F.ws + WS_H1B) + (size_t)tok * DM + 4 * h;
            f32x16 acc;
#pragma unroll
            for (int r = 0; r < 16; ++r) acc[r] = 0.f;
            float ssq = 0.f;
            u32x2 pre[8];
#pragma unroll
            for (int q = 0; q < 8; ++q) pre[q] = *(const u32x2*)(hp + 8 * q);
            for (int m0 = 0; m0 < 128; m0 += 8) {
                u32x2 cur[8];
#pragma unroll
                for (int q = 0; q < 8; ++q) cur[q] = pre[q];
                if (m0 + 8 < 128) {
#pragma unroll
                    for (int q = 0; q < 8; ++q) pre[q] = *(const u32x2*)(hp + 8 * (m0 + 8 + q));
                }
#pragma unroll
                for (int q = 0; q < 8; ++q) { const f32x4 wv = *(const LAS f32x4*)(W4 + ((2 * (m0 + q) + h) * 32 + j) * 4); const f32x4 a = (f32x4){bflo(cur[q].x), bfhi(cur[q].x), bflo(cur[q].y), bfhi(cur[q].y)};
                    ssq += (a[0] * a[0] + a[1] * a[1]) + (a[2] * a[2] + a[3] * a[3]);
#pragma unroll
                    for (int c = 0; c < 4; ++c) acc = __builtin_amdgcn_mfma_f32_32x32x2f32(wv[c], a[c], acc, 0, 0, 0); }
            }
            ssq += __shfl_xor(ssq, 32);
            const float rstd = 1.0f / sqrtf(ssq * (1.f / DM) + EPS);
            float lg[16];
#pragma unroll
            for (int r = 0; r < 16; ++r) lg[r] = acc[r] * rstd + F.b_router[(r & 3) + 8 * (r >> 2) + 4 * h];
            float v[8]; int id[8]; unsigned used = 0u;
#pragma unroll
            for (int k = 0; k < 4; ++k) { float best = -3.0e38f; int bi = 0, br = 0;
#pragma unroll
                for (int r = 0; r < 16; ++r) { const bool c = !((used >> r) & 1u) && lg[r] > best; best = c ? lg[r] : best; bi = c ? ((r & 3) + 8 * (r >> 2) + 4 * h) : bi; br = c ? r : br; }
                used |= 1u << br; v[k] = best; id[k] = bi; }
#pragma unroll
            for (int k = 0; k < 4; ++k) { v[4 + k] = __shfl_xor(v[k], 32); id[4 + k] = __shfl_xor(id[k], 32); }
            float tv[4]; int ti[4]; unsigned u2 = 0u;
#pragma unroll
            for (int k = 0; k < 4; ++k) { float best = -3.0e38f; int bi = 1 << 30, bc = 0;
#pragma unroll
                for (int c8 = 0; c8 < 8; ++c8) { const bool c = !((u2 >> c8) & 1u) && (v[c8] > best || (v[c8] == best && id[c8] < bi)); best = c ? v[c8] : best; bi = c ? id[c8] : bi; bc = c ? c8 : bc; }
                u2 |= 1u << bc; tv[k] = best; ti[k] = bi; }
            float den = 0.f, pr[4];
#pragma unroll
            for (int k = 0; k < 4; ++k) { pr[k] = __expf(tv[k] - tv[0]); den += pr[k]; }
            const float rden = 1.0f / den;
            if (h == 0) { const int tl = F.wave * 32 + j; rsd[tl] = rstd;
#pragma unroll
                for (int k = 0; k < 4; ++k) { sel_e[tl * 4 + k] = ti[k]; sel_g[tl * 4 + k] = pr[k] * rden; } }
        }
        __syncthreads();
        if (F.tid < 128) {
#pragma unroll
            for (int k = 0; k < 4; ++k) lpos[F.tid * 4 + k] = atomicAdd((int*)&hist[sel_e[F.tid * 4 + k]], 1); }
        __syncthreads();
        if (F.tid < 32) base[F.tid] = (int)__hip_atomic_fetch_add(&cnt[64 * F.tid], (unsigned)hist[F.tid], __ATOMIC_RELAXED, __HIP_MEMORY_SCOPE_AGENT);
        __syncthreads();
        if (F.tid < 128) {
#pragma unroll
            for (int k = 0; k < 4; ++k) { const int e = sel_e[F.tid * 4 + k]; const size_t sl = (size_t)e * ECAP + base[e] + lpos[F.tid * 4 + k];
                STOK[sl] = (tok0 + F.tid) * 4 + k; SGATE[sl] = sel_g[F.tid * 4 + k]; SRSTD[sl] = rsd[F.tid]; } }
    }
    __syncthreads();
}

struct RbTab { LAS int* e; LAS int* start; LAS int* rows; LAS int* off; int nrb; };
__device__ __forceinline__ RbTab build_rbtab(Ctx& F) {
    RbTab T; LAS int* m = (LAS int*)(F.lds + MISC_OFF + 1024);
    T.e = m; T.start = m + 640; T.rows = m + 1280; T.off = m + 1920;
    LAS int* nrbp = m + 1920 + 64;
    const unsigned* cnt = (const unsigned*)(F.ws + WS_CTL) + CW_CNT;
    __syncthreads();
    if (F.tid == 0) { int off = 0, rb = 0;
        for (int e = 0; e < NE; ++e) { const int c = (int)__hip_atomic_load(&cnt[64 * e], __ATOMIC_RELAXED, __HIP_MEMORY_SCOPE_AGENT); T.off[e] = off;
            for (int i = 0; i * 256 < c; ++i) { T.e[rb] = e; T.start[rb] = i * 256; T.rows[rb] = (c - i * 256) < 256 ? (c - i * 256) : 256; ++rb; }
            off += c; }
        T.off[NE] = off; *nrbp = rb; }
    __syncthreads();
    T.nrb = *nrbp;
    return T;
}

__device__ __forceinline__ float swiglu_(float hg, float hu) {
    hg = fminf(hg, SW_LIMIT); hu = fminf(fmaxf(hu, -SW_LIMIT), SW_LIMIT);
    return (hu + 1.0f) * (hg * sigmoidf_(SW_ALPHA * hg));
}
struct P4Pol {
    static constexpr bool PERM = true, FP8 = true, GATHER = true;
    const char* A; const char* B; unsigned char* hid; const int* stok; const float* srstd; const float* bg; const float* bu; RbTab T; int G, c, flags;
    __device__ __forceinline__ bool next(int i, gm::Unit& u) const { int pm, pn; if (!gm::order_next(i, G, c, T.nrb, 8, pm, pn)) return false;
        u.pm = pm; u.pn = pn; u.e = __builtin_amdgcn_readfirstlane(T.e[pm]); u.rows = __builtin_amdgcn_readfirstlane(T.rows[pm]); u.A = A; u.B = B + ((size_t)(u.e * 8 + pn) * 256) * 1024; return true; }
    __device__ __forceinline__ void a_off(const gm::Unit& u, int R0, int C0, int R1, int C1, unsigned (&vo)[2][2]) const {
        const int* lst = stok + (size_t)u.e * ECAP + T.start[u.pm];
#pragma unroll
        for (int h = 0; h < 2; ++h) { int r0 = R0 + 128 * h, r1 = R1 + 128 * h; r0 = r0 < u.rows ? r0 : 0; r1 = r1 < u.rows ? r1 : 0;
            vo[h][0] = (unsigned)(lst[r0] >> 2) * 1024u + (unsigned)C0 * 2u; vo[h][1] = (unsigned)(lst[r1] >> 2) * 1024u + (unsigned)C1 * 2u; }
    }
    __device__ __forceinline__ void idx_prefetch(const gm::Unit& u, LAS unsigned char* lds, int wid) const {
        if (wid < 4) { const int* lst = stok + (size_t)u.e * ECAP + __builtin_amdgcn_readfirstlane(T.start[u.pm]) + wid * 64 + (threadIdx.x & 63);
            __builtin_amdgcn_global_load_lds((const unsigned*)lst, (LAS unsigned*)(lds + IDX_OFF + wid * 256), 4, 0, 0); } }
    __device__ __forceinline__ void a_off_lds(const gm::Unit& u, int, int, int, int, LAS unsigned char* lds, unsigned (&vo)[2][2]) const {
        const LAS int* ib = (const LAS int*)(lds + IDX_OFF);
        int tq = threadIdx.x; asm volatile("" : "+v"(tq));
        int R0, C0, R1, C1; gm::stage_rc(tq * 16, R0, C0); gm::stage_rc(tq * 16 + 8192, R1, C1);
#pragma unroll
        for (int h = 0; h < 2; ++h) { int r0 = R0 + 128 * h, r1 = R1 + 128 * h; r0 = r0 < u.rows ? r0 : 0; r1 = r1 < u.rows ? r1 : 0;
            vo[h][0] = (unsigned)(ib[r0] >> 2) * 1024u + (unsigned)C0 * 2u; vo[h][1] = (unsigned)(ib[r1] >> 2) * 1024u + (unsigned)C1 * 2u; }
    }
    __device__ __forceinline__ size_t koff(int t) const { return (size_t)t * 128; }
    __device__ __forceinline__ void acc_init(f32x4 (&acc)[2][2][4][2], const gm::Unit&, int, int, int, int) const { gm::acc_zero(acc); }
    __device__ __forceinline__ void meta_prefetch(const gm::Unit& u, LAS unsigned char* lds, int wid, int ui) const {
        LAS unsigned char* mb = lds + META_OFF + (ui & 1) * META_BYTES; const int ln = threadIdx.x & 63;
        const float* src = (wid < 4) ? srstd + (size_t)u.e * ECAP + __builtin_amdgcn_readfirstlane(T.start[u.pm]) + wid * 64 + ln
                                     : ((wid < 6) ? bg : bu) + u.e * DFF + u.pn * 128 + (wid & 1) * 64 + ln;
        __builtin_amdgcn_global_load_lds((const unsigned*)src, (LAS unsigned*)(mb + wid * 256), 4, 0, 0);
    }
    __device__ __forceinline__ void epi(const f32x4 (&acc)[2][2][4][2], const gm::Unit& u, int wr, int wc, int fr, int fq, LAS unsigned char* lds, int ui) const {
        if (flags & 4) { if (acc[0][0][0][0][0] == 1.2345e-30f) hid[0] = 1; return; }
        const LAS unsigned char* mb = lds + META_OFF + (ui & 1) * META_BYTES;
        const size_t grow = (size_t)T.off[u.e] + T.start[u.pm];
        const int jl = wc * 32 + 8 * fq, j0 = u.pn * 128 + jl;
        const f32x4 bg0 = *(const LAS f32x4*)(mb + 1024 + jl * 4), bg1 = *(const LAS f32x4*)(mb + 1024 + jl * 4 + 16), bu0 = *(const LAS f32x4*)(mb + 1536 + jl * 4), bu1 = *(const LAS f32x4*)(mb + 1536 + jl * 4 + 16);
#pragma unroll
        for (int ai = 0; ai < 2; ++ai)
#pragma unroll
            for (int m = 0; m < 4; ++m) { const int r = ai * 128 + wr * 64 + m * 16 + fr;
                if (r < u.rows) { const float rs = *(const LAS float*)(mb + r * 4) * W8_INV;
                    const f32x4 g0 = acc[ai][0][m][0] * rs + bg0, g1 = acc[ai][0][m][1] * rs + bg1, u0 = acc[ai][1][m][0] * rs + bu0, u1 = acc[ai][1][m][1] * rs + bu1;
                    *(u32x2*)(hid + (grow + r) * DFF + j0) = (u32x2){pk4_fp8(swiglu_(g0[0], u0[0]), swiglu_(g0[1], u0[1]), swiglu_(g0[2], u0[2]), swiglu_(g0[3], u0[3])),
                                                                     pk4_fp8(swiglu_(g1[0], u1[0]), swiglu_(g1[1], u1[1]), swiglu_(g1[2], u1[2]), swiglu_(g1[3], u1[3]))}; } }
    }
};
__device__ __forceinline__ void phase_gateup(Ctx& F) {
    RbTab T = build_rbtab(F);
    P4Pol S{(const char*)(F.ws + WS_H1Q), (const char*)(F.ws + WS_WGU), F.ws + WS_HID, (const int*)(F.ws + WS_STOK), (const float*)(F.ws + WS_SRSTD), F.b_gate, F.b_up, T, F.G, F.vc, F.flags};
    gm::gemm_phase<P4Pol>(F.lds, S);
}

struct P5Pol {
    static constexpr bool PERM = true, FP8 = true, GATHER = false;
    const char* A; const char* B; const int* stok; const float* sgate; const float* bd; unsigned char* y; int* tslot; RbTab T; int G, c, flags;
    __device__ __forceinline__ bool next(int i, gm::Unit& u) const { int pm, pn; if (!gm::order_next(i, G, c, T.nrb, 4, pm, pn)) return false;
        u.pm = pm; u.pn = pn; u.e = __builtin_amdgcn_readfirstlane(T.e[pm]); u.rows = __builtin_amdgcn_readfirstlane(T.rows[pm]);
        const int grow = __builtin_amdgcn_readfirstlane(T.off[u.e] + T.start[pm]); u.A = A + (size_t)grow * 1024; u.B = B + ((size_t)u.e * 1024 + pn * 256) * 1024; return true; }
    __device__ __forceinline__ void a_off(const gm::Unit&, int R0, int C0, int R1, int C1, unsigned (&vo)[2][2]) const {
        vo[0][0] = (unsigned)(R0 * 1024 + C0 * 2); vo[0][1] = (unsigned)(R1 * 1024 + C1 * 2); vo[1][0] = vo[0][0] + 128u * 1024u; vo[1][1] = vo[0][1] + 128u * 1024u; }
    __device__ __forceinline__ size_t koff(int t) const { return (size_t)t * 128; }
    __device__ __forceinline__ void acc_init(f32x4 (&acc)[2][2][4][2], const gm::Unit&, int, int, int, int) const { gm::acc_zero(acc); }
    __device__ __forceinline__ void meta_prefetch(const gm::Unit& u, LAS unsigned char* lds, int wid, int ui) const {
        LAS unsigned char* mb = lds + META_OFF + (ui & 1) * META_BYTES; const int ln = threadIdx.x & 63;
        const size_t sb = (size_t)u.e * ECAP + __builtin_amdgcn_readfirstlane(T.start[u.pm]) + (wid & 3) * 64 + ln;
        const unsigned* src = (wid < 4) ? (const unsigned*)(stok + sb) : (const unsigned*)(sgate + sb);
        __builtin_amdgcn_global_load_lds(src, (LAS unsigned*)(mb + wid * 256), 4, 0, 0);
        if (wid < 4) __builtin_amdgcn_global_load_lds((const unsigned*)(bd + u.e * DM + u.pn * 256 + wid * 64 + ln), (LAS unsigned*)(mb + 2048 + wid * 256), 4, 0, 0);
    }
    __device__ __forceinline__ void epi(const f32x4 (&acc)[2][2][4][2], const gm::Unit& u, int wr, int wc, int fr, int fq, LAS unsigned char* lds, int ui) const {
        if (flags & 8) { if (acc[0][0][0][0][0] == 1.2345e-30f) y[0] = 1; return; }
        const LAS unsigned char* mb = lds + META_OFF + (ui & 1) * META_BYTES;
        const int cl = wc * 32 + 8 * fq, col0 = u.pn * 256 + cl; const size_t grow = (size_t)T.off[u.e] + T.start[u.pm];
        f32x4 bv[2][2];
#pragma unroll
        for (int bj = 0; bj < 2; ++bj) { bv[bj][0] = *(const LAS f32x4*)(mb + 2048 + (bj * 128 + cl) * 4); bv[bj][1] = *(const LAS f32x4*)(mb + 2048 + (bj * 128 + cl) * 4 + 16); }
#pragma unroll
        for (int ai = 0; ai < 2; ++ai)
#pragma unroll
            for (int m = 0; m < 4; ++m) { const int r = ai * 128 + wr * 64 + m * 16 + fr;
                if (r < u.rows) { const int tr = *(const LAS int*)(mb + r * 4); const float gt = *(const LAS float*)(mb + 1024 + r * 4) * Y8_SCALE, gw = gt * W8_INV;
                    unsigned char* p = y + (grow + r) * DM + col0;
                    if (u.pn == 0 && wc == 0 && fq == 0) tslot[tr] = (int)(grow + r);
#pragma unroll
                    for (int bj = 0; bj < 2; ++bj) { const f32x4 v0 = acc[ai][bj][m][0] * gw + bv[bj][0] * gt, v1 = acc[ai][bj][m][1] * gw + bv[bj][1] * gt;
                        *(u32x2*)(p + bj * 128) = (u32x2){pk4_fp8(v0[0], v0[1], v0[2], v0[3]), pk4_fp8(v1[0], v1[1], v1[2], v1[3])}; } } }
    }
};
__device__ __forceinline__ void phase_down(Ctx& F) {
    RbTab T = build_rbtab(F);
    P5Pol S{(const char*)(F.ws + WS_HID), (const char*)(F.ws + WS_WDN), (const int*)(F.ws + WS_STOK), (const float*)(F.ws + WS_SGATE), F.b_down, F.ws + WS_Y, (int*)(F.ws + WS_TSLOT), T, F.G, F.vc, F.flags};
    gm::gemm_phase<P5Pol>(F.lds, S);
}

__device__ __forceinline__ void phase_final(Ctx& F) {
    const int gw = F.bid * NWAVES + F.wave, NGW = F.G * NWAVES;
    const unsigned char* Y = F.ws + WS_Y; const int* TS = (const int*)(F.ws + WS_TSLOT);
    for (int m = gw; m < NTOK; m += NGW) {
        f32x4* xr = (f32x4*)(F.out + (size_t)m * DM) + F.lane; const f32x4* gr = (const f32x4*)F.fin_gain + F.lane;
        const u32x2* hr = (const u32x2*)((const bf16*)(F.ws + WS_H1B) + (size_t)m * DM) + F.lane;
        const int s0 = __builtin_amdgcn_readfirstlane(TS[m * 4]), s1 = __builtin_amdgcn_readfirstlane(TS[m * 4 + 1]), s2 = __builtin_amdgcn_readfirstlane(TS[m * 4 + 2]), s3 = __builtin_amdgcn_readfirstlane(TS[m * 4 + 3]);
        const unsigned* y0 = (const unsigned*)(Y + (size_t)s0 * DM) + F.lane; const unsigned* y1 = (const unsigned*)(Y + (size_t)s1 * DM) + F.lane;
        const unsigned* y2 = (const unsigned*)(Y + (size_t)s2 * DM) + F.lane; const unsigned* y3 = (const unsigned*)(Y + (size_t)s3 * DM) + F.lane;
        f32x4 v[4]; float s = 0.f;
#pragma unroll
        for (int j = 0; j < 4; ++j) { const u32x2 hb = hr[64 * j]; v[j] = (f32x4){bflo(hb.x), bfhi(hb.x), bflo(hb.y), bfhi(hb.y)}; const unsigned a = y0[64 * j], b = y1[64 * j], c = y2[64 * j], d = y3[64 * j];
            const f32x2 al = __builtin_amdgcn_cvt_pk_f32_fp8((int)a, false), ah = __builtin_amdgcn_cvt_pk_f32_fp8((int)a, true), bl = __builtin_amdgcn_cvt_pk_f32_fp8((int)b, false), bh = __builtin_amdgcn_cvt_pk_f32_fp8((int)b, true);
            const f32x2 cl = __builtin_amdgcn_cvt_pk_f32_fp8((int)c, false), ch = __builtin_amdgcn_cvt_pk_f32_fp8((int)c, true), dl = __builtin_amdgcn_cvt_pk_f32_fp8((int)d, false), dh = __builtin_amdgcn_cvt_pk_f32_fp8((int)d, true);
            v[j].x += ((al[0] + bl[0]) + (cl[0] + dl[0])) * Y8_INV; v[j].y += ((al[1] + bl[1]) + (cl[1] + dl[1])) * Y8_INV;
            v[j].z += ((ah[0] + bh[0]) + (ch[0] + dh[0])) * Y8_INV; v[j].w += ((ah[1] + bh[1]) + (ch[1] + dh[1])) * Y8_INV;
            s += (v[j].x * v[j].x + v[j].y * v[j].y) + (v[j].z * v[j].z + v[j].w * v[j].w); }
        const float rstd = 1.0f / sqrtf(wave_sum(s) * (1.f / DM) + EPS);
#pragma unroll
        for (int j = 0; j < 4; ++j) xr[64 * j] = v[j] * rstd * gr[64 * j];
    }
}

struct Args { const float* in[17]; float* out; unsigned char* ws; int ph_lo, ph_hi, flags, pad; };
constexpr int NPHASE = 9;
__global__ void __launch_bounds__(NTHR, 2) fwd_kernel(Args args) {
    extern __shared__ __attribute__((aligned(16))) unsigned char lds_raw[];
    Ctx F;
    F.x = args.in[0]; F.w_in = args.in[1]; F.w_out = args.in[2]; F.lb_logits = args.in[3]; F.hg_gain = args.in[4]; F.sb_gain = args.in[5]; F.mix_gain = args.in[6]; F.ffn_gain = args.in[7];
    F.w_router = args.in[8]; F.b_router = args.in[9]; F.w_gate = args.in[10]; F.b_gate = args.in[11]; F.w_up = args.in[12]; F.b_up = args.in[13]; F.w_down = args.in[14]; F.b_down = args.in[15]; F.fin_gain = args.in[16];
    F.out = args.out; F.ws = args.ws; F.lds = (LAS unsigned char*)lds_raw;
    F.tid = threadIdx.x; F.lane = F.tid & 63; F.wave = __builtin_amdgcn_readfirstlane(F.tid >> 6); F.G = gridDim.x; F.bid = blockIdx.x; F.flags = args.flags;
    volatile LAS unsigned* MISC = (volatile LAS unsigned*)(F.lds + MISC_OFF);
    if (F.tid < 64) MISC[F.tid] = 0u;
    __syncthreads();
    const int lo = args.ph_lo, hi = args.ph_hi;
    XcdBarrier bar; bar.bar = (unsigned*)(F.ws + WS_CTL) + CW_BAR; bar.x = 0; bar.st = nullptr;
    if (hi - lo > 1) bar = xcd_barrier_post((unsigned*)(F.ws + WS_CTL) + CW_BAR, MISC + 8);
#ifdef TEST_PHASE
#define IN(k) ((k) == TEST_PHASE && lo <= (k))
#else
#define IN(k) (lo <= (k) && (k) < hi)
#endif
#define SEAM(k) do { if (IN(k) && IN((k) + 1)) xcd_barrier(bar); } while (0)
    if (IN(0)) { phase0(F); } SEAM(0);
    F.vc = F.bid;
    if (hi - lo > 1 && IN(0)) {
        if (F.tid == 0) { bool ok = (F.G % 8 == 0); unsigned* bw = (unsigned*)(F.ws + WS_CTL) + CW_BAR;
            for (unsigned j = 0; j < 16; ++j) { const unsigned c = xb_ld(&bw[XB_XCNT(j)]); ok = ok && (j < 8 ? c == (unsigned)F.G / 8 : c == 0u); }
            MISC[3] = ok ? (MISC[10] * 8u + bar.x) : (unsigned)F.bid; }
        __syncthreads();
        F.vc = __builtin_amdgcn_readfirstlane((int)MISC[3]);
    }
    if (IN(1)) { phase1(F); } SEAM(1);
    if (IN(2)) { hgrn_passA(F);
        if (F.tid < 256) *(LAS f32x4*)(F.lds + 122880 + F.tid * 16) = *(const f32x4*)(F.ffn_gain + F.tid * 4);
        __syncthreads();
        if (F.wave < 4) sb_attn_fast(F);
        moe_convert_jobs(F, (LAS float*)(F.lds + 32768 + F.wave * 10240), (const LAS float*)(F.lds + 122880));
        } SEAM(2);
    if (IN(3)) { hgrn_passB(F); if (hi - lo > 1) xcd_barrier(bar); hgrn_passC(F); } SEAM(3);
    if (IN(4)) { phase3(F); } SEAM(4);
    if (IN(5)) { phase_router_fast(F); } SEAM(5);
    if (IN(6)) { phase_gateup(F); } SEAM(6);
    if (IN(7)) { phase_down(F); } SEAM(7);
    if (IN(8)) { phase_final(F); }
#undef IN
#undef SEAM
}

extern "C" void kernel_launch(void* const* d_in, const int* in_sizes, int n_in, void* d_out, int out_size, void* d_ws, size_t ws_size, hipStream_t stream) {
    static int grid = 0;
    if (grid == 0) {
        if (n_in != 17 || in_sizes[0] != NTOK * DM || out_size != NTOK * DM || ws_size < WS_END2) {
            fprintf(stderr, "kernel_launch: unexpected shapes / workspace (n_in %d, in0 %d, out %d, ws %zu, need %zu); nothing launched\n", n_in, n_in > 0 ? in_sizes[0] : -1, out_size, ws_size, (size_t)WS_END); grid = -1; return; }
        int dev = 0, cus = 0;
        if (hipGetDevice(&dev) != hipSuccess || hipDeviceGetAttribute(&cus, hipDeviceAttributeMultiprocessorCount, dev) != hipSuccess) { grid = -1; return; }
        if (hipFuncSetAttribute((const void*)fwd_kernel, hipFuncAttributeMaxDynamicSharedMemorySize, LDS_BYTES) != hipSuccess) { fprintf(stderr, "kernel_launch: hipFuncSetAttribute failed\n"); grid = -1; return; }
        int per_cu = 0;
        if (hipOccupancyMaxActiveBlocksPerMultiprocessor(&per_cu, (const void*)fwd_kernel, NTHR, LDS_BYTES) != hipSuccess || per_cu < 1) fprintf(stderr, "kernel_launch: occupancy query reports %d\n", per_cu);
        (void)hipGetLastError();
        grid = cus;
    }
    if (grid < 0) return;
    (void)hipMemsetAsync((char*)d_ws + WS_CTL, 0, CTL_BYTES, stream);
    Args a{};
    for (int i = 0; i < 17; ++i) a.in[i] = (const float*)d_in[i];
    a.out = (float*)d_out; a.ws = (unsigned char*)d_ws;
#if N_LAUNCH_MODE == 1
#ifdef PROBE_K
    a.ph_lo = 0; a.ph_hi = PROBE_K; a.flags = PROBE_FLAGS;
    hipLaunchKernelGGL(fwd_kernel, dim3(grid), dim3(NTHR), LDS_BYTES, stream, a);
    (void)hipMemsetAsync((char*)d_ws + WS_CTL, 0, CTL_BYTES, stream);
#endif
    a.ph_lo = 0; a.ph_hi = NPHASE; a.flags = 0;
    hipLaunchKernelGGL(fwd_kernel, dim3(grid), dim3(NTHR), LDS_BYTES, stream, a);
#else
    for (int p = 0; p < NPHASE; ++p) { a.ph_lo = p; a.ph_hi = p + 1; hipLaunchKernelGGL(fwd_kernel, dim3(grid), dim3(NTHR), LDS_BYTES, stream, a); }
#endif
}
```

```cpp
#include <hip/hip_runtime.h>
#include <cstdio>
#include <cstdint>

#ifndef PROBE_FLAGS
#define PROBE_FLAGS 0
#endif
#ifndef N_LAUNCH_MODE
#define N_LAUNCH_MODE 1
#endif

#define LAS __attribute__((address_space(3)))
typedef unsigned short bf16;
typedef short bf16x8 __attribute__((ext_vector_type(8)));
typedef float f32x2 __attribute__((ext_vector_type(2)));
typedef float f32x4 __attribute__((ext_vector_type(4)));
typedef float f32x16 __attribute__((ext_vector_type(16)));
typedef unsigned u32x2 __attribute__((ext_vector_type(2)));
typedef unsigned u32x4 __attribute__((ext_vector_type(4)));

constexpr int NTOK = 32768, DM = 1024, SEQ = 8192, NBATCH = 4;
constexpr int INC = 3584;
constexpr int C_HQ = 0, C_HF = 512, C_HI = 1024, C_HG = 1536, C_SQ = 2048, C_SK = 2560, C_SV = 3072;
constexpr int NE = 32, TOPK = 4, DFF = 1024, NK = NTOK * TOPK;
constexpr int ECAP = NTOK;
constexpr float EPS = 1e-5f, SW_LIMIT = 7.0f, SW_ALPHA = 1.702f;
constexpr float W8_SCALE = 64.0f, W8_INV = 1.0f / 64.0f;
constexpr float SB_PEXIT = 1.0e-30f;

constexpr size_t WS_WDN = 0;
constexpr size_t WS_WGU = WS_WDN + 67108864;
constexpr size_t WS_C = WS_WGU + 134217728;
constexpr size_t C_BYTES = (size_t)(NK + 256) * 2048;
constexpr size_t WS_D = WS_C + C_BYTES;
constexpr size_t WS_E = WS_D + 67108864;
constexpr size_t WS_H1B = WS_C;
constexpr size_t WS_MIX = WS_D;
constexpr size_t WS_H1Q = WS_WDN + 33554432;
constexpr size_t WS_PROJ = WS_C;
constexpr size_t WS_WIN = WS_PROJ + (size_t)NTOK * INC * 2;
constexpr size_t WS_WOUT = WS_WIN + (size_t)INC * 1024 * 2;
constexpr size_t WS_HST = WS_WOUT + (size_t)1024 * 1024 * 2;
constexpr size_t WS_HDEC = WS_HST + (size_t)256 * 65536;
static_assert(WS_HDEC + 256 * 128 * 4 <= WS_C + C_BYTES, "C region");
constexpr size_t WS_CTL = WS_E;
constexpr size_t CTL_BYTES = 1u << 20;
constexpr size_t WS_RSTD = WS_CTL + CTL_BYTES;
constexpr size_t WS_STOK = WS_RSTD + (size_t)NTOK * 4;
constexpr size_t WS_SGATE = WS_STOK + (size_t)NE * ECAP * 4;
constexpr size_t WS_SRSTD = WS_SGATE + (size_t)NE * ECAP * 4;
constexpr size_t WS_END = WS_SRSTD + (size_t)NE * ECAP * 4;
constexpr size_t HID_BYTES = (size_t)(NK + 256) * 1024;
constexpr size_t WS_HID = WS_C + C_BYTES - HID_BYTES;
constexpr size_t WS_Y = WS_WGU;
static_assert(WS_Y + (size_t)NK * DM <= WS_HID, "y vs hidden");
constexpr float Y8_SCALE = 16.0f, Y8_INV = 1.0f / 16.0f;
constexpr size_t WS_TSLOT = WS_END;
constexpr size_t WS_END2 = WS_TSLOT + (size_t)NTOK * 4 * 4;
constexpr int CW_JOB = 32;
constexpr int CW_CNT = 64;
constexpr int CW_BAR = 4096;

constexpr int RING_BYTES = 131072;
constexpr int MISC_OFF = RING_BYTES;
constexpr int IDX_OFF = MISC_OFF + 9216;
constexpr int META_OFF = MISC_OFF + 10240, META_BYTES = 3072;
constexpr int LDS_BYTES = 147456;
constexpr int NWAVES = 8, NTHR = 512;

__device__ __forceinline__ unsigned f2bf(float f) { unsigned u = __builtin_bit_cast(unsigned, f); return (u + 0x7fffu + ((u >> 16) & 1u)) >> 16; }
__device__ __forceinline__ unsigned pk2(float lo, float hi) { return f2bf(lo) | (f2bf(hi) << 16); }
__device__ __forceinline__ unsigned pk4_fp8(float a, float b, float c, float d) { int w = __builtin_amdgcn_cvt_pk_fp8_f32(a, b, 0, false); w = __builtin_amdgcn_cvt_pk_fp8_f32(c, d, w, true); return (unsigned)w; }
__device__ __forceinline__ float bf2f(unsigned b) { return __builtin_bit_cast(float, b << 16); }
__device__ __forceinline__ float bflo(unsigned w) { return __builtin_bit_cast(float, w << 16); }
__device__ __forceinline__ float bfhi(unsigned w) { return __builtin_bit_cast(float, w & 0xffff0000u); }
__device__ __forceinline__ float wave_sum(float v) {
#pragma unroll
    for (int o = 1; o < 64; o <<= 1) v += __shfl_xor(v, o);
    return v;
}
__device__ __forceinline__ float sigmoidf_(float x) { return __builtin_amdgcn_rcpf(1.0f + __builtin_amdgcn_exp2f(-1.44269504f * x)); }
__device__ __forceinline__ float siluf_(float x) { return x * sigmoidf_(x); }
__device__ __forceinline__ float exp_raw(float x) { return __builtin_amdgcn_exp2f(1.44269504f * x); }
__device__ __forceinline__ float softplusf_(float z) { return fmaxf(z, 0.f) + __logf(1.0f + __expf(-fabsf(z))); }
#define LDS_WAIT() asm volatile("s_waitcnt lgkmcnt(0)" ::: "memory")
#define VM_WAIT() asm volatile("s_waitcnt vmcnt(0)" ::: "memory")

struct Ctx {
    const float *x, *w_in, *w_out, *lb_logits, *hg_gain, *sb_gain, *mix_gain, *ffn_gain, *w_router, *b_router, *w_gate, *b_gate, *w_up, *b_up, *w_down, *b_down, *fin_gain;
    float* out; unsigned char* ws;
    LAS unsigned char* lds;
    int tid, lane, wave, G, bid, flags, vc;
};

#define XB_TMO      128
#define XB_XCNT(j)  (256  + 64 * (j))
#define XB_XSUB(j)  (1280 + 64 * (j))
#define XB_XGEN(j)  (2304 + 64 * (j))
#define XB_TOP      3328
#define XB_TOPGEN   3392
#define XCD_BAR_WORDS 3456
#define XB_SPIN_CAP (1u << 22)
__device__ __forceinline__ unsigned xb_ld(unsigned* p)              { return __hip_atomic_load(p, __ATOMIC_RELAXED, __HIP_MEMORY_SCOPE_AGENT); }
__device__ __forceinline__ unsigned xb_add(unsigned* p, unsigned v) { return __hip_atomic_fetch_add(p, v, __ATOMIC_RELAXED, __HIP_MEMORY_SCOPE_AGENT); }
__device__ __forceinline__ unsigned xb_xcc_id() { return (unsigned)__builtin_amdgcn_s_getreg((3 << 11) | 20) & 0xFu; }
#define XB_SPIN(cond, bar) do { unsigned _sp = 0; while (cond) { __builtin_amdgcn_s_sleep(1); \
    if ((++_sp & 255u) == 0u) { if (xb_ld(&(bar)[XB_TMO])) break; if (_sp > XB_SPIN_CAP) { atomicAdd(&(bar)[XB_TMO], 1u); break; } } } } while (0)
struct XcdBarrier { unsigned* bar; unsigned x; volatile LAS unsigned* st; };
__device__ __forceinline__ XcdBarrier xcd_barrier_post(unsigned* bar, volatile LAS unsigned* st) {
    XcdBarrier b; b.bar = bar; b.x = xb_xcc_id(); b.st = st;
    if (threadIdx.x == 0) st[2] = xb_add(&bar[XB_XCNT(b.x)], 1u);
    return b;
}
__device__ __forceinline__ void xcd_barrier_complete(unsigned* bar, unsigned x, unsigned& nloc, unsigned& nx) {
    const unsigned G = gridDim.x * gridDim.y * gridDim.z;
    unsigned sum, cnt, mine, sp = 0u;
    for (;;) {
        sum = 0u; cnt = 0u; mine = 0u;
#pragma unroll
        for (unsigned j = 0; j < 16; ++j) { const unsigned c = xb_ld(&bar[XB_XCNT(j)]); sum += c; cnt += (c > 0u) ? 1u : 0u; mine = (j == x) ? c : mine; }
        if (sum == G) break;
        __builtin_amdgcn_s_sleep(1);
        if ((++sp & 255u) == 0u) { if (xb_ld(&bar[XB_TMO])) break; if (sp > XB_SPIN_CAP) { atomicAdd(&bar[XB_TMO], 1u); break; } }
    }
    nloc = mine > 0u ? mine : 1u; nx = cnt > 0u ? cnt : 1u;
}
__device__ __forceinline__ void xcd_barrier(const XcdBarrier& b) {
    asm volatile("s_waitcnt vmcnt(0)" ::: "memory");
    __syncthreads();
    if (threadIdx.x == 0) {
        unsigned* bar = b.bar;
        __builtin_amdgcn_s_waitcnt(0);
        unsigned nloc = b.st[0], nx = b.st[1];
        if (nloc == 0u) { xcd_barrier_complete(bar, b.x, nloc, nx); b.st[0] = nloc; b.st[1] = nx; }
        const unsigned old = xb_add(&bar[XB_XSUB(b.x)], 1u);
        const unsigned gen = old / nloc;
        if (old + 1u == (gen + 1u) * nloc) {
            __builtin_amdgcn_fence(__ATOMIC_RELEASE, "agent");
            asm volatile("s_waitcnt vmcnt(0)" ::: "memory");
            const unsigned og = xb_add(&bar[XB_TOP], 1u);
            const unsigned tg = og / nx;
            if (og + 1u == (tg + 1u) * nx) xb_add(&bar[XB_TOPGEN], 1u);
            else XB_SPIN(xb_ld(&bar[XB_TOPGEN]) == tg, bar);
            __builtin_amdgcn_fence(__ATOMIC_ACQUIRE, "agent");
            xb_add(&bar[XB_XGEN(b.x)], 1u);
            asm volatile("s_waitcnt vmcnt(0)" ::: "memory");
        } else {
            XB_SPIN(xb_ld(&bar[XB_XGEN(b.x)]) == gen, bar);
            __builtin_amdgcn_fence(__ATOMIC_ACQUIRE, "agent");
            asm volatile("s_waitcnt vmcnt(0)" ::: "memory");
        }
    }
    __syncthreads();
}

namespace gm {
constexpr int BM = 256, BK = 64, HALF = 128, HTB = HALF * BK * 2, NXCD = 8, WGM = 8;
typedef int v8i32 __attribute__((ext_vector_type(8)));
__device__ __forceinline__ int lds_byte(int r, int c) { const int st = (r >> 4) * 2 + (c >> 5), rr = r & 15, cc = c & 31, ob = rr * 64 + cc * 2; return st * 1024 + (ob ^ (((ob >> 9) & 1) << 5)); }
__device__ __forceinline__ void stage_rc(int b, int& R, int& C) { const int st = b / 1024, sb = b % 1024, swz = sb ^ (((sb >> 9) & 1) << 5); R = (st >> 1) * 16 + swz / 64; C = (st & 1) * 32 + (swz % 64) / 2; }
__device__ __forceinline__ int perm32(int rho) { const int n = rho >> 4, i = rho & 15; return 8 * (i >> 2) + 4 * n + (i & 3); }
__device__ __forceinline__ unsigned cvt_pk_bf16(float lo, float hi) { unsigned r; asm volatile("v_cvt_pk_bf16_f32 %0, %1, %2" : "=v"(r) : "v"(lo), "v"(hi)); return r; }

struct Unit { const char* A; const char* B; int pm, pn, e, rows; };

__device__ __forceinline__ bool order_next(int i, int G, int c, int nM, int nN, int& pm, int& pn) {
    const int nwg = nM * nN; const long L = (long)i * G + c; if (L >= nwg) return false;
    int wgid = (int)L; { const int q = nwg / NXCD, r = nwg % NXCD, xcd = wgid % NXCD, off = wgid / NXCD; wgid = (xcd < r ? xcd * (q + 1) : r * (q + 1) + (xcd - r) * q) + off; }
    const int nig = WGM * nN, gid = wgid / nig, fm = gid * WGM, gsz = (nM - fm) < WGM ? (nM - fm) : WGM;
    pm = fm + ((wgid % nig) % gsz); pn = (wgid % nig) / gsz; return true;
}

__device__ __forceinline__ void acc_zero(f32x4 (&acc)[2][2][4][2]) {
#pragma unroll
    for (int a = 0; a < 2; ++a)
#pragma unroll
        for (int b = 0; b < 2; ++b)
#pragma unroll
            for (int m = 0; m < 4; ++m)
#pragma unroll
                for (int n = 0; n < 2; ++n) acc[a][b][m][n] = (f32x4){0.f, 0.f, 0.f, 0.f};
}
template <class P>
__device__ __forceinline__ void gemm_phase(LAS unsigned char* lds, const P& S) {
    const int tid = threadIdx.x, wid = __builtin_amdgcn_readfirstlane(tid >> 6), lane = tid & 63, wr = wid >> 2, wc = wid & 3, fr = lane & 15, fq = lane >> 4;
    constexpr int NT = P::FP8 ? 8 : 16, KB = P::FP8 ? 1024 : 2048;
    int R0, C0, R1, C1; stage_rc(tid * 16, R0, C0); stage_rc(tid * 16 + 8192, R1, C1);
    unsigned voffB[2];
    { const int Rb0 = P::PERM ? ((R0 & ~31) + perm32(R0 & 31)) : R0, Rb1 = P::PERM ? ((R1 & ~31) + perm32(R1 & 31)) : R1;
      voffB[0] = (unsigned)(Rb0 * KB + C0 * 2); voffB[1] = (unsigned)(Rb1 * KB + C1 * 2); }
    const size_t kstep = (size_t)(BK * 2), hstepB = (size_t)HALF * KB;
    const unsigned ldsw = (unsigned)wid * 1024u;
    const int aoff = lds_byte(wr * 64 + fr, fq * 8), boff = lds_byte(wc * 32 + fr, fq * 8);
#define G_SA(b, h) (((b) * 2 + (h)) * HTB)
#define G_SB(b, h) ((4 + (b) * 2 + (h)) * HTB)
#define G_STAGEB(bufoff, gbase) do { const char* _gb = (gbase); asm volatile("" : "+s"(_gb)); _Pragma("unroll") for (int _i = 0; _i < 2; ++_i) \
        __builtin_amdgcn_global_load_lds((const unsigned*)(_gb + voffB[_i]), (LAS unsigned*)(lds + (bufoff) + ldsw + _i * 8192), 16, 0, 0); } while (0)
#define G_STAGEA(bufoff, gbase, vo, h) do { const char* _gb = (gbase); asm volatile("" : "+s"(_gb)); _Pragma("unroll") for (int _i = 0; _i < 2; ++_i) \
        __builtin_amdgcn_global_load_lds((const unsigned*)(_gb + (vo)[h][_i]), (LAS unsigned*)(lds + (bufoff) + ldsw + _i * 8192), 16, 0, 0); } while (0)
#define G_LD16(off) (*(const LAS bf16x8*)(lds + (off)))
#define G_CAT2(lo, hi) __builtin_bit_cast(v8i32, __builtin_shufflevector(lo, hi, 0, 1, 2, 3, 4, 5, 6, 7, 8, 9, 10, 11, 12, 13, 14, 15))
#define G_LDA(dst, b, h) do { _Pragma("unroll") for (int m = 0; m < 4; ++m) { if constexpr (P::FP8) dst##8[m] = G_CAT2(G_LD16(G_SA(b, h) + aoff + m * 2048), G_LD16(G_SA(b, h) + aoff + m * 2048 + 1024)); \
        else { _Pragma("unroll") for (int k = 0; k < 2; ++k) dst[m][k] = G_LD16(G_SA(b, h) + aoff + m * 2048 + k * 1024); } } } while (0)
#define G_LDB(dst, b, h) do { _Pragma("unroll") for (int n = 0; n < 2; ++n) { if constexpr (P::FP8) dst##8[n] = G_CAT2(G_LD16(G_SB(b, h) + boff + n * 2048), G_LD16(G_SB(b, h) + boff + n * 2048 + 1024)); \
        else { _Pragma("unroll") for (int k = 0; k < 2; ++k) dst[n][k] = G_LD16(G_SB(b, h) + boff + n * 2048 + k * 1024); } } } while (0)
#define G_MMA(ai, bj, At, Bt) do { __builtin_amdgcn_s_setprio(1); _Pragma("unroll") for (int m = 0; m < 4; ++m) _Pragma("unroll") for (int n = 0; n < 2; ++n) { \
        if constexpr (P::FP8) asm volatile("v_mfma_f32_16x16x128_f8f6f4 %0, %1, %2, %0" : "+v"(acc[ai][bj][m][n]) : "v"(Bt##8[n]), "v"(At##8[m])); \
        else { _Pragma("unroll") for (int k = 0; k < 2; ++k) acc[ai][bj][m][n] = __builtin_amdgcn_mfma_f32_16x16x32_bf16(Bt[n][k], At[m][k], acc[ai][bj][m][n], 0, 0, 0); } } \
        __builtin_amdgcn_s_setprio(0); } while (0)
#define G_MMA_TAIL() do { if constexpr (P::FP8) asm volatile("s_nop 15" ::: "memory"); } while (0)
#define G_WAIT_V(n) asm volatile("s_waitcnt vmcnt(" #n ")" ::: "memory")
#define G_WAIT_L(n) asm volatile("s_waitcnt lgkmcnt(" #n ")" ::: "memory")
#define G_BAR __builtin_amdgcn_s_barrier()
#define G_SCHED __builtin_amdgcn_sched_barrier(0)
    Unit cur, nxt; int ui = 0;
    if (!S.next(0, cur)) return;
    f32x4 acc[2][2][4][2];
    S.acc_init(acc, cur, wr, wc, fr, fq);
    bf16x8 At[4][2], B0[2][2], B1[2][2]; v8i32 At8[4], B08[2], B18[2];
    unsigned voA[2][2];
    S.a_off(cur, R0, C0, R1, C1, voA);
    const char* cA = cur.A; const char* cB = cur.B;
    G_STAGEB(G_SB(0, 0), cB); G_STAGEB(G_SB(0, 1), cB + hstepB); G_STAGEA(G_SA(0, 0), cA + S.koff(0), voA, 0); G_STAGEA(G_SA(0, 1), cA + S.koff(0), voA, 1);
    if (wr == 1) G_BAR;
    G_WAIT_V(2); G_BAR;
    G_STAGEB(G_SB(1, 0), cB + kstep); G_STAGEA(G_SA(1, 0), cA + S.koff(1), voA, 0); G_STAGEB(G_SB(1, 1), cB + hstepB + kstep);
    G_WAIT_V(6); G_BAR;
    for (;;) {
        const bool has_next = S.next(ui + 1, nxt);
        const char* nA = has_next ? nxt.A : cA; const char* nB = has_next ? nxt.B : cB;
        S.meta_prefetch(cur, lds, wid, ui);
        if constexpr (P::GATHER) { if (has_next) S.idx_prefetch(nxt, lds, wid); }
#pragma unroll 1
        for (int t = 0; t < NT; t += 2) {
            const bool last = (t == NT - 2);
            const char* a1 = cA + S.koff(t + 1);
            const char* a2 = last ? nA + S.koff(0) : cA + S.koff(t + 2); const char* b2 = last ? nB : cB + (size_t)(t + 2) * kstep;
            const char* a3 = last ? nA + S.koff(1) : cA + S.koff(t + 3); const char* b3 = b2 + kstep;
            G_LDB(B0, 0, 0); G_LDB(B1, 0, 1); G_SCHED; G_LDA(At, 0, 0); G_STAGEA(G_SA(1, 1), a1, voA, 1);
            if constexpr (P::GATHER) { if (last && has_next) S.a_off_lds(nxt, R0, C0, R1, C1, lds, voA); }
            G_WAIT_V(8); G_WAIT_L(0); G_BAR; G_MMA(0, 0, At, B0); G_MMA(0, 1, At, B1); G_MMA_TAIL(); G_BAR; G_SCHED;
            G_LDA(At, 0, 1); G_STAGEB(G_SB(0, 0), b2); G_STAGEB(G_SB(0, 1), b2 + hstepB); G_STAGEA(G_SA(0, 0), a2, voA, 0);
            G_WAIT_V(8); G_WAIT_L(0); G_BAR; G_MMA(1, 0, At, B0); G_MMA(1, 1, At, B1); G_MMA_TAIL(); G_BAR; G_SCHED;
            G_LDB(B0, 1, 0); G_LDB(B1, 1, 1); G_SCHED; G_LDA(At, 1, 0); G_STAGEA(G_SA(0, 1), a2, voA, 1);
            G_WAIT_V(8); G_WAIT_L(0); G_BAR; G_MMA(0, 0, At, B0); G_MMA(0, 1, At, B1); G_MMA_TAIL(); G_BAR; G_SCHED;
            G_LDA(At, 1, 1); G_STAGEB(G_SB(1, 0), b3); G_STAGEB(G_SB(1, 1), b3 + hstepB); G_STAGEA(G_SA(1, 0), a3, voA, 0);
            G_WAIT_V(8); G_WAIT_L(0); G_BAR; G_MMA(1, 0, At, B0); G_MMA(1, 1, At, B1); G_MMA_TAIL(); G_BAR; G_SCHED;
        }
        if (wr == 0) G_BAR;
        S.epi(acc, cur, wr, wc, fr, fq, lds, ui);
        if (!has_next) break;
        S.acc_init(acc, nxt, wr, wc, fr, fq);
        cur = nxt; cA = nA; cB = nB; ++ui;
        if (wr == 1) G_BAR;
    }
    G_WAIT_V(0);
    G_BAR;
#undef G_SA
#undef G_SB
#undef G_STAGEA
#undef G_STAGEB
#undef G_LDA
#undef G_LDB
#undef G_MMA
#undef G_MMA_TAIL
#undef G_CAT2
#undef G_LD16
#undef G_WAIT_V
#undef G_WAIT_L
#undef G_BAR
#undef G_SCHED
}
}

template <bool FP8> __device__ __forceinline__ void p0_tile(const f32x4 (&rg)[8], unsigned (&o)[16], int k0, const LAS float* kscale, float mult, LAS float* scr, int lane) {
    const int kr = lane >> 4, c16 = lane & 15;
    asm volatile("" ::: "memory");
#pragma unroll
    for (int j = 0; j < 8; ++j) *(LAS f32x4*)(scr + (4 * j + kr) * 68 + 4 * c16) = rg[j];
    asm volatile("" ::: "memory");
    float v[32];
#pragma unroll
    for (int k = 0; k < 32; ++k) v[k] = scr[k * 68 + lane] * mult;
    if (kscale) {
#pragma unroll
        for (int q = 0; q < 8; ++q) { const f32x4 g = *(const LAS f32x4*)(kscale + k0 + 4 * q); v[4 * q] *= g[0]; v[4 * q + 1] *= g[1]; v[4 * q + 2] *= g[2]; v[4 * q + 3] *= g[3]; }
    }
    if constexpr (FP8) {
#pragma unroll
        for (int q = 0; q < 8; ++q) o[q] = pk4_fp8(v[4 * q], v[4 * q + 1], v[4 * q + 2], v[4 * q + 3]);
    } else {
#pragma unroll
        for (int q = 0; q < 16; ++q) o[q] = pk2(v[2 * q], v[2 * q + 1]);
    }
    asm volatile("" ::: "memory");
}
template <bool FP8> __device__ __forceinline__ void p0_job(const float* W, int N, unsigned char* WT, int n0, int kq, long drow0, const LAS float* kscale, float mult, LAS float* scr, int lane) {
    const int kr = lane >> 4, c16 = lane & 15;
    const float* src = W + (size_t)(kq * 256 + kr) * N + n0 + 4 * c16;
    f32x4 rr[3][8];
#pragma unroll
    for (int j = 0; j < 8; ++j) rr[0][j] = *(const f32x4*)(src + (size_t)(4 * j) * N);
#pragma unroll
    for (int j = 0; j < 8; ++j) rr[1][j] = *(const f32x4*)(src + (size_t)(32 + 4 * j) * N);
#pragma unroll
    for (int j = 0; j < 8; ++j) rr[2][j] = *(const f32x4*)(src + (size_t)(64 + 4 * j) * N);
    unsigned char* drow = WT + (size_t)(drow0 + lane) * (FP8 ? 1024 : 2048) + (size_t)kq * 256 * (FP8 ? 1 : 2);
    unsigned line[32];
#pragma unroll
    for (int t = 0; t < 8; ++t) {
        f32x4 cur[8];
#pragma unroll
        for (int j = 0; j < 8; ++j) cur[j] = rr[t % 3][j];
        if (t + 3 < 8) {
#pragma unroll
            for (int j = 0; j < 8; ++j) rr[t % 3][j] = *(const f32x4*)(src + (size_t)(32 * (t + 3) + 4 * j) * N);
        }
        unsigned o[16];
        p0_tile<FP8>(cur, o, kq * 256 + 32 * t, kscale, mult, scr, lane);
        if constexpr (FP8) {
#pragma unroll
            for (int q = 0; q < 8; ++q) line[8 * (t & 3) + q] = o[q];
            if ((t & 3) == 3) {
#pragma unroll
                for (int q = 0; q < 8; ++q) *(u32x4*)(drow + 128 * (t >> 2) + 16 * q) = (u32x4){line[4 * q], line[4 * q + 1], line[4 * q + 2], line[4 * q + 3]};
            }
        } else {
#pragma unroll
            for (int q = 0; q < 16; ++q) line[16 * (t & 1) + q] = o[q];
            if ((t & 1) == 1) {
#pragma unroll
                for (int q = 0; q < 8; ++q) *(u32x4*)(drow + 128 * (t >> 1) + 16 * q) = (u32x4){line[4 * q], line[4 * q + 1], line[4 * q + 2], line[4 * q + 3]};
            }
        }
    }
}
__device__ __forceinline__ void moe_one_job(Ctx& F, int r, LAS float* scr, const LAS float* gainl) {
    unsigned char* WGU = F.ws + WS_WGU; unsigned char* WDN = F.ws + WS_WDN;
    constexpr int J_E = 16 * 4;
    const int e = r / (3 * J_E), q = r % (3 * J_E), which = q / J_E, rr = q % J_E, nb = rr & 15, kq = rr >> 4, n0 = nb * 64;
    if (which == 0) p0_job<true>(F.w_gate + (size_t)e * 1048576, 1024, WGU, n0, kq, (long)(e * 8 + (n0 >> 7)) * 256 + (n0 & 127), gainl, W8_SCALE, scr, F.lane);
    else if (which == 1) p0_job<true>(F.w_up + (size_t)e * 1048576, 1024, WGU, n0, kq, (long)(e * 8 + (n0 >> 7)) * 256 + 128 + (n0 & 127), gainl, W8_SCALE, scr, F.lane);
    else p0_job<true>(F.w_down + (size_t)e * 1048576, 1024, WDN, n0, kq, (long)e * 1024 + n0, nullptr, W8_SCALE, scr, F.lane);
}
__device__ __forceinline__ void moe_convert_jobs(Ctx& F, LAS float* scr, const LAS float* gainl) {
    unsigned* ctr = (unsigned*)(F.ws + WS_CTL) + CW_JOB;
    constexpr int NJ = NE * 3 * 64;
    const int nstatic = (F.G * 16 <= NJ) ? F.G * 16 : 0;
    if (F.wave >= 4 && nstatic) { const int j0 = F.bid * 16 + (F.wave - 4);
        for (int r = j0; r < j0 + 16; r += 4) moe_one_job(F, r, scr, gainl); }
    for (;;) {
        unsigned tk = 0; if (F.lane == 0) tk = __hip_atomic_fetch_add(ctr, 2u, __ATOMIC_RELAXED, __HIP_MEMORY_SCOPE_AGENT);
        const int j0 = nstatic + __builtin_amdgcn_readfirstlane((int)tk);
        if (j0 >= NJ) break;
        for (int r = j0; r < j0 + 2; ++r) moe_one_job(F, r, scr, gainl);
    }
}
__device__ __forceinline__ void phase0(Ctx& F) {
    LAS float* scr = (LAS float*)(F.lds + F.wave * 16384);
    const int gw = F.bid * NWAVES + F.wave, NGW = F.G * NWAVES;
    unsigned char* WIN = F.ws + WS_WIN; unsigned char* WOUT = F.ws + WS_WOUT;
    constexpr int J_IN = (INC / 64) * 4, J_OUT = 16 * 4;
    constexpr int NJOBS = J_IN + J_OUT;
    for (int it = gw; it < NJOBS; it += NGW) {
        int r = it;
        if (r < J_IN) { const int nb = r >> 2, kq = r & 3; p0_job<false>(F.w_in, INC, WIN, nb * 64, kq, nb * 64, nullptr, 1.0f, scr, F.lane); continue; } r -= J_IN;
        { const int nb = r >> 2, kq = r & 3; p0_job<false>(F.w_out, 1024, WOUT, nb * 64, kq, nb * 64, nullptr, 1.0f, scr, F.lane); }
    }
    bf16* U = (bf16*)(F.ws + WS_D);
    const f32x4* gr = (const f32x4*)F.mix_gain + F.lane;
    f32x4 g[4];
#pragma unroll
    for (int j = 0; j < 4; ++j) g[j] = gr[64 * j];
    f32x4 nv[4];
    if (gw < NTOK) {
#pragma unroll
        for (int j = 0; j < 4; ++j) nv[j] = ((const f32x4*)(F.x + (size_t)gw * DM) + F.lane)[64 * j];
    }
    for (int m = gw; m < NTOK; m += NGW) {
        f32x4 v[4]; float s = 0.f;
#pragma unroll
        for (int j = 0; j < 4; ++j) v[j] = nv[j];
        if (m + NGW < NTOK) {
#pragma unroll
            for (int j = 0; j < 4; ++j) nv[j] = ((const f32x4*)(F.x + (size_t)(m + NGW) * DM) + F.lane)[64 * j];
        }
#pragma unroll
        for (int j = 0; j < 4; ++j) s += (v[j].x * v[j].x + v[j].y * v[j].y) + (v[j].z * v[j].z + v[j].w * v[j].w);
        const float rstd = 1.0f / sqrtf(wave_sum(s) * (1.f / DM) + EPS);
        unsigned long long* o8 = (unsigned long long*)(U + (size_t)m * DM) + F.lane;
#pragma unroll
        for (int j = 0; j < 4; ++j)
            o8[64 * j] = (unsigned long long)pk2(v[j].x * rstd * g[j].x, v[j].y * rstd * g[j].y) | ((unsigned long long)pk2(v[j].z * rstd * g[j].z, v[j].w * rstd * g[j].w) << 32);
    }
}

struct P1Pol {
    static constexpr bool PERM = true, FP8 = false, GATHER = false;
    const char* A; const char* B; bf16* O; const float* lbl; int G, c, flags;
    __device__ __forceinline__ bool next(int i, gm::Unit& u) const { int pm, pn; if (!gm::order_next(i, G, c, NTOK / 256, INC / 256, pm, pn)) return false;
        u.pm = pm; u.pn = pn; u.A = A + (size_t)pm * 256 * 2048; u.B = B + (size_t)pn * 256 * 2048; u.e = 0; u.rows = 256; return true; }
    __device__ __forceinline__ void a_off(const gm::Unit&, int R0, int C0, int R1, int C1, unsigned (&vo)[2][2]) const {
        vo[0][0] = (unsigned)(R0 * 1024 + C0) * 2u; vo[0][1] = (unsigned)(R1 * 1024 + C1) * 2u; vo[1][0] = vo[0][0] + 128u * 2048u; vo[1][1] = vo[0][1] + 128u * 2048u; }
    __device__ __forceinline__ size_t koff(int t) const { return (size_t)t * 128; }
    template <int TYPE> __device__ __forceinline__ void epi_t(const f32x4 (&acc)[2][2][4][2], const gm::Unit& u, int wr, int wc, int fr, int fq) const {
        const int row0 = u.pm * 256 + wr * 64 + fr, col0 = u.pn * 256 + wc * 32 + 8 * fq;
        f32x4 lbv[2][2];
        if constexpr (TYPE == 1) {
#pragma unroll
            for (int bj = 0; bj < 2; ++bj)
#pragma unroll
                for (int n = 0; n < 2; ++n) { const int c = col0 + bj * 128 + 4 * n - C_HF; const f32x4 a0 = *(const f32x4*)(lbl + c), a1 = *(const f32x4*)(lbl + 512 + c);
#pragma unroll
                    for (int j = 0; j < 4; ++j) lbv[bj][n][j] = sigmoidf_(a0[j] - a1[j]); }
        }
#pragma unroll
        for (int ai = 0; ai < 2; ++ai)
#pragma unroll
            for (int m = 0; m < 4; ++m) { bf16* rowp = O + (size_t)(row0 + ai * 128 + m * 16) * INC + col0;
#pragma unroll
                for (int bj = 0; bj < 2; ++bj) { f32x4 v[2];
#pragma unroll
                    for (int n = 0; n < 2; ++n)
#pragma unroll
                        for (int j = 0; j < 4; ++j) { const float x = acc[ai][bj][m][n][j];
                            if constexpr (TYPE == 0) v[n][j] = x * sigmoidf_(x);
                            else if constexpr (TYPE == 1) { const float lb = lbv[bj][n][j]; v[n][j] = __logf(lb + (1.0f - lb) * sigmoidf_(x)); }
                            else if constexpr (TYPE == 4) v[n][j] = x * 0.125f;
                            else v[n][j] = x; }
                    u32x4 w; w.x = gm::cvt_pk_bf16(v[0][0], v[0][1]); w.y = gm::cvt_pk_bf16(v[0][2], v[0][3]); w.z = gm::cvt_pk_bf16(v[1][0], v[1][1]); w.w = gm::cvt_pk_bf16(v[1][2], v[1][3]);
                    *(u32x4*)(rowp + bj * 128) = w; } }
    }
    __device__ __forceinline__ void acc_init(f32x4 (&acc)[2][2][4][2], const gm::Unit&, int, int, int, int) const { gm::acc_zero(acc); }
    __device__ __forceinline__ void meta_prefetch(const gm::Unit&, LAS unsigned char*, int, int) const {}
    __device__ __forceinline__ void epi(const f32x4 (&acc)[2][2][4][2], const gm::Unit& u, int wr, int wc, int fr, int fq, LAS unsigned char*, int) const {
        if (flags & 1) { if (acc[0][0][0][0][0] == 1.2345e-30f) O[0] = 1; return; }
        const int type = u.pn >> 1;
        if (type == 0 || type == 3) epi_t<0>(acc, u, wr, wc, fr, fq);
        else if (type == 1) epi_t<1>(acc, u, wr, wc, fr, fq);
        else if (type == 4) epi_t<4>(acc, u, wr, wc, fr, fq);
        else epi_t<2>(acc, u, wr, wc, fr, fq);
    }
};
__device__ __forceinline__ void phase1(Ctx& F) {
    P1Pol S{(const char*)(F.ws + WS_D), (const char*)(F.ws + WS_WIN), (bf16*)(F.ws + WS_PROJ), F.lb_logits, F.G, F.vc, F.flags};
    gm::gemm_phase<P1Pol>(F.lds, S);
}

typedef short s16x4 __attribute__((ext_vector_type(4)));
__device__ __forceinline__ s16x4 tr_read(LAS const unsigned char* p) { return __builtin_bit_cast(s16x4, __builtin_amdgcn_ds_read_tr16_b64_v4i16((LAS s16x4*)p)); }
__device__ __forceinline__ bf16x8 cat8(s16x4 a, s16x4 b) { return (bf16x8){a[0], a[1], a[2], a[3], b[0], b[1], b[2], b[3]}; }
__device__ __forceinline__ bf16x8 pack8(f32x4 a, f32x4 b) { u32x4 w; w.x = gm::cvt_pk_bf16(a[0], a[1]); w.y = gm::cvt_pk_bf16(a[2], a[3]); w.z = gm::cvt_pk_bf16(b[0], b[1]); w.w = gm::cvt_pk_bf16(b[2], b[3]); return __builtin_bit_cast(bf16x8, w); }
#define MFMA16(a, b, c) __builtin_amdgcn_mfma_f32_16x16x32_bf16((a), (b), (c), 0, 0, 0)
#define MFMA32(a, b, c) __builtin_amdgcn_mfma_f32_32x32x16_bf16((a), (b), (c), 0, 0, 0)
constexpr int SBV_PITCH = 192, SBV_BYTES = 32 * SBV_PITCH;
__device__ __forceinline__ void sb_attn_fast(Ctx& F) {
    bf16* PROJ = (bf16*)(F.ws + WS_PROJ);
    LAS unsigned char* VT = F.lds + F.wave * SBV_BYTES;
    const int l = F.lane, c = l & 31, hh = l >> 5, i = l & 15, sub = (l >> 4) & 1;
    const int gw = F.bid * 4 + F.wave, NGW = F.G * 4;
    const bool xl = (F.G == 256);
    const int xcd = F.vc & 7, wx = (F.vc >> 3) * 4 + F.wave;
    for (int n = 0; ; ++n) {
        int qt, bh;
        if (xl) { if (n >= 8) break; bh = xcd + 8 * (n >> 1); qt = wx + 128 * (n & 1); }
        else { const int item = gw + n * NGW; if (item >= NBATCH * 8 * (SEQ / 32)) break; qt = item & 255; bh = item >> 8; }
        const int b = bh >> 3, h = bh & 7, t0 = qt * 32;
        const size_t tokbase = (size_t)b * SEQ;
        const bf16* qp = PROJ + (tokbase + t0 + c) * INC + C_SQ + h * 64;
        bf16* mixp = (bf16*)(F.ws + WS_MIX) + (tokbase + t0 + c) * DM + 512 + h * 64;
        bf16x8 qfr[4];
#pragma unroll
        for (int ks = 0; ks < 4; ++ks) qfr[ks] = *(const bf16x8*)(qp + 16 * ks + 8 * hh);
        const bf16* kb = PROJ + tokbase * INC + C_SK + h * 64 + 8 * hh;
        const bf16* vb = PROJ + tokbase * INC + C_SV + h * 64 + (l & 7) * 8;
        f32x16 O0, O1;
#pragma unroll
        for (int r = 0; r < 16; ++r) { O0[r] = 0.f; O1[r] = 0.f; }
        float prun = 1.0f;
        bf16x8 kn[3][4]; u32x4 vn[3][4];
#pragma unroll
        for (int d = 0; d < 3; ++d) { const int sd = (t0 - 32 * d) > 0 ? (t0 - 32 * d) : 0;
#pragma unroll
            for (int ks = 0; ks < 4; ++ks) kn[d][ks] = *(const bf16x8*)(kb + (size_t)(sd + c) * INC + 16 * ks);
#pragma unroll
            for (int q = 0; q < 4; ++q) vn[d][q] = *(const u32x4*)(vb + (size_t)(sd + 8 * q + (l >> 3)) * INC);
            asm volatile("" ::: "memory");
        }
#define ATT_TILE(SV, D) { \
            const int s_ = (SV); const int sn_ = (s_ - 96) > 0 ? (s_ - 96) : 0; \
            asm volatile("" ::: "memory"); \
            _Pragma("unroll") for (int q = 0; q < 4; ++q) *(LAS u32x4*)(VT + (8 * q + (l >> 3)) * SBV_PITCH + (l & 7) * 16) = vn[D][q]; \
            asm volatile("" ::: "memory"); \
            f32x16 z; \
            _Pragma("unroll") for (int r = 0; r < 16; ++r) z[r] = 0.f; \
            _Pragma("unroll") for (int ks = 0; ks < 4; ++ks) z = MFMA32(kn[D][ks], qfr[ks], z); \
            __builtin_amdgcn_sched_barrier(0); \
            _Pragma("unroll") for (int ks = 0; ks < 4; ++ks) kn[D][ks] = *(const bf16x8*)(kb + (size_t)(sn_ + c) * INC + 16 * ks); \
            _Pragma("unroll") for (int q = 0; q < 4; ++q) vn[D][q] = *(const u32x4*)(vb + (size_t)(sn_ + 8 * q + (l >> 3)) * INC); \
              \
            float sg[16], om[16]; \
            _Pragma("unroll") for (int r = 0; r < 16; ++r) { const float e = __builtin_amdgcn_exp2f(-fmaxf(z[r] * 1.44269504f, -120.f)); \
                sg[r] = __builtin_amdgcn_rcpf(1.0f + e); om[r] = e * sg[r]; } \
            if (s_ == t0) {                    \
                _Pragma("unroll") for (int r = 0; r < 16; ++r) { const bool ok = ((r & 3) + 8 * (r >> 2) + 4 * hh) < c; sg[r] = ok ? sg[r] : 0.f; om[r] = ok ? om[r] : 1.0f; } } \
            float gs[4], pg[4]; \
            _Pragma("unroll") for (int q = 0; q < 4; ++q) { gs[q] = (om[4 * q] * om[4 * q + 1]) * (om[4 * q + 2] * om[4 * q + 3]); pg[q] = __shfl_xor(gs[q], 32); } \
            float lgq[4]; float tail = 1.0f; \
            _Pragma("unroll") for (int q = 3; q >= 0; --q) { lgq[q] = tail * (hh == 0 ? pg[q] : 1.0f); tail *= gs[q] * pg[q]; } \
            f32x4 a4[4]; \
            _Pragma("unroll") for (int q = 0; q < 4; ++q) { const float w3 = prun * lgq[q], w2 = w3 * om[4 * q + 3], w1 = w2 * om[4 * q + 2], w0 = w1 * om[4 * q + 1]; \
                a4[q] = (f32x4){sg[4 * q] * w0, sg[4 * q + 1] * w1, sg[4 * q + 2] * w2, sg[4 * q + 3] * w3}; } \
            prun *= tail; \
            const bf16x8 p0 = pack8(a4[0], a4[1]), p1 = pack8(a4[2], a4[3]); \
            asm volatile("" ::: "memory"); \
            _Pragma("unroll") for (int s2 = 0; s2 < 2; ++s2) { const bf16x8 pf = s2 ? p1 : p0; \
                LAS const unsigned char* vr = VT + (16 * s2 + 4 * hh + (i >> 2)) * SBV_PITCH + (16 * sub + 4 * (i & 3)) * 2; \
                const bf16x8 v0 = cat8(tr_read(vr), tr_read(vr + 8 * SBV_PITCH)); \
                const bf16x8 v1 = cat8(tr_read(vr + 64), tr_read(vr + 8 * SBV_PITCH + 64)); \
                O0 = MFMA32(v0, pf, O0); O1 = MFMA32(v1, pf, O1); } \
            asm volatile("" ::: "memory"); }
        for (int s0 = t0; ; s0 -= 96) {
            ATT_TILE(s0, 0)
            if (s0 < 32 || __ballot(prun >= SB_PEXIT) == 0ull) break;
            ATT_TILE(s0 - 32, 1)
            if (s0 < 64 || __ballot(prun >= SB_PEXIT) == 0ull) break;
            ATT_TILE(s0 - 64, 2)
            if (s0 < 96 || __ballot(prun >= SB_PEXIT) == 0ull) break;
        }
#undef ATT_TILE
        float ssq = 0.f;
#pragma unroll
        for (int r = 0; r < 16; ++r) ssq += O0[r] * O0[r] + O1[r] * O1[r];
        ssq += __shfl_xor(ssq, 32);
        const float rn = 1.0f / sqrtf(ssq * (1.f / 64) + EPS);
#pragma unroll
        for (int dt = 0; dt < 2; ++dt)
#pragma unroll
            for (int q = 0; q < 4; ++q) { const int d0 = 32 * dt + 8 * q + 4 * hh; const f32x4 gn = *(const f32x4*)(F.sb_gain + h * 64 + d0);
                const float o0 = (dt ? O1[4 * q] : O0[4 * q]) * rn * gn[0], o1 = (dt ? O1[4 * q + 1] : O0[4 * q + 1]) * rn * gn[1], o2 = (dt ? O1[4 * q + 2] : O0[4 * q + 2]) * rn * gn[2], o3 = (dt ? O1[4 * q + 3] : O0[4 * q + 3]) * rn * gn[3];
                *(u32x2*)(mixp + d0) = (u32x2){gm::cvt_pk_bf16(o0, o1), gm::cvt_pk_bf16(o2, o3)}; }
    }
}
constexpr int HA_SET = 8192 + 9216 + 9216;
__device__ __forceinline__ void hgrn_passA(Ctx& F) {
    const bf16* PROJ = (const bf16*)(F.ws + WS_PROJ);
    float* HST = (float*)(F.ws + WS_HST); float* HDEC = (float*)(F.ws + WS_HDEC);
    const int i = F.lane & 15, g = F.lane >> 4, w = F.wave;
    for (int it = F.bid; it < 256; it += F.G) {
        const int b = it >> 6, h = (it >> 4) & 3, sc = it & 15;
        const size_t rowbase = (size_t)b * SEQ + sc * 512;
        const int row = F.tid >> 4, chunk = F.tid & 15;
        const bf16* gp = PROJ + (rowbase + row) * INC + h * 128 + chunk * 8;
        f32x4 acc[8];
#pragma unroll
        for (int kt = 0; kt < 8; ++kt) acc[kt] = (f32x4){0.f, 0.f, 0.f, 0.f};
        float run = 0.f;
        const int k = F.tid & 127, tq = F.tid >> 7, tqu = __builtin_amdgcn_readfirstlane(tq);
        u32x4 nf = *(const u32x4*)(gp + (size_t)15 * 32 * INC + C_HF), nv = *(const u32x4*)(gp + (size_t)15 * 32 * INC + C_HI);
        __syncthreads();
        for (int tl = 15; tl >= 0; --tl) {
            LAS unsigned char* set = F.lds + (tl & 1) * HA_SET;
            LAS unsigned char* RAWF = set; LAS unsigned char* KH = set + 8192; LAS unsigned char* VI = set + 8192 + 9216;
            *(LAS u32x4*)(RAWF + row * 256 + chunk * 16) = nf; *(LAS u32x4*)(VI + row * 288 + chunk * 16) = nv;
            if (tl > 0) { nf = *(const u32x4*)(gp + (size_t)(tl - 1) * 32 * INC + C_HF); nv = *(const u32x4*)(gp + (size_t)(tl - 1) * 32 * INC + C_HI); }
            __syncthreads();
            {
                float lfv[32];
#pragma unroll
                for (int s = 0; s < 32; ++s) lfv[s] = bf2f(*(const LAS unsigned short*)(RAWF + s * 256 + k * 2));
#define PA_Q(Q) { _Pragma("unroll") for (int s = 31; s >= 0; --s) { if ((s >> 3) == (Q)) *(LAS unsigned short*)(KH + s * 288 + k * 2) = (unsigned short)f2bf((1.0f - exp_raw(lfv[s])) * exp_raw(run)); run += lfv[s]; } }
                if (tqu == 0) PA_Q(0) else if (tqu == 1) PA_Q(1) else if (tqu == 2) PA_Q(2) else PA_Q(3)
#undef PA_Q
            }
            __syncthreads();
            const bf16x8 bv = cat8(tr_read(VI + (4 * g + (i >> 2)) * 288 + (16 * w + 4 * (i & 3)) * 2), tr_read(VI + (16 + 4 * g + (i >> 2)) * 288 + (16 * w + 4 * (i & 3)) * 2));
#pragma unroll
            for (int kt = 0; kt < 8; ++kt) {
                const bf16x8 av = cat8(tr_read(KH + (4 * g + (i >> 2)) * 288 + (16 * kt + 4 * (i & 3)) * 2), tr_read(KH + (16 + 4 * g + (i >> 2)) * 288 + (16 * kt + 4 * (i & 3)) * 2));
                acc[kt] = MFMA16(av, bv, acc[kt]); }
        }
        float* hp = HST + (size_t)it * 16384;
#pragma unroll
        for (int kt = 0; kt < 8; ++kt) *(f32x4*)(hp + ((w * 8 + kt) * 64 + F.lane) * 4) = acc[kt];
        if (tq == 0) HDEC[it * 128 + k] = __expf(run);
        __syncthreads();
    }
}
__device__ __forceinline__ void hgrn_passB(Ctx& F) {
    float* HST = (float*)(F.ws + WS_HST); const float* HDEC = (const float*)(F.ws + WS_HDEC);
    for (int u = F.bid; u < 256; u += F.G) {
        const int bh = u >> 4, part = u & 15;
        const int e = part * 1024 + F.tid * 2;
        const int kk = 16 * ((e >> 8) & 7) + 4 * (((e >> 2) & 63) >> 4) + (e & 3);
        f32x2 L[16]; f32x2 D[16];
#pragma unroll
        for (int sc = 0; sc < 16; ++sc) { L[sc] = *(const f32x2*)(HST + (size_t)(bh * 16 + sc) * 16384 + e); D[sc] = *(const f32x2*)(HDEC + (bh * 16 + sc) * 128 + kk); }
        f32x2 S = (f32x2){0.f, 0.f};
#pragma unroll
        for (int sc = 0; sc < 16; ++sc) { *(f32x2*)(HST + (size_t)(bh * 16 + sc) * 16384 + e) = S; S = S * D[sc] + L[sc]; }
    }
}
constexpr int HC_RAWF = 0, HC_RAWQ = 4096, HC_QH = 8192, HC_KT = HC_QH + 4352, HC_V = HC_KT + 4352, HC_G = HC_V + 4608, HC_DK = HC_G + 4352, HC_PART = HC_DK + 512, HC_SET = HC_PART + 512;
#define PASSC_ITER(ITR, D, ROLE) do { const int itr = (ITR); \
            if (ROLE) { \
                if (itr >= 1 && itr <= 32) { const int st = itr - 1; const LAS unsigned char* set = F.lds + (st & 3) * HC_SET; \
                    float tot = 0.f; \
                _Pragma("unroll") \
                    for (int ww = 0; ww < 8; ++ww) tot += *(const LAS float*)(set + HC_PART + (ww * 16 + i) * 4); \
                    const float rs = 1.0f / sqrtf(tot * (1.f / 128) + EPS); \
                _Pragma("unroll") \
                    for (int u = 0; u < 2; ++u) { const int vt = 2 * w + u; \
                        const u32x2 gi = *(const LAS u32x2*)(set + HC_G + i * 272 + (16 * vt + 4 * g) * 2); \
                        u32x2 o; o.x = gm::cvt_pk_bf16(oT[u][0] * rs * gain[u][0] * bflo(gi.x), oT[u][1] * rs * gain[u][1] * bfhi(gi.x)); o.y = gm::cvt_pk_bf16(oT[u][2] * rs * gain[u][2] * bflo(gi.y), oT[u][3] * rs * gain[u][3] * bfhi(gi.y)); \
                        *(u32x2*)((bf16*)(F.ws + WS_MIX) + (rowbase + st * 16 + i) * DM + h * 128 + 16 * vt + 4 * g) = o; } } \
                if (itr >= 0 && itr < 32) { LAS unsigned char* set = F.lds + (itr & 3) * HC_SET; \
                    bf16x8 qf[4]; \
                    f32x4 pT = (f32x4){0.f, 0.f, 0.f, 0.f}; \
                _Pragma("unroll") \
                    for (int ks = 0; ks < 4; ++ks) { \
                        qf[ks] = cat8(*(const LAS s16x4*)(set + HC_QH + i * 272 + (32 * ks + 4 * g) * 2), *(const LAS s16x4*)(set + HC_QH + i * 272 + (32 * ks + 16 + 4 * g) * 2)); \
                        const bf16x8 kf = cat8(*(const LAS s16x4*)(set + HC_KT + i * 272 + (32 * ks + 4 * g) * 2), *(const LAS s16x4*)(set + HC_KT + i * 272 + (32 * ks + 16 + 4 * g) * 2)); \
                        pT = MFMA16(kf, qf[ks], pT); } \
                _Pragma("unroll") \
                    for (int r = 0; r < 4; ++r) pT[r] = (4 * g + r <= i) ? pT[r] : 0.f; \
                    const s16x4 z4 = (s16x4){0, 0, 0, 0}; \
                    const bf16x8 pf = pack8(pT, (f32x4){0.f, 0.f, 0.f, 0.f}); \
                    bf16x8 vf[2]; \
                _Pragma("unroll") \
                    for (int u = 0; u < 2; ++u) { const int vt = 2 * w + u; \
                        vf[u] = cat8(tr_read(set + HC_V + (4 * g + (i >> 2)) * 288 + (16 * vt + 4 * (i & 3)) * 2), z4); \
                        oT[u] = MFMA16(vf[u], pf, ((f32x4){0.f, 0.f, 0.f, 0.f})); \
                _Pragma("unroll") \
                        for (int ks = 0; ks < 4; ++ks) oT[u] = MFMA16(pack8(acc[u][2 * ks], acc[u][2 * ks + 1]), qf[ks], oT[u]); } \
                _Pragma("unroll") \
                    for (int kt = 0; kt < 8; ++kt) { const bf16x8 ak = cat8(tr_read(set + HC_KT + (4 * g + (i >> 2)) * 272 + (16 * kt + 4 * (i & 3)) * 2), z4); \
                        const f32x4 dk = *(const LAS f32x4*)(set + HC_DK + (16 * kt + 4 * g) * 4); \
                _Pragma("unroll") \
                        for (int u = 0; u < 2; ++u) { acc[u][kt] = MFMA16(ak, vf[u], acc[u][kt]); acc[u][kt] = acc[u][kt] * dk; } } \
                _Pragma("unroll") \
                    for (int u = 0; u < 2; ++u) { float ssq = (oT[u][0] * oT[u][0] + oT[u][1] * oT[u][1]) + (oT[u][2] * oT[u][2] + oT[u][3] * oT[u][3]); \
                        ssq += __shfl_xor(ssq, 16); ssq += __shfl_xor(ssq, 32); \
                        if (g == 0) *(LAS float*)(set + HC_PART + ((2 * w + u) * 16 + i) * 4) = ssq; } } \
            } else { \
                if (itr + 1 >= 0 && itr + 1 < 32) { LAS unsigned char* set = F.lds + ((itr + 1) & 3) * HC_SET; \
                    float lfv[16], qv[8]; float run = 0.f;        \
                _Pragma("unroll") \
                    for (int s2 = 0; s2 < 16; ++s2) lfv[s2] = bf2f(*(const LAS unsigned short*)(set + HC_RAWF + s2 * 256 + k * 2)); \
                _Pragma("unroll") \
                    for (int j = 0; j < 8; ++j) qv[j] = bf2f(*(const LAS unsigned short*)(set + HC_RAWQ + (8 * tqu + j) * 256 + k * 2)); \
                    if (tqu == 0) { \
                _Pragma("unroll") \
                        for (int s2 = 0; s2 < 8; ++s2) { run += lfv[s2]; \
                            *(LAS unsigned short*)(set + HC_QH + s2 * 272 + k * 2) = (unsigned short)f2bf(qv[s2] * exp_raw(run)); \
                            *(LAS unsigned short*)(set + HC_KT + s2 * 272 + k * 2) = (unsigned short)f2bf((1.0f - exp_raw(lfv[s2])) * exp_raw(fminf(-run, 80.f))); } \
                _Pragma("unroll") \
                        for (int s2 = 8; s2 < 16; ++s2) run += lfv[s2]; \
                        *(LAS float*)(set + HC_DK + k * 4) = exp_raw(run); \
                    } else { \
                _Pragma("unroll") \
                        for (int s2 = 0; s2 < 8; ++s2) run += lfv[s2]; \
                _Pragma("unroll") \
                        for (int s2 = 8; s2 < 16; ++s2) { run += lfv[s2]; \
                            *(LAS unsigned short*)(set + HC_QH + s2 * 272 + k * 2) = (unsigned short)f2bf(qv[s2 - 8] * exp_raw(run)); \
                            *(LAS unsigned short*)(set + HC_KT + s2 * 272 + k * 2) = (unsigned short)f2bf((1.0f - exp_raw(lfv[s2])) * exp_raw(fminf(-run, 80.f))); } } } \
                if (itr + 2 < 32) { LAS unsigned char* set = F.lds + ((itr + 2) & 3) * HC_SET; \
                    *(LAS u32x4*)(set + HC_RAWF + row * 256 + chunk * 16) = pfq[D][0]; *(LAS u32x4*)(set + HC_RAWQ + row * 256 + chunk * 16) = pfq[D][1]; \
                    *(LAS u32x4*)(set + HC_V + row * 288 + chunk * 16) = pfq[D][2]; *(LAS u32x4*)(set + HC_G + row * 272 + chunk * 16) = pfq[D][3]; } \
            } \
            if (!(ROLE)) { const int pst = (itr + 5 < 32) ? itr + 5 : 31; const bf16* gq = gp + (size_t)pst * 16 * INC;     pfq[D][0] = *(const u32x4*)(gq + C_HF); pfq[D][1] = *(const u32x4*)(gq + C_HQ); pfq[D][2] = *(const u32x4*)(gq + C_HI); pfq[D][3] = *(const u32x4*)(gq + C_HG); } \
            __syncthreads(); } while (0)
__device__ __forceinline__ void hgrn_passC(Ctx& F) {
    bf16* PROJ = (bf16*)(F.ws + WS_PROJ);
    const float* HST = (const float*)(F.ws + WS_HST);
    const int i = F.lane & 15, g = F.lane >> 4, w = F.wave;
    const bool mfw = (w < 4);
    for (int it = F.bid; it < 256; it += F.G) {
        const int b = it >> 6, h = (it >> 4) & 3, sc = it & 15;
        const size_t rowbase = (size_t)b * SEQ + sc * 512;
        const int t = F.tid & 255, row = t >> 4, chunk = t & 15;
        const bf16* gp = PROJ + (rowbase + row) * INC + h * 128 + chunk * 8;
        u32x4 pfq[3][4];
#pragma unroll
        for (int d = 0; d < 3; ++d)
#pragma unroll
            for (int q = 0; q < 4; ++q) pfq[d][q] = (u32x4){0u, 0u, 0u, 0u};
        f32x4 gain[2]; f32x4 acc[2][8]; f32x4 oT[2];
#pragma unroll
        for (int u = 0; u < 2; ++u) { gain[u] = *(const f32x4*)(F.hg_gain + h * 128 + 16 * ((2 * w + u) & 7) + 4 * g); oT[u] = (f32x4){0.f, 0.f, 0.f, 0.f};
#pragma unroll
            for (int kt = 0; kt < 8; ++kt) acc[u][kt] = (f32x4){0.f, 0.f, 0.f, 0.f}; }
        const int k = t & 127, tq = t >> 7, tqu = __builtin_amdgcn_readfirstlane(tq);
        if (mfw) {
#pragma unroll
            for (int u = 0; u < 2; ++u)
#pragma unroll
                for (int kt = 0; kt < 8; ++kt) acc[u][kt] = *(const f32x4*)(HST + (size_t)it * 16384 + (((2 * w + u) * 8 + kt) * 64 + F.lane) * 4);
            __syncthreads();
            for (int base = -2; base <= 32; base += 3) { PASSC_ITER(base, 0, true); PASSC_ITER(base + 1, 1, true); PASSC_ITER(base + 2, 2, true); }
        } else {
#pragma unroll
            for (int d = 0; d < 3; ++d) { const bf16* gq = gp + (size_t)d * 16 * INC; pfq[d][0] = *(const u32x4*)(gq + C_HF); pfq[d][1] = *(const u32x4*)(gq + C_HQ); pfq[d][2] = *(const u32x4*)(gq + C_HI); pfq[d][3] = *(const u32x4*)(gq + C_HG); }
            __syncthreads();
            for (int base = -2; base <= 32; base += 3) { PASSC_ITER(base, 0, false); PASSC_ITER(base + 1, 1, false); PASSC_ITER(base + 2, 2, false); }
        }
    }
}
#undef PASSC_ITER

struct P3Pol {
    static constexpr bool PERM = true, FP8 = false, GATHER = false;
    const char* A; const char* B; const float* x; bf16* h1b; unsigned char* h1q; int G, c, flags;
    __device__ __forceinline__ bool next(int i, gm::Unit& u) const { int pm, pn; if (!gm::order_next(i, G, c, NTOK / 256, 4, pm, pn)) return false;
        u.pm = pm; u.pn = pn; u.A = A + (size_t)pm * 256 * 2048; u.B = B + (size_t)pn * 256 * 2048; u.e = 0; u.rows = 256; return true; }
    __device__ __forceinline__ void a_off(const gm::Unit&, int R0, int C0, int R1, int C1, unsigned (&vo)[2][2]) const {
        vo[0][0] = (unsigned)(R0 * 1024 + C0) * 2u; vo[0][1] = (unsigned)(R1 * 1024 + C1) * 2u; vo[1][0] = vo[0][0] + 128u * 2048u; vo[1][1] = vo[0][1] + 128u * 2048u; }
    __device__ __forceinline__ size_t koff(int t) const { return (size_t)t * 128; }
    __device__ __forceinline__ void acc_init(f32x4 (&acc)[2][2][4][2], const gm::Unit& u, int wr, int wc, int fr, int fq) const {
        const int row0 = u.pm * 256 + wr * 64 + fr, col0 = u.pn * 256 + wc * 32 + 8 * fq;
#pragma unroll
        for (int ai = 0; ai < 2; ++ai)
#pragma unroll
            for (int m = 0; m < 4; ++m) { const float* xp = x + (size_t)(row0 + ai * 128 + m * 16) * DM + col0;
#pragma unroll
                for (int bj = 0; bj < 2; ++bj) { acc[ai][bj][m][0] = *(const f32x4*)(xp + bj * 128); acc[ai][bj][m][1] = *(const f32x4*)(xp + bj * 128 + 4); } }
#pragma unroll
        for (int ai = 0; ai < 2; ++ai)
#pragma unroll
            for (int m = 0; m < 4; ++m)
#pragma unroll
                for (int bj = 0; bj < 2; ++bj) asm volatile("" : "+v"(acc[ai][bj][m][0]), "+v"(acc[ai][bj][m][1]));
    }
    __device__ __forceinline__ void meta_prefetch(const gm::Unit&, LAS unsigned char*, int, int) const {}
    __device__ __forceinline__ void epi(const f32x4 (&acc)[2][2][4][2], const gm::Unit& u, int wr, int wc, int fr, int fq, LAS unsigned char*, int) const {
        if (flags & 2) { if (acc[0][0][0][0][0] == 1.2345e-30f) h1q[0] = 1; return; }
        const int row0 = u.pm * 256 + wr * 64 + fr, col0 = u.pn * 256 + wc * 32 + 8 * fq;
#pragma unroll
        for (int ai = 0; ai < 2; ++ai)
#pragma unroll
            for (int m = 0; m < 4; ++m) { const size_t off = (size_t)(row0 + ai * 128 + m * 16) * DM + col0;
#pragma unroll
                for (int bj = 0; bj < 2; ++bj) { const f32x4 v0 = acc[ai][bj][m][0], v1 = acc[ai][bj][m][1];
                    u32x4 w; w.x = gm::cvt_pk_bf16(v0[0], v0[1]); w.y = gm::cvt_pk_bf16(v0[2], v0[3]); w.z = gm::cvt_pk_bf16(v1[0], v1[1]); w.w = gm::cvt_pk_bf16(v1[2], v1[3]);
                    *(u32x4*)(h1b + off + bj * 128) = w;
                    *(u32x2*)(h1q + off + bj * 128) = (u32x2){pk4_fp8(v0[0], v0[1], v0[2], v0[3]), pk4_fp8(v1[0], v1[1], v1[2], v1[3])}; } }
    }
};
__device__ __forceinline__ void phase3(Ctx& F) {
    P3Pol S{(const char*)(F.ws + WS_MIX), (const char*)(F.ws + WS_WOUT), F.x, (bf16*)(F.ws + WS_H1B), F.ws + WS_H1Q, F.G, F.vc, F.flags};
    gm::gemm_phase<P3Pol>(F.lds, S);
}

__device__ __forceinline__ void phase_router_fast(Ctx& F) {
    LAS float* W4 = (LAS float*)F.lds;
    LAS unsigned char* M = F.lds + MISC_OFF + 1024;
    LAS float* rsd = (LAS float*)M; LAS int* sel_e = (LAS int*)(M + 512); LAS float* sel_g = (LAS float*)(M + 2560); LAS int* lpos = (LAS int*)(M + 4608); LAS int* hist = (LAS int*)(M + 6656); LAS int* base = hist + 32;
    unsigned* cnt = (unsigned*)(F.ws + WS_CTL) + CW_CNT;
    int* STOK = (int*)(F.ws + WS_STOK); float* SGATE = (float*)(F.ws + WS_SGATE); float* SRSTD = (float*)(F.ws + WS_SRSTD);
    for (int idx = F.tid; idx < 1024 * NE; idx += NTHR) { const int k = idx >> 5, e = idx & 31; W4[((k >> 2) * 32 + e) * 4 + (k & 3)] = F.w_router[idx] * F.ffn_gain[k]; }
    for (int tb = F.bid; tb < NTOK / 128; tb += F.G) {
        const int tok0 = tb * 128;
        __syncthreads();
        if (F.tid < 32) hist[F.tid] = 0;
        if (F.wave < 4) {
            const int j = F.lane & 31, h = F.lane >> 5, tok = tok0 + F.wave * 32 + j;
            const bf16* hp = (const bf16*)(F.ws + WS_H1B) + (size_t)tok * DM + 4 * h;
            f32x16 acc;
#pragma unroll
            for (int r = 0; r < 16; ++r) acc[r] = 0.f;
            float ssq = 0.f;
            u32x2 pre[8];
#pragma unroll
            for (int q = 0; q < 8; ++q) pre[q] = *(const u32x2*)(hp + 8 * q);
            for (int m0 = 0; m0 < 128; m0 += 8) {
                u32x2 cur[8];
#pragma unroll
                for (int q = 0; q < 8; ++q) cur[q] = pre[q];
                if (m0 + 8 < 128) {
#pragma unroll
                    for (int q = 0; q < 8; ++q) pre[q] = *(const u32x2*)(hp + 8 * (m0 + 8 + q));
                }
#pragma unroll
                for (int q = 0; q < 8; ++q) { const f32x4 wv = *(const LAS f32x4*)(W4 + ((2 * (m0 + q) + h) * 32 + j) * 4); const f32x4 a = (f32x4){bflo(cur[q].x), bfhi(cur[q].x), bflo(cur[q].y), bfhi(cur[q].y)};
                    ssq += (a[0] * a[0] + a[1] * a[1]) + (a[2] * a[2] + a[3] * a[3]);
#pragma unroll
                    for (int c = 0; c < 4; ++c) acc = __builtin_amdgcn_mfma_f32_32x32x2f32(wv[c], a[c], acc, 0, 0, 0); }
            }
            ssq += __shfl_xor(ssq, 32);
            const float rstd = 1.0f / sqrtf(ssq * (1.f / DM) + EPS);
            float lg[16];
#pragma unroll
            for (int r = 0; r < 16; ++r) lg[r] = acc[r] * rstd + F.b_router[(r & 3) + 8 * (r >> 2) + 4 * h];
            float v[8]; int id[8]; unsigned used = 0u;
#pragma unroll
            for (int k = 0; k < 4; ++k) { float best = -3.0e38f; int bi = 0, br = 0;
#pragma unroll
                for (int r = 0; r < 16; ++r) { const bool c = !((used >> r) & 1u) && lg[r] > best; best = c ? lg[r] : best; bi = c ? ((r & 3) + 8 * (r >> 2) + 4 * h) : bi; br = c ? r : br; }
                used |= 1u << br; v[k] = best; id[k] = bi; }
#pragma unroll
            for (int k = 0; k < 4; ++k) { v[4 + k] = __shfl_xor(v[k], 32); id[4 + k] = __shfl_xor(id[k], 32); }
            float tv[4]; int ti[4]; unsigned u2 = 0u;
#pragma unroll
            for (int k = 0; k < 4; ++k) { float best = -3.0e38f; int bi = 1 << 30, bc = 0;
#pragma unroll
                for (int c8 = 0; c8 < 8; ++c8) { const bool c = !((u2 >> c8) & 1u) && (v[c8] > best || (v[c8] == best && id[c8] < bi)); best = c ? v[c8] : best; bi = c ? id[c8] : bi; bc = c ? c8 : bc; }
                u2 |= 1u << bc; tv[k] = best; ti[k] = bi; }
            float den = 0.f, pr[4];
#pragma unroll
            for (int k = 0; k < 4; ++k) { pr[k] = __expf(tv[k] - tv[0]); den += pr[k]; }
            const float rden = 1.0f / den;
            if (h == 0) { const int tl = F.wave * 32 + j; rsd[tl] = rstd;
#pragma unroll
                for (int k = 0; k < 4; ++k) { sel_e[tl * 4 + k] = ti[k]; sel_g[tl * 4 + k] = pr[k] * rden; } }
        }
        __syncthreads();
        if (F.tid < 128) {
#pragma unroll
            for (int k = 0; k < 4; ++k) lpos[F.tid * 4 + k] = atomicAdd((int*)&hist[sel_e[F.tid * 4 + k]], 1); }
        __syncthreads();
        if (F.tid < 32) base[F.tid] = (int)__hip_atomic_fetch_add(&cnt[64 * F.tid], (unsigned)hist[F.tid], __ATOMIC_RELAXED, __HIP_MEMORY_SCOPE_AGENT);
        __syncthreads();
        if (F.tid < 128) {
#pragma unroll
            for (int k = 0; k < 4; ++k) { const int e = sel_e[F.tid * 4 + k]; const size_t sl = (size_t)e * ECAP + base[e] + lpos[F.tid * 4 + k];
                STOK[sl] = (tok0 + F.tid) * 4 + k; SGATE[sl] = sel_g[F.tid * 4 + k]; SRSTD[sl] = rsd[F.tid]; } }
    }
    __syncthreads();
}

struct RbTab { LAS int* e; LAS int* start; LAS int* rows; LAS int* off; int nrb; };
__device__ __forceinline__ RbTab build_rbtab(Ctx& F) {
    RbTab T; LAS int* m = (LAS int*)(F.lds + MISC_OFF + 1024);
    T.e = m; T.start = m + 640; T.rows = m + 1280; T.off = m + 1920;
    LAS int* nrbp = m + 1920 + 64;
    const unsigned* cnt = (const unsigned*)(F.ws + WS_CTL) + CW_CNT;
    __syncthreads();
    if (F.tid == 0) { int off = 0, rb = 0;
        for (int e = 0; e < NE; ++e) { const int c = (int)__hip_atomic_load(&cnt[64 * e], __ATOMIC_RELAXED, __HIP_MEMORY_SCOPE_AGENT); T.off[e] = off;
            for (int i = 0; i * 256 < c; ++i) { T.e[rb] = e; T.start[rb] = i * 256; T.rows[rb] = (c - i * 256) < 256 ? (c - i * 256) : 256; ++rb; }
            off += c; }
        T.off[NE] = off; *nrbp = rb; }
    __syncthreads();
    T.nrb = *nrbp;
    return T;
}

__device__ __forceinline__ float swiglu_(float hg, float hu) {
    hg = fminf(hg, SW_LIMIT); hu = fminf(fmaxf(hu, -SW_LIMIT), SW_LIMIT);
    return (hu + 1.0f) * (hg * sigmoidf_(SW_ALPHA * hg));
}
struct P4Pol {
    static constexpr bool PERM = true, FP8 = true, GATHER = true;
    const char* A; const char* B; unsigned char* hid; const int* stok; const float* srstd; const float* bg; const float* bu; RbTab T; int G, c, flags;
    __device__ __forceinline__ bool next(int i, gm::Unit& u) const { int pm, pn; if (!gm::order_next(i, G, c, T.nrb, 8, pm, pn)) return false;
        u.pm = pm; u.pn = pn; u.e = __builtin_amdgcn_readfirstlane(T.e[pm]); u.rows = __builtin_amdgcn_readfirstlane(T.rows[pm]); u.A = A; u.B = B + ((size_t)(u.e * 8 + pn) * 256) * 1024; return true; }
    __device__ __forceinline__ void a_off(const gm::Unit& u, int R0, int C0, int R1, int C1, unsigned (&vo)[2][2]) const {
        const int* lst = stok + (size_t)u.e * ECAP + T.start[u.pm];
#pragma unroll
        for (int h = 0; h < 2; ++h) { int r0 = R0 + 128 * h, r1 = R1 + 128 * h; r0 = r0 < u.rows ? r0 : 0; r1 = r1 < u.rows ? r1 : 0;
            vo[h][0] = (unsigned)(lst[r0] >> 2) * 1024u + (unsigned)C0 * 2u; vo[h][1] = (unsigned)(lst[r1] >> 2) * 1024u + (unsigned)C1 * 2u; }
    }
    __device__ __forceinline__ void idx_prefetch(const gm::Unit& u, LAS unsigned char* lds, int wid) const {
        if (wid < 4) { const int* lst = stok + (size_t)u.e * ECAP + __builtin_amdgcn_readfirstlane(T.start[u.pm]) + wid * 64 + (threadIdx.x & 63);
            __builtin_amdgcn_global_load_lds((const unsigned*)lst, (LAS unsigned*)(lds + IDX_OFF + wid * 256), 4, 0, 0); } }
    __device__ __forceinline__ void a_off_lds(const gm::Unit& u, int, int, int, int, LAS unsigned char* lds, unsigned (&vo)[2][2]) const {
        const LAS int* ib = (const LAS int*)(lds + IDX_OFF);
        int tq = threadIdx.x; asm volatile("" : "+v"(tq));
        int R0, C0, R1, C1; gm::stage_rc(tq * 16, R0, C0); gm::stage_rc(tq * 16 + 8192, R1, C1);
#pragma unroll
        for (int h = 0; h < 2; ++h) { int r0 = R0 + 128 * h, r1 = R1 + 128 * h; r0 = r0 < u.rows ? r0 : 0; r1 = r1 < u.rows ? r1 : 0;
            vo[h][0] = (unsigned)(ib[r0] >> 2) * 1024u + (unsigned)C0 * 2u; vo[h][1] = (unsigned)(ib[r1] >> 2) * 1024u + (unsigned)C1 * 2u; }
    }
    __device__ __forceinline__ size_t koff(int t) const { return (size_t)t * 128; }
    __device__ __forceinline__ void acc_init(f32x4 (&acc)[2][2][4][2], const gm::Unit&, int, int, int, int) const { gm::acc_zero(acc); }
    __device__ __forceinline__ void meta_prefetch(const gm::Unit& u, LAS unsigned char* lds, int wid, int ui) const {
        LAS unsigned char* mb = lds + META_OFF + (ui & 1) * META_BYTES; const int ln = threadIdx.x & 63;
        const float* src = (wid < 4) ? srstd + (size_t)u.e * ECAP + __builtin_amdgcn_readfirstlane(T.start[u.pm]) + wid * 64 + ln
                                     : ((wid < 6) ? bg : bu) + u.e * DFF + u.pn * 128 + (wid & 1) * 64 + ln;
        __builtin_amdgcn_global_load_lds((const unsigned*)src, (LAS unsigned*)(mb + wid * 256), 4, 0, 0);
    }
    __device__ __forceinline__ void epi(const f32x4 (&acc)[2][2][4][2], const gm::Unit& u, int wr, int wc, int fr, int fq, LAS unsigned char* lds, int ui) const {
        if (flags & 4) { if (acc[0][0][0][0][0] == 1.2345e-30f) hid[0] = 1; return; }
        const LAS unsigned char* mb = lds + META_OFF + (ui & 1) * META_BYTES;
        const size_t grow = (size_t)T.off[u.e] + T.start[u.pm];
        const int jl = wc * 32 + 8 * fq, j0 = u.pn * 128 + jl;
        const f32x4 bg0 = *(const LAS f32x4*)(mb + 1024 + jl * 4), bg1 = *(const LAS f32x4*)(mb + 1024 + jl * 4 + 16), bu0 = *(const LAS f32x4*)(mb + 1536 + jl * 4), bu1 = *(const LAS f32x4*)(mb + 1536 + jl * 4 + 16);
#pragma unroll
        for (int ai = 0; ai < 2; ++ai)
#pragma unroll
            for (int m = 0; m < 4; ++m) { const int r = ai * 128 + wr * 64 + m * 16 + fr;
                if (r < u.rows) { const float rs = *(const LAS float*)(mb + r * 4) * W8_INV;
                    const f32x4 g0 = acc[ai][0][m][0] * rs + bg0, g1 = acc[ai][0][m][1] * rs + bg1, u0 = acc[ai][1][m][0] * rs + bu0, u1 = acc[ai][1][m][1] * rs + bu1;
                    *(u32x2*)(hid + (grow + r) * DFF + j0) = (u32x2){pk4_fp8(swiglu_(g0[0], u0[0]), swiglu_(g0[1], u0[1]), swiglu_(g0[2], u0[2]), swiglu_(g0[3], u0[3])),
                                                                     pk4_fp8(swiglu_(g1[0], u1[0]), swiglu_(g1[1], u1[1]), swiglu_(g1[2], u1[2]), swiglu_(g1[3], u1[3]))}; } }
    }
};
__device__ __forceinline__ void phase_gateup(Ctx& F) {
    RbTab T = build_rbtab(F);
    P4Pol S{(const char*)(F.ws + WS_H1Q), (const char*)(F.ws + WS_WGU), F.ws + WS_HID, (const int*)(F.ws + WS_STOK), (const float*)(F.ws + WS_SRSTD), F.b_gate, F.b_up, T, F.G, F.vc, F.flags};
    gm::gemm_phase<P4Pol>(F.lds, S);
}

struct P5Pol {
    static constexpr bool PERM = true, FP8 = true, GATHER = false;
    const char* A; const char* B; const int* stok; const float* sgate; const float* bd; unsigned char* y; int* tslot; RbTab T; int G, c, flags;
    __device__ __forceinline__ bool next(int i, gm::Unit& u) const { int pm, pn; if (!gm::order_next(i, G, c, T.nrb, 4, pm, pn)) return false;
        u.pm = pm; u.pn = pn; u.e = __builtin_amdgcn_readfirstlane(T.e[pm]); u.rows = __builtin_amdgcn_readfirstlane(T.rows[pm]);
        const int grow = __builtin_amdgcn_readfirstlane(T.off[u.e] + T.start[pm]); u.A = A + (size_t)grow * 1024; u.B = B + ((size_t)u.e * 1024 + pn * 256) * 1024; return true; }
    __device__ __forceinline__ void a_off(const gm::Unit&, int R0, int C0, int R1, int C1, unsigned (&vo)[2][2]) const {
        vo[0][0] = (unsigned)(R0 * 1024 + C0 * 2); vo[0][1] = (unsigned)(R1 * 1024 + C1 * 2); vo[1][0] = vo[0][0] + 128u * 1024u; vo[1][1] = vo[0][1] + 128u * 1024u; }
    __device__ __forceinline__ size_t koff(int t) const { return (size_t)t * 128; }
    __device__ __forceinline__ void acc_init(f32x4 (&acc)[2][2][4][2], const gm::Unit&, int, int, int, int) const { gm::acc_zero(acc); }
    __device__ __forceinline__ void meta_prefetch(const gm::Unit& u, LAS unsigned char* lds, int wid, int ui) const {
        LAS unsigned char* mb = lds + META_OFF + (ui & 1) * META_BYTES; const int ln = threadIdx.x & 63;
        const size_t sb = (size_t)u.e * ECAP + __builtin_amdgcn_readfirstlane(T.start[u.pm]) + (wid & 3) * 64 + ln;
        const unsigned* src = (wid < 4) ? (const unsigned*)(stok + sb) : (const unsigned*)(sgate + sb);
        __builtin_amdgcn_global_load_lds(src, (LAS unsigned*)(mb + wid * 256), 4, 0, 0);
        if (wid < 4) __builtin_amdgcn_global_load_lds((const unsigned*)(bd + u.e * DM + u.pn * 256 + wid * 64 + ln), (LAS unsigned*)(mb + 2048 + wid * 256), 4, 0, 0);
    }
    __device__ __forceinline__ void epi(const f32x4 (&acc)[2][2][4][2], const gm::Unit& u, int wr, int wc, int fr, int fq, LAS unsigned char* lds, int ui) const {
        if (flags & 8) { if (acc[0][0][0][0][0] == 1.2345e-30f) y[0] = 1; return; }
        const LAS unsigned char* mb = lds + META_OFF + (ui & 1) * META_BYTES;
        const int cl = wc * 32 + 8 * fq, col0 = u.pn * 256 + cl; const size_t grow = (size_t)T.off[u.e] + T.start[u.pm];
        f32x4 bv[2][2];
#pragma unroll
        for (int bj = 0; bj < 2; ++bj) { bv[bj][0] = *(const LAS f32x4*)(mb + 2048 + (bj * 128 + cl) * 4); bv[bj][1] = *(const LAS f32x4*)(mb + 2048 + (bj * 128 + cl) * 4 + 16); }
#pragma unroll
        for (int ai = 0; ai < 2; ++ai)
#pragma unroll
            for (int m = 0; m < 4; ++m) { const int r = ai * 128 + wr * 64 + m * 16 + fr;
                if (r < u.rows) { const int tr = *(const LAS int*)(mb + r * 4); const float gt = *(const LAS float*)(mb + 1024 + r * 4) * Y8_SCALE, gw = gt * W8_INV;
                    unsigned char* p = y + (grow + r) * DM + col0;
                    if (u.pn == 0 && wc == 0 && fq == 0) tslot[tr] = (int)(grow + r);
#pragma unroll
                    for (int bj = 0; bj < 2; ++bj) { const f32x4 v0 = acc[ai][bj][m][0] * gw + bv[bj][0] * gt, v1 = acc[ai][bj][m][1] * gw + bv[bj][1] * gt;
                        *(u32x2*)(p + bj * 128) = (u32x2){pk4_fp8(v0[0], v0[1], v0[2], v0[3]), pk4_fp8(v1[0], v1[1], v1[2], v1[3])}; } } }
    }
};
__device__ __forceinline__ void phase_down(Ctx& F) {
    RbTab T = build_rbtab(F);
    P5Pol S{(const char*)(F.ws + WS_HID), (const char*)(F.ws + WS_WDN), (const int*)(F.ws + WS_STOK), (const float*)(F.ws + WS_SGATE), F.b_down, F.ws + WS_Y, (int*)(F.ws + WS_TSLOT), T, F.G, F.vc, F.flags};
    gm::gemm_phase<P5Pol>(F.lds, S);
}

__device__ __forceinline__ void phase_final(Ctx& F) {
    const int gw = F.bid * NWAVES + F.wave, NGW = F.G * NWAVES;
    const unsigned char* Y = F.ws + WS_Y; const int* TS = (const int*)(F.ws + WS_TSLOT);
    for (int m = gw; m < NTOK; m += NGW) {
        f32x4* xr = (f32x4*)(F.out + (size_t)m * DM) + F.lane; const f32x4* gr = (const f32x4*)F.fin_gain + F.lane;
        const u32x2* hr = (const u32x2*)((const bf16*)(F.ws + WS_H1B) + (size_t)m * DM) + F.lane;
        const int s0 = __builtin_amdgcn_readfirstlane(TS[m * 4]), s1 = __builtin_amdgcn_readfirstlane(TS[m * 4 + 1]), s2 = __builtin_amdgcn_readfirstlane(TS[m * 4 + 2]), s3 = __builtin_amdgcn_readfirstlane(TS[m * 4 + 3]);
        const unsigned* y0 = (const unsigned*)(Y + (size_t)s0 * DM) + F.lane; const unsigned* y1 = (const unsigned*)(Y + (size_t)s1 * DM) + F.lane;
        const unsigned* y2 = (const unsigned*)(Y + (size_t)s2 * DM) + F.lane; const unsigned* y3 = (const unsigned*)(Y + (size_t)s3 * DM) + F.lane;
        f32x4 v[4]; float s = 0.f;
#pragma unroll
        for (int j = 0; j < 4; ++j) { const u32x2 hb = hr[64 * j]; v[j] = (f32x4){bflo(hb.x), bfhi(hb.x), bflo(hb.y), bfhi(hb.y)}; const unsigned a = y0[64 * j], b = y1[64 * j], c = y2[64 * j], d = y3[64 * j];
            const f32x2 al = __builtin_amdgcn_cvt_pk_f32_fp8((int)a, false), ah = __builtin_amdgcn_cvt_pk_f32_fp8((int)a, true), bl = __builtin_amdgcn_cvt_pk_f32_fp8((int)b, false), bh = __builtin_amdgcn_cvt_pk_f32_fp8((int)b, true);
            const f32x2 cl = __builtin_amdgcn_cvt_pk_f32_fp8((int)c, false), ch = __builtin_amdgcn_cvt_pk_f32_fp8((int)c, true), dl = __builtin_amdgcn_cvt_pk_f32_fp8((int)d, false), dh = __builtin_amdgcn_cvt_pk_f32_fp8((int)d, true);
            v[j].x += ((al[0] + bl[0]) + (cl[0] + dl[0])) * Y8_INV; v[j].y += ((al[1] + bl[1]) + (cl[1] + dl[1])) * Y8_INV;
            v[j].z += ((ah[0] + bh[0]) + (ch[0] + dh[0])) * Y8_INV; v[j].w += ((ah[1] + bh[1]) + (ch[1] + dh[1])) * Y8_INV;
            s += (v[j].x * v[j].x + v[j].y * v[j].y) + (v[j].z * v[j].z + v[j].w * v[j].w); }
        const float rstd = 1.0f / sqrtf(wave_sum(s) * (1.f / DM) + EPS);
#pragma unroll
        for (int j = 0; j < 4; ++j) xr[64 * j] = v[j] * rstd * gr[64 * j];
    }
}

struct Args { const float* in[17]; float* out; unsigned char* ws; int ph_lo, ph_hi, flags, pad; };
constexpr int NPHASE = 9;
__global__ void __launch_bounds__(NTHR, 2) fwd_kernel(Args args) {
    extern __shared__ __attribute__((aligned(16))) unsigned char lds_raw[];
    Ctx F;
    F.x = args.in[0]; F.w_in = args.in[1]; F.w_out = args.in[2]; F.lb_logits = args.in[3]; F.hg_gain = args.in[4]; F.sb_gain = args.in[5]; F.mix_gain = args.in[6]; F.ffn_gain = args.in[7];
    F.w_router = args.in[8]; F.b_router = args.in[9]; F.w_gate = args.in[10]; F.b_gate = args.in[11]; F.w_up = args.in[12]; F.b_up = args.in[13]; F.w_down = args.in[14]; F.b_down = args.in[15]; F.fin_gain = args.in[16];
    F.out = args.out; F.ws = args.ws; F.lds = (LAS unsigned char*)lds_raw;
    F.tid = threadIdx.x; F.lane = F.tid & 63; F.wave = __builtin_amdgcn_readfirstlane(F.tid >> 6); F.G = gridDim.x; F.bid = blockIdx.x; F.flags = args.flags;
    volatile LAS unsigned* MISC = (volatile LAS unsigned*)(F.lds + MISC_OFF);
    if (F.tid < 64) MISC[F.tid] = 0u;
    __syncthreads();
    const int lo = args.ph_lo, hi = args.ph_hi;
    XcdBarrier bar; bar.bar = (unsigned*)(F.ws + WS_CTL) + CW_BAR; bar.x = 0; bar.st = nullptr;
    if (hi - lo > 1) bar = xcd_barrier_post((unsigned*)(F.ws + WS_CTL) + CW_BAR, MISC + 8);
#ifdef TEST_PHASE
#define IN(k) ((k) == TEST_PHASE && lo <= (k))
#else
#define IN(k) (lo <= (k) && (k) < hi)
#endif
#define SEAM(k) do { if (IN(k) && IN((k) + 1)) xcd_barrier(bar); } while (0)
    if (IN(0)) { phase0(F); } SEAM(0);
    F.vc = F.bid;
    if (hi - lo > 1 && IN(0)) {
        if (F.tid == 0) { bool ok = (F.G % 8 == 0); unsigned* bw = (unsigned*)(F.ws + WS_CTL) + CW_BAR;
            for (unsigned j = 0; j < 16; ++j) { const unsigned c = xb_ld(&bw[XB_XCNT(j)]); ok = ok && (j < 8 ? c == (unsigned)F.G / 8 : c == 0u); }
            MISC[3] = ok ? (MISC[10] * 8u + bar.x) : (unsigned)F.bid; }
        __syncthreads();
        F.vc = __builtin_amdgcn_readfirstlane((int)MISC[3]);
    }
    if (IN(1)) { phase1(F); } SEAM(1);
    if (IN(2)) { hgrn_passA(F);
        if (F.tid < 256) *(LAS f32x4*)(F.lds + 122880 + F.tid * 16) = *(const f32x4*)(F.ffn_gain + F.tid * 4);
        __syncthreads();
        if (F.wave < 4) sb_attn_fast(F);
        moe_convert_jobs(F, (LAS float*)(F.lds + 32768 + F.wave * 10240), (const LAS float*)(F.lds + 122880));
        } SEAM(2);
    if (IN(3)) { hgrn_passB(F); if (hi - lo > 1) xcd_barrier(bar); hgrn_passC(F); } SEAM(3);
    if (IN(4)) { phase3(F); } SEAM(4);
    if (IN(5)) { phase_router_fast(F); } SEAM(5);
    if (IN(6)) { phase_gateup(F); } SEAM(6);
    if (IN(7)) { phase_down(F); } SEAM(7);
    if (IN(8)) { phase_final(F); }
#undef IN
#undef SEAM
}

extern "C" void kernel_launch(void* const* d_in, const int* in_sizes, int n_in, void* d_out, int out_size, void* d_ws, size_t ws_size, hipStream_t stream) {
    static int grid = 0;
    if (grid == 0) {
        if (n_in != 17 || in_sizes[0] != NTOK * DM || out_size != NTOK * DM || ws_size < WS_END2) {
            fprintf(stderr, "kernel_launch: unexpected shapes / workspace (n_in %d, in0 %d, out %d, ws %zu, need %zu); nothing launched\n", n_in, n_in > 0 ? in_sizes[0] : -1, out_size, ws_size, (size_t)WS_END); grid = -1; return; }
        int dev = 0, cus = 0;
        if (hipGetDevice(&dev) != hipSuccess || hipDeviceGetAttribute(&cus, hipDeviceAttributeMultiprocessorCount, dev) != hipSuccess) { grid = -1; return; }
        if (hipFuncSetAttribute((const void*)fwd_kernel, hipFuncAttributeMaxDynamicSharedMemorySize, LDS_BYTES) != hipSuccess) { fprintf(stderr, "kernel_launch: hipFuncSetAttribute failed\n"); grid = -1; return; }
        int per_cu = 0;
        if (hipOccupancyMaxActiveBlocksPerMultiprocessor(&per_cu, (const void*)fwd_kernel, NTHR, LDS_BYTES) != hipSuccess || per_cu < 1) fprintf(stderr, "kernel_launch: occupancy query reports %d\n", per_cu);
        (void)hipGetLastError();
        grid = cus;
    }
    if (grid < 0) return;
    (void)hipMemsetAsync((char*)d_ws + WS_CTL, 0, CTL_BYTES, stream);
    Args a{};
    for (int i = 0; i < 17; ++i) a.in[i] = (const float*)d_in[i];
    a.out = (float*)d_out; a.ws = (unsigned char*)d_ws;
#if N_LAUNCH_MODE == 1
#ifdef PROBE_K
    a.ph_lo = 0; a.ph_hi = PROBE_K; a.flags = PROBE_FLAGS;
    hipLaunchKernelGGL(fwd_kernel, dim3(grid), dim3(NTHR), LDS_BYTES, stream, a);
    (void)hipMemsetAsync((char*)d_ws + WS_CTL, 0, CTL_BYTES, stream);
#endif
    a.ph_lo = 0; a.ph_hi = NPHASE; a.flags = 0;
    hipLaunchKernelGGL(fwd_kernel, dim3(grid), dim3(NTHR), LDS_BYTES, stream, a);
#else
    for (int p = 0; p < NPHASE; ++p) { a.ph_lo = p; a.ph_hi = p + 1; hipLaunchKernelGGL(fwd_kernel, dim3(grid), dim3(NTHR), LDS_BYTES, stream, a); }
#endif
}
```

```cpp
#include <hip/hip_runtime.h>
#include <cstdio>
#include <cstdint>

#ifndef PROBE_FLAGS
#define PROBE_FLAGS 0
#endif
#ifndef N_LAUNCH_MODE
#define N_LAUNCH_MODE 1
#endif

#define LAS __attribute__((address_space(3)))
typedef unsigned short bf16;
typedef short bf16x8 __attribute__((ext_vector_type(8)));
typedef float f32x2 __attribute__((ext_vector_type(2)));
typedef float f32x4 __attribute__((ext_vector_type(4)));
typedef float f32x16 __attribute__((ext_vector_type(16)));
typedef unsigned u32x2 __attribute__((ext_vector_type(2)));
typedef unsigned u32x4 __attribute__((ext_vector_type(4)));

constexpr int NTOK = 32768, DM = 1024, SEQ = 8192, NBATCH = 4;
constexpr int INC = 3584;
constexpr int C_HQ = 0, C_HF = 512, C_HI = 1024, C_HG = 1536, C_SQ = 2048, C_SK = 2560, C_SV = 3072;
constexpr int NE = 32, TOPK = 4, DFF = 1024, NK = NTOK * TOPK;
constexpr int ECAP = NTOK;
constexpr float EPS = 1e-5f, SW_LIMIT = 7.0f, SW_ALPHA = 1.702f;
constexpr float W8_SCALE = 64.0f, W8_INV = 1.0f / 64.0f;
constexpr float SB_PEXIT = 1.0e-30f;

constexpr size_t WS_WDN = 0;
constexpr size_t WS_WGU = WS_WDN + 67108864;
constexpr size_t WS_C = WS_WGU + 134217728;
constexpr size_t C_BYTES = (size_t)(NK + 256) * 2048;
constexpr size_t WS_D = WS_C + C_BYTES;
constexpr size_t WS_E = WS_D + 67108864;
constexpr size_t WS_H1B = WS_C;
constexpr size_t WS_MIX = WS_D;
constexpr size_t WS_H1Q = WS_WDN + 33554432;
constexpr size_t WS_PROJ = WS_C;
constexpr size_t WS_WIN = WS_PROJ + (size_t)NTOK * INC * 2;
constexpr size_t WS_WOUT = WS_WIN + (size_t)INC * 1024 * 2;
constexpr size_t WS_HST = WS_WOUT + (size_t)1024 * 1024 * 2;
constexpr size_t WS_HDEC = WS_HST + (size_t)256 * 65536;
static_assert(WS_HDEC + 256 * 128 * 4 <= WS_C + C_BYTES, "C region");
constexpr size_t WS_CTL = WS_E;
constexpr size_t CTL_BYTES = 1u << 20;
constexpr size_t WS_RSTD = WS_CTL + CTL_BYTES;
constexpr size_t WS_STOK = WS_RSTD + (size_t)NTOK * 4;
constexpr size_t WS_SGATE = WS_STOK + (size_t)NE * ECAP * 4;
constexpr size_t WS_SRSTD = WS_SGATE + (size_t)NE * ECAP * 4;
constexpr size_t WS_END = WS_SRSTD + (size_t)NE * ECAP * 4;
constexpr size_t HID_BYTES = (size_t)(NK + 256) * 1024;
constexpr size_t WS_HID = WS_C + C_BYTES - HID_BYTES;
constexpr size_t WS_Y = WS_WGU;
static_assert(WS_Y + (size_t)NK * DM <= WS_HID, "y vs hidden");
constexpr float Y8_SCALE = 16.0f, Y8_INV = 1.0f / 16.0f;
constexpr size_t WS_TSLOT = WS_END;
constexpr size_t WS_END2 = WS_TSLOT + (size_t)NTOK * 4 * 4;
constexpr int CW_JOB = 32;
constexpr int CW_CNT = 64;
constexpr int CW_BAR = 4096;

constexpr int RING_BYTES = 131072;
constexpr int MISC_OFF = RING_BYTES;
constexpr int IDX_OFF = MISC_OFF + 9216;
constexpr int META_OFF = MISC_OFF + 10240, META_BYTES = 3072;
constexpr int LDS_BYTES = 147456;
constexpr int NWAVES = 8, NTHR = 512;

__device__ __forceinline__ unsigned f2bf(float f) { unsigned u = __builtin_bit_cast(unsigned, f); return (u + 0x7fffu + ((u >> 16) & 1u)) >> 16; }
__device__ __forceinline__ unsigned cvtpk_bf16(float lo, float hi) { unsigned r; asm volatile("v_cvt_pk_bf16_f32 %0, %1, %2" : "=v"(r) : "v"(lo), "v"(hi)); return r; }
__device__ __forceinline__ unsigned pk2(float lo, float hi) { return cvtpk_bf16(lo, hi); }
__device__ __forceinline__ unsigned pk4_fp8(float a, float b, float c, float d) { int w = __builtin_amdgcn_cvt_pk_fp8_f32(a, b, 0, false); w = __builtin_amdgcn_cvt_pk_fp8_f32(c, d, w, true); return (unsigned)w; }
__device__ __forceinline__ float bf2f(unsigned b) { return __builtin_bit_cast(float, b << 16); }
__device__ __forceinline__ float bflo(unsigned w) { return __builtin_bit_cast(float, w << 16); }
__device__ __forceinline__ float bfhi(unsigned w) { return __builtin_bit_cast(float, w & 0xffff0000u); }
__device__ __forceinline__ float wave_sum(float v) {
#pragma unroll
    for (int o = 1; o < 64; o <<= 1) v += __shfl_xor(v, o);
    return v;
}
__device__ __forceinline__ float sigmoidf_(float x) { return __builtin_amdgcn_rcpf(1.0f + __builtin_amdgcn_exp2f(-1.44269504f * x)); }
__device__ __forceinline__ float siluf_(float x) { return x * sigmoidf_(x); }
__device__ __forceinline__ float exp_raw(float x) { return __builtin_amdgcn_exp2f(1.44269504f * x); }
__device__ __forceinline__ float softplusf_(float z) { return fmaxf(z, 0.f) + __logf(1.0f + __expf(-fabsf(z))); }
#define LDS_WAIT() asm volatile("s_waitcnt lgkmcnt(0)" ::: "memory")
#define VM_WAIT() asm volatile("s_waitcnt vmcnt(0)" ::: "memory")

struct Ctx {
    const float *x, *w_in, *w_out, *lb_logits, *hg_gain, *sb_gain, *mix_gain, *ffn_gain, *w_router, *b_router, *w_gate, *b_gate, *w_up, *b_up, *w_down, *b_down, *fin_gain;
    float* out; unsigned char* ws;
    LAS unsigned char* lds;
    int tid, lane, wave, G, bid, flags, vc;
};

#define XB_TMO      128
#define XB_XCNT(j)  (256  + 64 * (j))
#define XB_XSUB(j)  (1280 + 64 * (j))
#define XB_XGEN(j)  (2304 + 64 * (j))
#define XB_TOP      3328
#define XB_TOPGEN   3392
#define XCD_BAR_WORDS 3456
#define XB_SPIN_CAP (1u << 22)
__device__ __forceinline__ unsigned xb_ld(unsigned* p)              { return __hip_atomic_load(p, __ATOMIC_RELAXED, __HIP_MEMORY_SCOPE_AGENT); }
__device__ __forceinline__ unsigned xb_add(unsigned* p, unsigned v) { return __hip_atomic_fetch_add(p, v, __ATOMIC_RELAXED, __HIP_MEMORY_SCOPE_AGENT); }
__device__ __forceinline__ unsigned xb_xcc_id() { return (unsigned)__builtin_amdgcn_s_getreg((3 << 11) | 20) & 0xFu; }
#define XB_SPIN(cond, bar) do { unsigned _sp = 0; while (cond) { __builtin_amdgcn_s_sleep(1); \
    if ((++_sp & 255u) == 0u) { if (xb_ld(&(bar)[XB_TMO])) break; if (_sp > XB_SPIN_CAP) { atomicAdd(&(bar)[XB_TMO], 1u); break; } } } } while (0)
struct XcdBarrier { unsigned* bar; unsigned x; volatile LAS unsigned* st; };
__device__ __forceinline__ XcdBarrier xcd_barrier_post(unsigned* bar, volatile LAS unsigned* st) {
    XcdBarrier b; b.bar = bar; b.x = xb_xcc_id(); b.st = st;
    if (threadIdx.x == 0) st[2] = xb_add(&bar[XB_XCNT(b.x)], 1u);
    return b;
}
__device__ __forceinline__ void xcd_barrier_complete(unsigned* bar, unsigned x, unsigned& nloc, unsigned& nx) {
    const unsigned G = gridDim.x * gridDim.y * gridDim.z;
    unsigned sum, cnt, mine, sp = 0u;
    for (;;) {
        sum = 0u; cnt = 0u; mine = 0u;
        unsigned cv[16];
#pragma unroll
        for (unsigned j = 0; j < 16; ++j) cv[j] = xb_ld(&bar[XB_XCNT(j)]);
        asm volatile("" ::: "memory");
#pragma unroll
        for (unsigned j = 0; j < 16; ++j) { const unsigned c = cv[j]; sum += c; cnt += (c > 0u) ? 1u : 0u; mine = (j == x) ? c : mine; }
        if (sum == G) break;
        __builtin_amdgcn_s_sleep(1);
        if ((++sp & 255u) == 0u) { if (xb_ld(&bar[XB_TMO])) break; if (sp > XB_SPIN_CAP) { atomicAdd(&bar[XB_TMO], 1u); break; } }
    }
    nloc = mine > 0u ? mine : 1u; nx = cnt > 0u ? cnt : 1u;
}
__device__ __forceinline__ void xcd_barrier(const XcdBarrier& b) {
    asm volatile("s_waitcnt vmcnt(0)" ::: "memory");
    __syncthreads();
    if (threadIdx.x == 0) {
        unsigned* bar = b.bar;
        __builtin_amdgcn_s_waitcnt(0);
        unsigned nloc = b.st[0], nx = b.st[1];
        if (nloc == 0u) { xcd_barrier_complete(bar, b.x, nloc, nx); b.st[0] = nloc; b.st[1] = nx; }
        const unsigned old = xb_add(&bar[XB_XSUB(b.x)], 1u);
        const unsigned gen = old / nloc;
        if (old + 1u == (gen + 1u) * nloc) {
            __builtin_amdgcn_fence(__ATOMIC_RELEASE, "agent");
            asm volatile("s_waitcnt vmcnt(0)" ::: "memory");
            const unsigned og = xb_add(&bar[XB_TOP], 1u);
            const unsigned tg = og / nx;
            if (og + 1u == (tg + 1u) * nx) xb_add(&bar[XB_TOPGEN], 1u);
            else XB_SPIN(xb_ld(&bar[XB_TOPGEN]) == tg, bar);
            __builtin_amdgcn_fence(__ATOMIC_ACQUIRE, "agent");
            xb_add(&bar[XB_XGEN(b.x)], 1u);
            asm volatile("s_waitcnt vmcnt(0)" ::: "memory");
        } else {
            XB_SPIN(xb_ld(&bar[XB_XGEN(b.x)]) == gen, bar);
            __builtin_amdgcn_fence(__ATOMIC_ACQUIRE, "agent");
            asm volatile("s_waitcnt vmcnt(0)" ::: "memory");
        }
    }
    __syncthreads();
}

namespace gm {
constexpr int BM = 256, BK = 64, HALF = 128, HTB = HALF * BK * 2, NXCD = 8, WGM = 8;
typedef int v8i32 __attribute__((ext_vector_type(8)));
__device__ __forceinline__ int lds_byte(int r, int c) { const int st = (r >> 4) * 2 + (c >> 5), rr = r & 15, cc = c & 31, ob = rr * 64 + cc * 2; return st * 1024 + (ob ^ (((ob >> 9) & 1) << 5)); }
__device__ __forceinline__ void stage_rc(int b, int& R, int& C) { const int st = b / 1024, sb = b % 1024, swz = sb ^ (((sb >> 9) & 1) << 5); R = (st >> 1) * 16 + swz / 64; C = (st & 1) * 32 + (swz % 64) / 2; }
__device__ __forceinline__ int perm32(int rho) { const int n = rho >> 4, i = rho & 15; return 8 * (i >> 2) + 4 * n + (i & 3); }
__device__ __forceinline__ unsigned cvt_pk_bf16(float lo, float hi) { unsigned r; asm volatile("v_cvt_pk_bf16_f32 %0, %1, %2" : "=v"(r) : "v"(lo), "v"(hi)); return r; }

struct Unit { const char* A; const char* B; int pm, pn, e, rows; };

__device__ __forceinline__ bool order_next(int i, int G, int c, int nM, int nN, int& pm, int& pn) {
    const int nwg = nM * nN; const long L = (long)i * G + c; if (L >= nwg) return false;
    int wgid = (int)L; { const int q = nwg / NXCD, r = nwg % NXCD, xcd = wgid % NXCD, off = wgid / NXCD; wgid = (xcd < r ? xcd * (q + 1) : r * (q + 1) + (xcd - r) * q) + off; }
    const int nig = WGM * nN, gid = wgid / nig, fm = gid * WGM, gsz = (nM - fm) < WGM ? (nM - fm) : WGM;
    pm = fm + ((wgid % nig) % gsz); pn = (wgid % nig) / gsz; return true;
}

__device__ __forceinline__ void acc_zero(f32x4 (&acc)[2][2][4][2]) {
#pragma unroll
    for (int a = 0; a < 2; ++a)
#pragma unroll
        for (int b = 0; b < 2; ++b)
#pragma unroll
            for (int m = 0; m < 4; ++m)
#pragma unroll
                for (int n = 0; n < 2; ++n) acc[a][b][m][n] = (f32x4){0.f, 0.f, 0.f, 0.f};
}
template <class P>
__device__ __forceinline__ void gemm_phase(LAS unsigned char* lds, const P& S) {
    const int tid = threadIdx.x, wid = __builtin_amdgcn_readfirstlane(tid >> 6), lane = tid & 63, wr = wid >> 2, wc = wid & 3, fr = lane & 15, fq = lane >> 4;
    constexpr int NT = P::FP8 ? 8 : 16, KB = P::FP8 ? 1024 : 2048;
    int R0, C0, R1, C1; stage_rc(tid * 16, R0, C0); stage_rc(tid * 16 + 8192, R1, C1);
    unsigned voffB[2];
    { const int Rb0 = P::PERM ? ((R0 & ~31) + perm32(R0 & 31)) : R0, Rb1 = P::PERM ? ((R1 & ~31) + perm32(R1 & 31)) : R1;
      voffB[0] = (unsigned)(Rb0 * KB + C0 * 2); voffB[1] = (unsigned)(Rb1 * KB + C1 * 2); }
    const size_t kstep = (size_t)(BK * 2), hstepB = (size_t)HALF * KB;
    const unsigned ldsw = (unsigned)wid * 1024u;
    const int aoff = lds_byte(wr * 64 + fr, fq * 8), boff = lds_byte(wc * 32 + fr, fq * 8);
#define G_SA(b, h) (((b) * 2 + (h)) * HTB)
#define G_SB(b, h) ((4 + (b) * 2 + (h)) * HTB)
#define G_STAGEB(bufoff, gbase) do { const char* _gb = (gbase); asm volatile("" : "+s"(_gb)); _Pragma("unroll") for (int _i = 0; _i < 2; ++_i) \
        __builtin_amdgcn_global_load_lds((const unsigned*)(_gb + voffB[_i]), (LAS unsigned*)(lds + (bufoff) + ldsw + _i * 8192), 16, 0, 0); } while (0)
#define G_STAGEA(bufoff, gbase, vo, h) do { const char* _gb = (gbase); asm volatile("" : "+s"(_gb)); _Pragma("unroll") for (int _i = 0; _i < 2; ++_i) \
        __builtin_amdgcn_global_load_lds((const unsigned*)(_gb + (vo)[h][_i]), (LAS unsigned*)(lds + (bufoff) + ldsw + _i * 8192), 16, 0, 0); } while (0)
#define G_LD16(off) (*(const LAS bf16x8*)(lds + (off)))
#define G_CAT2(lo, hi) __builtin_bit_cast(v8i32, __builtin_shufflevector(lo, hi, 0, 1, 2, 3, 4, 5, 6, 7, 8, 9, 10, 11, 12, 13, 14, 15))
#define G_LDA(dst, b, h) do { _Pragma("unroll") for (int m = 0; m < 4; ++m) { if constexpr (P::FP8) dst##8[m] = G_CAT2(G_LD16(G_SA(b, h) + aoff + m * 2048), G_LD16(G_SA(b, h) + aoff + m * 2048 + 1024)); \
        else { _Pragma("unroll") for (int k = 0; k < 2; ++k) dst[m][k] = G_LD16(G_SA(b, h) + aoff + m * 2048 + k * 1024); } } } while (0)
#define G_LDB(dst, b, h) do { _Pragma("unroll") for (int n = 0; n < 2; ++n) { if constexpr (P::FP8) dst##8[n] = G_CAT2(G_LD16(G_SB(b, h) + boff + n * 2048), G_LD16(G_SB(b, h) + boff + n * 2048 + 1024)); \
        else { _Pragma("unroll") for (int k = 0; k < 2; ++k) dst[n][k] = G_LD16(G_SB(b, h) + boff + n * 2048 + k * 1024); } } } while (0)
#define G_MMA(ai, bj, At, Bt) do { __builtin_amdgcn_s_setprio(1); _Pragma("unroll") for (int m = 0; m < 4; ++m) _Pragma("unroll") for (int n = 0; n < 2; ++n) { \
        if constexpr (P::FP8) asm volatile("v_mfma_f32_16x16x128_f8f6f4 %0, %1, %2, %0" : "+v"(acc[ai][bj][m][n]) : "v"(Bt##8[n]), "v"(At##8[m])); \
        else { _Pragma("unroll") for (int k = 0; k < 2; ++k) acc[ai][bj][m][n] = __builtin_amdgcn_mfma_f32_16x16x32_bf16(Bt[n][k], At[m][k], acc[ai][bj][m][n], 0, 0, 0); } } \
        __builtin_amdgcn_s_setprio(0); } while (0)
#define G_MMA_TAIL() do { if constexpr (P::FP8) asm volatile("s_nop 15" ::: "memory"); } while (0)
#define G_WAIT_V(n) asm volatile("s_waitcnt vmcnt(" #n ")" ::: "memory")
#define G_WAIT_L(n) asm volatile("s_waitcnt lgkmcnt(" #n ")" ::: "memory")
#define G_BAR __builtin_amdgcn_s_barrier()
#define G_SCHED __builtin_amdgcn_sched_barrier(0)
    Unit cur, nxt; int ui = 0;
    if (!S.next(0, cur)) return;
    f32x4 acc[2][2][4][2];
    S.acc_init(acc, cur, wr, wc, fr, fq);
    bf16x8 At[4][2], B0[2][2], B1[2][2]; v8i32 At8[4], B08[2], B18[2];
    unsigned voA[2][2];
    S.a_off(cur, R0, C0, R1, C1, voA);
    const char* cA = cur.A; const char* cB = cur.B;
    G_STAGEB(G_SB(0, 0), cB); G_STAGEB(G_SB(0, 1), cB + hstepB); G_STAGEA(G_SA(0, 0), cA + S.koff(0), voA, 0); G_STAGEA(G_SA(0, 1), cA + S.koff(0), voA, 1);
    if (wr == 1) G_BAR;
    G_WAIT_V(2); G_BAR;
    G_STAGEB(G_SB(1, 0), cB + kstep); G_STAGEA(G_SA(1, 0), cA + S.koff(1), voA, 0); G_STAGEB(G_SB(1, 1), cB + hstepB + kstep);
    G_WAIT_V(6); G_BAR;
    for (;;) {
        const bool has_next = S.next(ui + 1, nxt);
        const char* nA = has_next ? nxt.A : cA; const char* nB = has_next ? nxt.B : cB;
        S.meta_prefetch(cur, lds, wid, ui);
        if constexpr (P::GATHER) { if (has_next) S.idx_prefetch(nxt, lds, wid); }
#pragma unroll 1
        for (int t = 0; t < NT; t += 2) {
            const bool last = (t == NT - 2);
            const char* a1 = cA + S.koff(t + 1);
            const char* a2 = last ? nA + S.koff(0) : cA + S.koff(t + 2); const char* b2 = last ? nB : cB + (size_t)(t + 2) * kstep;
            const char* a3 = last ? nA + S.koff(1) : cA + S.koff(t + 3); const char* b3 = b2 + kstep;
            G_LDB(B0, 0, 0); G_LDB(B1, 0, 1); G_SCHED; G_LDA(At, 0, 0); G_STAGEA(G_SA(1, 1), a1, voA, 1);
            if constexpr (P::GATHER) { if (last && has_next) S.a_off_lds(nxt, R0, C0, R1, C1, lds, voA); }
            G_WAIT_V(8); G_WAIT_L(0); G_BAR; G_MMA(0, 0, At, B0); G_MMA(0, 1, At, B1); G_BAR; G_SCHED;
            G_LDA(At, 0, 1); G_STAGEB(G_SB(0, 0), b2); G_STAGEB(G_SB(0, 1), b2 + hstepB); G_STAGEA(G_SA(0, 0), a2, voA, 0);
            G_WAIT_V(8); G_WAIT_L(0); G_BAR; G_MMA(1, 0, At, B0); G_MMA(1, 1, At, B1); G_BAR; G_SCHED;
            G_LDB(B0, 1, 0); G_LDB(B1, 1, 1); G_SCHED; G_LDA(At, 1, 0); G_STAGEA(G_SA(0, 1), a2, voA, 1);
            G_WAIT_V(8); G_WAIT_L(0); G_BAR; G_MMA(0, 0, At, B0); G_MMA(0, 1, At, B1); G_BAR; G_SCHED;
            G_LDA(At, 1, 1); G_STAGEB(G_SB(1, 0), b3); G_STAGEB(G_SB(1, 1), b3 + hstepB); G_STAGEA(G_SA(1, 0), a3, voA, 0);
            G_WAIT_V(8); G_WAIT_L(0); G_BAR; G_MMA(1, 0, At, B0); G_MMA(1, 1, At, B1); G_MMA_TAIL(); G_BAR; G_SCHED;
        }
        if (wr == 0) G_BAR;
        S.epi(acc, cur, wr, wc, fr, fq, lds, ui);
        if (!has_next) break;
        S.acc_init(acc, nxt, wr, wc, fr, fq);
        cur = nxt; cA = nA; cB = nB; ++ui;
        if (wr == 1) G_BAR;
    }
    G_WAIT_V(0);
    G_BAR;
#undef G_SA
#undef G_SB
#undef G_STAGEA
#undef G_STAGEB
#undef G_LDA
#undef G_LDB
#undef G_MMA
#undef G_MMA_TAIL
#undef G_CAT2
#undef G_LD16
#undef G_WAIT_V
#undef G_WAIT_L
#undef G_BAR
#undef G_SCHED
}
}

template <bool FP8> __device__ __forceinline__ void p0_tile(const f32x4 (&rg)[8], unsigned (&o)[16], int k0, const LAS float* kscale, float mult, LAS float* scr, int lane) {
    const int kr = lane >> 4, c16 = lane & 15;
    asm volatile("" ::: "memory");
#pragma unroll
    for (int j = 0; j < 8; ++j) *(LAS f32x4*)(scr + (4 * j + kr) * 68 + 4 * c16) = rg[j];
    asm volatile("" ::: "memory");
    float v[32];
#pragma unroll
    for (int k = 0; k < 32; ++k) v[k] = scr[k * 68 + lane] * mult;
    if (kscale) {
#pragma unroll
        for (int q = 0; q < 8; ++q) { const f32x4 g = *(const LAS f32x4*)(kscale + k0 + 4 * q); v[4 * q] *= g[0]; v[4 * q + 1] *= g[1]; v[4 * q + 2] *= g[2]; v[4 * q + 3] *= g[3]; }
    }
    if constexpr (FP8) {
#pragma unroll
        for (int q = 0; q < 8; ++q) o[q] = pk4_fp8(v[4 * q], v[4 * q + 1], v[4 * q + 2], v[4 * q + 3]);
    } else {
#pragma unroll
        for (int q = 0; q < 16; ++q) o[q] = pk2(v[2 * q], v[2 * q + 1]);
    }
    asm volatile("" ::: "memory");
}
template <bool FP8> __device__ __forceinline__ void p0_job(const float* W, int N, unsigned char* WT, int n0, int kq, long drow0, const LAS float* kscale, float mult, LAS float* scr, int lane) {
    const int kr = lane >> 4, c16 = lane & 15;
    const float* src = W + (size_t)(kq * 256 + kr) * N + n0 + 4 * c16;
    f32x4 rr[3][8];
#pragma unroll
    for (int j = 0; j < 8; ++j) rr[0][j] = __builtin_nontemporal_load((const f32x4*)(src + (size_t)(4 * j) * N));
#pragma unroll
    for (int j = 0; j < 8; ++j) rr[1][j] = __builtin_nontemporal_load((const f32x4*)(src + (size_t)(32 + 4 * j) * N));
#pragma unroll
    for (int j = 0; j < 8; ++j) rr[2][j] = __builtin_nontemporal_load((const f32x4*)(src + (size_t)(64 + 4 * j) * N));
    unsigned char* drow = WT + (size_t)(drow0 + lane) * (FP8 ? 1024 : 2048) + (size_t)kq * 256 * (FP8 ? 1 : 2);
    unsigned line[32];
#pragma unroll
    for (int t = 0; t < 8; ++t) {
        f32x4 cur[8];
#pragma unroll
        for (int j = 0; j < 8; ++j) cur[j] = rr[t % 3][j];
        if (t + 3 < 8) {
#pragma unroll
            for (int j = 0; j < 8; ++j) rr[t % 3][j] = __builtin_nontemporal_load((const f32x4*)(src + (size_t)(32 * (t + 3) + 4 * j) * N));
        }
        unsigned o[16];
        p0_tile<FP8>(cur, o, kq * 256 + 32 * t, kscale, mult, scr, lane);
        if constexpr (FP8) {
#pragma unroll
            for (int q = 0; q < 8; ++q) line[8 * (t & 3) + q] = o[q];
            if ((t & 3) == 3) {
#pragma unroll
                for (int q = 0; q < 8; ++q) *(u32x4*)(drow + 128 * (t >> 2) + 16 * q) = (u32x4){line[4 * q], line[4 * q + 1], line[4 * q + 2], line[4 * q + 3]};
            }
        } else {
#pragma unroll
            for (int q = 0; q < 16; ++q) line[16 * (t & 1) + q] = o[q];
            if ((t & 1) == 1) {
#pragma unroll
                for (int q = 0; q < 8; ++q) *(u32x4*)(drow + 128 * (t >> 1) + 16 * q) = (u32x4){line[4 * q], line[4 * q + 1], line[4 * q + 2], line[4 * q + 3]};
            }
        }
    }
}
__device__ __forceinline__ void p0_mini_bf16(const float* W, int N, unsigned char* WT, int n0, int kc, LAS float* scr, int lane) {
    const int kr = lane >> 4, c16 = lane & 15;
    const float* src = W + (size_t)(kc * 64 + kr) * N + n0 + 4 * c16;
    f32x4 r0[8], r1[8];
#pragma unroll
    for (int j = 0; j < 8; ++j) { r0[j] = __builtin_nontemporal_load((const f32x4*)(src + (size_t)(4 * j) * N)); r1[j] = __builtin_nontemporal_load((const f32x4*)(src + (size_t)(32 + 4 * j) * N)); }
    unsigned char* drow = WT + (size_t)(n0 + lane) * 2048 + (size_t)kc * 128;
    unsigned o0[16], o1[16];
    p0_tile<false>(r0, o0, 0, nullptr, 1.0f, scr, lane);
    p0_tile<false>(r1, o1, 0, nullptr, 1.0f, scr, lane);
#pragma unroll
    for (int q = 0; q < 4; ++q) { *(u32x4*)(drow + 16 * q) = (u32x4){o0[4 * q], o0[4 * q + 1], o0[4 * q + 2], o0[4 * q + 3]}; *(u32x4*)(drow + 64 + 16 * q) = (u32x4){o1[4 * q], o1[4 * q + 1], o1[4 * q + 2], o1[4 * q + 3]}; }
}
__device__ __forceinline__ void moe_one_job(Ctx& F, int r, LAS float* scr, const LAS float* gainl) {
    unsigned char* WGU = F.ws + WS_WGU; unsigned char* WDN = F.ws + WS_WDN;
    constexpr int J_E = 16 * 4;
    const int e = r / (3 * J_E), q = r % (3 * J_E), which = q / J_E, rr = q % J_E, nb = rr & 15, kq = rr >> 4, n0 = nb * 64;
    if (which == 0) p0_job<true>(F.w_gate + (size_t)e * 1048576, 1024, WGU, n0, kq, (long)(e * 8 + (n0 >> 7)) * 256 + (n0 & 127), gainl, W8_SCALE, scr, F.lane);
    else if (which == 1) p0_job<true>(F.w_up + (size_t)e * 1048576, 1024, WGU, n0, kq, (long)(e * 8 + (n0 >> 7)) * 256 + 128 + (n0 & 127), gainl, W8_SCALE, scr, F.lane);
    else p0_job<true>(F.w_down + (size_t)e * 1048576, 1024, WDN, n0, kq, (long)e * 1024 + n0, nullptr, W8_SCALE, scr, F.lane);
}
constexpr int CONV_W0 = 0, ATT_NW = 8;
__device__ __forceinline__ void moe_convert_jobs(Ctx& F, LAS float* scr, const LAS float* gainl) {
    unsigned* ctr = (unsigned*)(F.ws + WS_CTL) + CW_JOB;
    constexpr int NJ = NE * 3 * 64;
    const int nstatic = (F.G * 16 <= NJ) ? F.G * 16 : 0;
    if (F.wave >= CONV_W0 && nstatic) { const int j0 = F.bid * 16 + (F.wave - CONV_W0);
        for (int r = j0; r < j0 + 16; r += NWAVES - CONV_W0) moe_one_job(F, r, scr, gainl); }
    for (;;) {
        unsigned tk = 0; if (F.lane == 0) tk = __hip_atomic_fetch_add(ctr, 2u, __ATOMIC_RELAXED, __HIP_MEMORY_SCOPE_AGENT);
        const int j0 = nstatic + __builtin_amdgcn_readfirstlane((int)tk);
        if (j0 >= NJ) break;
        for (int r = j0; r < j0 + 2; ++r) moe_one_job(F, r, scr, gainl);
    }
}
__device__ __forceinline__ void phase0(Ctx& F) {
    LAS float* scr = (LAS float*)(F.lds + F.wave * 16384);
    const int gw = F.bid * NWAVES + F.wave, NGW = F.G * NWAVES;
    unsigned char* WIN = F.ws + WS_WIN; unsigned char* WOUT = F.ws + WS_WOUT;
    constexpr int J_IN = (INC / 64) * 16, J_OUT = 16 * 16;
    constexpr int NJOBS = J_IN + J_OUT;
    for (int it = gw; it < NJOBS; it += NGW) {
        int r = it;
        if (r < J_IN) { const int nb = r >> 4, kc = r & 15; p0_mini_bf16(F.w_in, INC, WIN, nb * 64, kc, scr, F.lane); continue; } r -= J_IN;
        { const int nb = r >> 4, kc = r & 15; p0_mini_bf16(F.w_out, 1024, WOUT, nb * 64, kc, scr, F.lane); }
    }
    bf16* U = (bf16*)(F.ws + WS_D);
    const f32x4* gr = (const f32x4*)F.mix_gain + F.lane;
    f32x4 g[4];
#pragma unroll
    for (int j = 0; j < 4; ++j) g[j] = gr[64 * j];
    f32x4 nv[4];
    if (gw < NTOK) {
#pragma unroll
        for (int j = 0; j < 4; ++j) nv[j] = __builtin_nontemporal_load((const f32x4*)(F.x + (size_t)gw * DM) + F.lane + 64 * j);
    }
    for (int m = gw; m < NTOK; m += NGW) {
        f32x4 v[4]; float s = 0.f;
#pragma unroll
        for (int j = 0; j < 4; ++j) v[j] = nv[j];
        if (m + NGW < NTOK) {
#pragma unroll
            for (int j = 0; j < 4; ++j) nv[j] = __builtin_nontemporal_load((const f32x4*)(F.x + (size_t)(m + NGW) * DM) + F.lane + 64 * j);
        }
#pragma unroll
        for (int j = 0; j < 4; ++j) s += (v[j].x * v[j].x + v[j].y * v[j].y) + (v[j].z * v[j].z + v[j].w * v[j].w);
        const float rstd = 1.0f / sqrtf(wave_sum(s) * (1.f / DM) + EPS);
        unsigned long long* o8 = (unsigned long long*)(U + (size_t)m * DM) + F.lane;
#pragma unroll
        for (int j = 0; j < 4; ++j)
            o8[64 * j] = (unsigned long long)pk2(v[j].x * rstd * g[j].x, v[j].y * rstd * g[j].y) | ((unsigned long long)pk2(v[j].z * rstd * g[j].z, v[j].w * rstd * g[j].w) << 32);
    }
}

struct P1Pol {
    static constexpr bool PERM = true, FP8 = false, GATHER = false;
    const char* A; const char* B; bf16* O; const float* lbl; int G, c, flags;
    __device__ __forceinline__ bool next(int i, gm::Unit& u) const { int pm, pn; if (!gm::order_next(i, G, c, NTOK / 256, INC / 256, pm, pn)) return false;
        u.pm = pm; u.pn = pn; u.A = A + (size_t)pm * 256 * 2048; u.B = B + (size_t)pn * 256 * 2048; u.e = 0; u.rows = 256; return true; }
    __device__ __forceinline__ void a_off(const gm::Unit&, int R0, int C0, int R1, int C1, unsigned (&vo)[2][2]) const {
        vo[0][0] = (unsigned)(R0 * 1024 + C0) * 2u; vo[0][1] = (unsigned)(R1 * 1024 + C1) * 2u; vo[1][0] = vo[0][0] + 128u * 2048u; vo[1][1] = vo[0][1] + 128u * 2048u; }
    __device__ __forceinline__ size_t koff(int t) const { return (size_t)t * 128; }
    template <int TYPE> __device__ __forceinline__ void epi_t(const f32x4 (&acc)[2][2][4][2], const gm::Unit& u, int wr, int wc, int fr, int fq) const {
        const int row0 = u.pm * 256 + wr * 64 + fr, col0 = u.pn * 256 + wc * 32 + 8 * fq;
        f32x4 lbv[2][2];
        if constexpr (TYPE == 1) {
#pragma unroll
            for (int bj = 0; bj < 2; ++bj)
#pragma unroll
                for (int n = 0; n < 2; ++n) { const int c = col0 + bj * 128 + 4 * n - C_HF; const f32x4 a0 = *(const f32x4*)(lbl + c), a1 = *(const f32x4*)(lbl + 512 + c);
#pragma unroll
                    for (int j = 0; j < 4; ++j) lbv[bj][n][j] = sigmoidf_(a0[j] - a1[j]); }
        }
#pragma unroll
        for (int ai = 0; ai < 2; ++ai)
#pragma unroll
            for (int m = 0; m < 4; ++m) { bf16* rowp = O + (size_t)(row0 + ai * 128 + m * 16) * INC + col0;
#pragma unroll
                for (int bj = 0; bj < 2; ++bj) { f32x4 v[2];
#pragma unroll
                    for (int n = 0; n < 2; ++n) { const f32x4 x = acc[ai][bj][m][n];
                        if constexpr (TYPE == 0 || TYPE == 1) {
                            const f32x4 t = x * (-1.44269504f); f32x4 e, s;
#pragma unroll
                            for (int j = 0; j < 4; ++j) e[j] = __builtin_amdgcn_exp2f(t[j]);
                            const f32x4 d = e + 1.0f;
#pragma unroll
                            for (int j = 0; j < 4; ++j) s[j] = __builtin_amdgcn_rcpf(d[j]);
                            if constexpr (TYPE == 0) v[n] = x * s;
                            else { const f32x4 lb = lbv[bj][n], a = lb + (1.0f - lb) * s;
#pragma unroll
                                for (int j = 0; j < 4; ++j) v[n][j] = 0.69314718f * __builtin_amdgcn_logf(a[j]); }
                        } else if constexpr (TYPE == 4) v[n] = x * 0.125f;
                        else v[n] = x; }
                    u32x4 w; w.x = gm::cvt_pk_bf16(v[0][0], v[0][1]); w.y = gm::cvt_pk_bf16(v[0][2], v[0][3]); w.z = gm::cvt_pk_bf16(v[1][0], v[1][1]); w.w = gm::cvt_pk_bf16(v[1][2], v[1][3]);
                    *(u32x4*)(rowp + bj * 128) = w; } }
    }
    __device__ __forceinline__ void acc_init(f32x4 (&acc)[2][2][4][2], const gm::Unit&, int, int, int, int) const { gm::acc_zero(acc); }
    __device__ __forceinline__ void meta_prefetch(const gm::Unit&, LAS unsigned char*, int, int) const {}
    __device__ __forceinline__ void epi(const f32x4 (&acc)[2][2][4][2], const gm::Unit& u, int wr, int wc, int fr, int fq, LAS unsigned char*, int) const {
        if (flags & 1) { if (acc[0][0][0][0][0] == 1.2345e-30f) O[0] = 1; return; }
        const int type = u.pn >> 1;
        if (type == 0 || type == 3) epi_t<0>(acc, u, wr, wc, fr, fq);
        else if (type == 1) epi_t<1>(acc, u, wr, wc, fr, fq);
        else if (type == 4) epi_t<4>(acc, u, wr, wc, fr, fq);
        else epi_t<2>(acc, u, wr, wc, fr, fq);
    }
};
__device__ __forceinline__ void phase1(Ctx& F) {
    P1Pol S{(const char*)(F.ws + WS_D), (const char*)(F.ws + WS_WIN), (bf16*)(F.ws + WS_PROJ), F.lb_logits, F.G, F.vc, F.flags};
    gm::gemm_phase<P1Pol>(F.lds, S);
}

typedef short s16x4 __attribute__((ext_vector_type(4)));
__device__ __forceinline__ s16x4 tr_read(LAS const unsigned char* p) { return __builtin_bit_cast(s16x4, __builtin_amdgcn_ds_read_tr16_b64_v4i16((LAS s16x4*)p)); }
__device__ __forceinline__ bf16x8 cat8(s16x4 a, s16x4 b) { return (bf16x8){a[0], a[1], a[2], a[3], b[0], b[1], b[2], b[3]}; }
__device__ __forceinline__ bf16x8 pack8(f32x4 a, f32x4 b) { u32x4 w; w.x = gm::cvt_pk_bf16(a[0], a[1]); w.y = gm::cvt_pk_bf16(a[2], a[3]); w.z = gm::cvt_pk_bf16(b[0], b[1]); w.w = gm::cvt_pk_bf16(b[2], b[3]); return __builtin_bit_cast(bf16x8, w); }
#define MFMA16(a, b, c) __builtin_amdgcn_mfma_f32_16x16x32_bf16((a), (b), (c), 0, 0, 0)
#define MFMA32(a, b, c) __builtin_amdgcn_mfma_f32_32x32x16_bf16((a), (b), (c), 0, 0, 0)
constexpr int SBV_PITCH = 192, SBV_BYTES = 32 * SBV_PITCH, SBG_OFF = 118784;
__device__ __forceinline__ void sb_attn_fast(Ctx& F, int nw) {
    bf16* PROJ = (bf16*)(F.ws + WS_PROJ);
    LAS unsigned char* VT = F.lds + F.wave * SBV_BYTES;
    const int l = F.lane, c = l & 31, hh = l >> 5, i = l & 15, sub = (l >> 4) & 1;
    const int gw = F.bid * nw + F.wave, NGW = F.G * nw;
    const bool xl = (F.G == 256) && (nw == 4);
    const int xcd = F.vc & 7, wx = (F.vc >> 3) * 4 + F.wave;
    for (int n = 0; ; ++n) {
        int qt, bh;
        if (xl) { if (n >= 8) break; bh = xcd + 8 * (n >> 1); qt = wx + 128 * (n & 1); }
        else { const int item = gw + n * NGW; if (item >= NBATCH * 8 * (SEQ / 32)) break; qt = item & 255; bh = item >> 8; }
        const int b = bh >> 3, h = bh & 7, t0 = qt * 32;
        const size_t tokbase = (size_t)b * SEQ;
        const bf16* qp = PROJ + (tokbase + t0 + c) * INC + C_SQ + h * 64;
        bf16* mixp = (bf16*)(F.ws + WS_MIX) + (tokbase + t0 + c) * DM + 512 + h * 64;
        bf16x8 qfr[4];
#pragma unroll
        for (int ks = 0; ks < 4; ++ks) qfr[ks] = *(const bf16x8*)(qp + 16 * ks + 8 * hh);
        const bf16* kb = PROJ + tokbase * INC + C_SK + h * 64 + 8 * hh;
        const bf16* vb = PROJ + tokbase * INC + C_SV + h * 64 + (l & 7) * 8;
        f32x16 O0, O1;
#pragma unroll
        for (int r = 0; r < 16; ++r) { O0[r] = 0.f; O1[r] = 0.f; }
        float prun = 1.0f;
        bf16x8 kn[3][4]; u32x4 vn[3][4];
#pragma unroll
        for (int d = 0; d < 3; ++d) { const int sd = (t0 - 32 * d) > 0 ? (t0 - 32 * d) : 0;
#pragma unroll
            for (int ks = 0; ks < 4; ++ks) kn[d][ks] = *(const bf16x8*)(kb + (size_t)(sd + c) * INC + 16 * ks);
#pragma unroll
            for (int q = 0; q < 4; ++q) vn[d][q] = *(const u32x4*)(vb + (size_t)(sd + 8 * q + (l >> 3)) * INC);
            asm volatile("" ::: "memory");
        }
#define ATT_TILE(SV, D) { \
            const int s_ = (SV); const int sn_ = (s_ - 96) > 0 ? (s_ - 96) : 0; \
            asm volatile("" ::: "memory"); \
            _Pragma("unroll") for (int q = 0; q < 4; ++q) *(LAS u32x4*)(VT + (8 * q + (l >> 3)) * SBV_PITCH + (l & 7) * 16) = vn[D][q]; \
            asm volatile("" ::: "memory"); \
            f32x16 z; \
            _Pragma("unroll") for (int r = 0; r < 16; ++r) z[r] = 0.f; \
            _Pragma("unroll") for (int ks = 0; ks < 4; ++ks) z = MFMA32(kn[D][ks], qfr[ks], z); \
            __builtin_amdgcn_sched_barrier(0); \
            _Pragma("unroll") for (int ks = 0; ks < 4; ++ks) kn[D][ks] = *(const bf16x8*)(kb + (size_t)(sn_ + c) * INC + 16 * ks); \
            _Pragma("unroll") for (int q = 0; q < 4; ++q) vn[D][q] = *(const u32x4*)(vb + (size_t)(sn_ + 8 * q + (l >> 3)) * INC); \
              \
            float sg[16], om[16]; \
            _Pragma("unroll") for (int r = 0; r < 16; ++r) { const float e = __builtin_amdgcn_exp2f(-fmaxf(z[r] * 1.44269504f, -120.f)); \
                sg[r] = __builtin_amdgcn_rcpf(1.0f + e); om[r] = e * sg[r]; } \
            if (s_ == t0) {                    \
                _Pragma("unroll") for (int r = 0; r < 16; ++r) { const bool ok = ((r & 3) + 8 * (r >> 2) + 4 * hh) < c; sg[r] = ok ? sg[r] : 0.f; om[r] = ok ? om[r] : 1.0f; } } \
            float gs[4], pg[4]; \
            _Pragma("unroll") for (int q = 0; q < 4; ++q) { gs[q] = (om[4 * q] * om[4 * q + 1]) * (om[4 * q + 2] * om[4 * q + 3]); pg[q] = __shfl_xor(gs[q], 32); } \
            float lgq[4]; float tail = 1.0f; \
            _Pragma("unroll") for (int q = 3; q >= 0; --q) { lgq[q] = tail * (hh == 0 ? pg[q] : 1.0f); tail *= gs[q] * pg[q]; } \
            f32x4 a4[4]; \
            _Pragma("unroll") for (int q = 0; q < 4; ++q) { const float w3 = prun * lgq[q], w2 = w3 * om[4 * q + 3], w1 = w2 * om[4 * q + 2], w0 = w1 * om[4 * q + 1]; \
                a4[q] = (f32x4){sg[4 * q] * w0, sg[4 * q + 1] * w1, sg[4 * q + 2] * w2, sg[4 * q + 3] * w3}; } \
            prun *= tail; \
            const bf16x8 p0 = pack8(a4[0], a4[1]), p1 = pack8(a4[2], a4[3]); \
            asm volatile("" ::: "memory"); \
            _Pragma("unroll") for (int s2 = 0; s2 < 2; ++s2) { const bf16x8 pf = s2 ? p1 : p0; \
                LAS const unsigned char* vr = VT + (16 * s2 + 4 * hh + (i >> 2)) * SBV_PITCH + (16 * sub + 4 * (i & 3)) * 2; \
                const bf16x8 v0 = cat8(tr_read(vr), tr_read(vr + 8 * SBV_PITCH)); \
                const bf16x8 v1 = cat8(tr_read(vr + 64), tr_read(vr + 8 * SBV_PITCH + 64)); \
                O0 = MFMA32(v0, pf, O0); O1 = MFMA32(v1, pf, O1); } \
            asm volatile("" ::: "memory"); }
        for (int s0 = t0; ; s0 -= 96) {
            ATT_TILE(s0, 0)
            if (s0 < 32 || __ballot(prun >= SB_PEXIT) == 0ull) break;
            ATT_TILE(s0 - 32, 1)
            if (s0 < 64 || __ballot(prun >= SB_PEXIT) == 0ull) break;
            ATT_TILE(s0 - 64, 2)
            if (s0 < 96 || __ballot(prun >= SB_PEXIT) == 0ull) break;
        }
#undef ATT_TILE
        float ssq = 0.f;
#pragma unroll
        for (int r = 0; r < 16; ++r) ssq += O0[r] * O0[r] + O1[r] * O1[r];
        ssq += __shfl_xor(ssq, 32);
        const float rn = 1.0f / sqrtf(ssq * (1.f / 64) + EPS);
#pragma unroll
        for (int dt = 0; dt < 2; ++dt)
#pragma unroll
            for (int q = 0; q < 4; ++q) { const int d0 = 32 * dt + 8 * q + 4 * hh; const f32x4 gn = *(const LAS f32x4*)(F.lds + SBG_OFF + (h * 64 + d0) * 4);
                const float o0 = (dt ? O1[4 * q] : O0[4 * q]) * rn * gn[0], o1 = (dt ? O1[4 * q + 1] : O0[4 * q + 1]) * rn * gn[1], o2 = (dt ? O1[4 * q + 2] : O0[4 * q + 2]) * rn * gn[2], o3 = (dt ? O1[4 * q + 3] : O0[4 * q + 3]) * rn * gn[3];
                *(u32x2*)(mixp + d0) = (u32x2){gm::cvt_pk_bf16(o0, o1), gm::cvt_pk_bf16(o2, o3)}; }
    }
}
constexpr int HA_SET = 8192 + 9216 + 9216;
__device__ __forceinline__ void hgrn_passA(Ctx& F) {
    const bf16* PROJ = (const bf16*)(F.ws + WS_PROJ);
    float* HST = (float*)(F.ws + WS_HST); float* HDEC = (float*)(F.ws + WS_HDEC);
    const int i = F.lane & 15, g = F.lane >> 4, w = F.wave;
    for (int it = F.bid; it < 256; it += F.G) {
        const int b = it >> 6, h = (it >> 4) & 3, sc = it & 15;
        const size_t rowbase = (size_t)b * SEQ + sc * 512;
        const int row = F.tid >> 4, chunk = F.tid & 15;
        const bf16* gp = PROJ + (rowbase + row) * INC + h * 128 + chunk * 8;
        f32x4 acc[8];
#pragma unroll
        for (int kt = 0; kt < 8; ++kt) acc[kt] = (f32x4){0.f, 0.f, 0.f, 0.f};
        float run = 0.f;
        const int k = F.tid & 127, tq = F.tid >> 7, tqu = __builtin_amdgcn_readfirstlane(tq);
        u32x4 nf[4], nv[4];
#pragma unroll
        for (int d = 0; d < 4; ++d) { nf[d] = *(const u32x4*)(gp + (size_t)(15 - d) * 32 * INC + C_HF); nv[d] = *(const u32x4*)(gp + (size_t)(15 - d) * 32 * INC + C_HI); }
        __syncthreads();
#define PA_Q(Q) { _Pragma("unroll") for (int s = 31; s >= 0; --s) { if ((s >> 3) == (Q)) *(LAS unsigned short*)(KH + s * 288 + k * 2) = (unsigned short)cvtpk_bf16((1.0f - exp_raw(lfv[s])) * exp_raw(run), 0.f); run += lfv[s]; } }
#define PA_STEP(J, D) { const int j_ = (J); \
            if (j_ <= 15) { const int tl = 15 - j_; LAS unsigned char* set = F.lds + (tl % 3) * HA_SET; \
                *(LAS u32x4*)(set + row * 256 + chunk * 16) = nf[D]; *(LAS u32x4*)(set + 8192 + 9216 + row * 288 + chunk * 16) = nv[D]; } \
            { const int tn = (11 - j_) > 0 ? (11 - j_) : 0;            \
              nf[D] = *(const u32x4*)(gp + (size_t)tn * 32 * INC + C_HF); nv[D] = *(const u32x4*)(gp + (size_t)tn * 32 * INC + C_HI); } \
            if (j_ >= 1 && j_ <= 16) { const int tl = 16 - j_; LAS unsigned char* set = F.lds + (tl % 3) * HA_SET; \
                LAS unsigned char* RAWF = set; LAS unsigned char* KH = set + 8192; \
                float lfv[32]; \
                _Pragma("unroll") for (int s = 0; s < 32; ++s) lfv[s] = bf2f(*(const LAS unsigned short*)(RAWF + s * 256 + k * 2)); \
                if (tqu == 0) PA_Q(0) else if (tqu == 1) PA_Q(1) else if (tqu == 2) PA_Q(2) else PA_Q(3) } \
            if (j_ >= 2 && j_ <= 17) { const int tl = 17 - j_; LAS unsigned char* set = F.lds + (tl % 3) * HA_SET; \
                LAS unsigned char* KH = set + 8192; LAS unsigned char* VI = set + 8192 + 9216; \
                const bf16x8 bv = cat8(tr_read(VI + (4 * g + (i >> 2)) * 288 + (16 * w + 4 * (i & 3)) * 2), tr_read(VI + (16 + 4 * g + (i >> 2)) * 288 + (16 * w + 4 * (i & 3)) * 2)); \
                _Pragma("unroll") for (int kt = 0; kt < 8; ++kt) { \
                    const bf16x8 av = cat8(tr_read(KH + (4 * g + (i >> 2)) * 288 + (16 * kt + 4 * (i & 3)) * 2), tr_read(KH + (16 + 4 * g + (i >> 2)) * 288 + (16 * kt + 4 * (i & 3)) * 2)); \
                    acc[kt] = MFMA16(av, bv, acc[kt]); } } \
            __syncthreads(); }
        for (int jb = 0; jb < 20; jb += 4) { PA_STEP(jb, 0) PA_STEP(jb + 1, 1) PA_STEP(jb + 2, 2) PA_STEP(jb + 3, 3) }
#undef PA_STEP
#undef PA_Q
        float* hp = HST + (size_t)it * 16384;
#pragma unroll
        for (int kt = 0; kt < 8; ++kt) *(f32x4*)(hp + ((w * 8 + kt) * 64 + F.lane) * 4) = acc[kt];
        if (tq == 0) HDEC[it * 128 + k] = __expf(run);
        __syncthreads();
    }
}
__device__ __forceinline__ void hgrn_passB(Ctx& F) {
    float* HST = (float*)(F.ws + WS_HST); const float* HDEC = (const float*)(F.ws + WS_HDEC);
    for (int u = F.bid; u < 256; u += F.G) {
        const int bh = u >> 4, part = u & 15;
        const int e = part * 1024 + F.tid * 2;
        const int kk = 16 * ((e >> 8) & 7) + 4 * (((e >> 2) & 63) >> 4) + (e & 3);
        f32x2 L[16]; f32x2 D[16];
#pragma unroll
        for (int sc = 0; sc < 16; ++sc) { L[sc] = *(const f32x2*)(HST + (size_t)(bh * 16 + sc) * 16384 + e); D[sc] = *(const f32x2*)(HDEC + (bh * 16 + sc) * 128 + kk); }
        f32x2 S = (f32x2){0.f, 0.f};
#pragma unroll
        for (int sc = 0; sc < 16; ++sc) { *(f32x2*)(HST + (size_t)(bh * 16 + sc) * 16384 + e) = S; S = S * D[sc] + L[sc]; }
    }
}
constexpr int HC_RAWF = 0, HC_RAWQ = 4096, HC_QH = 8192, HC_KT = HC_QH + 4352, HC_V = HC_KT + 4352, HC_G = HC_V + 4608, HC_DK = HC_G + 4352, HC_PART = HC_DK + 512, HC_SET = HC_PART + 512;
#define PASSC_ITER(ITR, D, ROLE) do { const int itr = (ITR); \
            if (ROLE) { \
                if (itr >= 1 && itr <= 32) { const int st = itr - 1; const LAS unsigned char* set = F.lds + (st & 3) * HC_SET; \
                    float tot = 0.f; \
                _Pragma("unroll") \
                    for (int ww = 0; ww < 8; ++ww) tot += *(const LAS float*)(set + HC_PART + (ww * 16 + i) * 4); \
                    const float rs = 1.0f / sqrtf(tot * (1.f / 128) + EPS); \
                _Pragma("unroll") \
                    for (int u = 0; u < 2; ++u) { const int vt = 2 * w + u; \
                        const u32x2 gi = *(const LAS u32x2*)(set + HC_G + i * 272 + (16 * vt + 4 * g) * 2); \
                        u32x2 o; o.x = gm::cvt_pk_bf16(oT[u][0] * rs * gain[u][0] * bflo(gi.x), oT[u][1] * rs * gain[u][1] * bfhi(gi.x)); o.y = gm::cvt_pk_bf16(oT[u][2] * rs * gain[u][2] * bflo(gi.y), oT[u][3] * rs * gain[u][3] * bfhi(gi.y)); \
                        *(u32x2*)((bf16*)(F.ws + WS_MIX) + (rowbase + st * 16 + i) * DM + h * 128 + 16 * vt + 4 * g) = o; } } \
                if (itr >= 0 && itr < 32) { LAS unsigned char* set = F.lds + (itr & 3) * HC_SET; \
                    bf16x8 qf[4]; \
                    f32x4 pT = (f32x4){0.f, 0.f, 0.f, 0.f}; \
                _Pragma("unroll") \
                    for (int ks = 0; ks < 4; ++ks) { \
                        qf[ks] = cat8(*(const LAS s16x4*)(set + HC_QH + i * 272 + (32 * ks + 4 * g) * 2), *(const LAS s16x4*)(set + HC_QH + i * 272 + (32 * ks + 16 + 4 * g) * 2)); \
                        const bf16x8 kf = cat8(*(const LAS s16x4*)(set + HC_KT + i * 272 + (32 * ks + 4 * g) * 2), *(const LAS s16x4*)(set + HC_KT + i * 272 + (32 * ks + 16 + 4 * g) * 2)); \
                        pT = MFMA16(kf, qf[ks], pT); } \
                _Pragma("unroll") \
                    for (int r = 0; r < 4; ++r) pT[r] = (4 * g + r <= i) ? pT[r] : 0.f; \
                    const s16x4 z4 = (s16x4){0, 0, 0, 0}; \
                    const bf16x8 pf = pack8(pT, (f32x4){0.f, 0.f, 0.f, 0.f}); \
                    bf16x8 vf[2]; \
                _Pragma("unroll") \
                    for (int u = 0; u < 2; ++u) { const int vt = 2 * w + u; \
                        vf[u] = cat8(tr_read(set + HC_V + (4 * g + (i >> 2)) * 288 + (16 * vt + 4 * (i & 3)) * 2), z4); \
                        oT[u] = MFMA16(vf[u], pf, ((f32x4){0.f, 0.f, 0.f, 0.f})); \
                _Pragma("unroll") \
                        for (int ks = 0; ks < 4; ++ks) oT[u] = MFMA16(pack8(acc[u][2 * ks], acc[u][2 * ks + 1]), qf[ks], oT[u]); } \
                _Pragma("unroll") \
                    for (int kt = 0; kt < 8; ++kt) { const bf16x8 ak = cat8(tr_read(set + HC_KT + (4 * g + (i >> 2)) * 272 + (16 * kt + 4 * (i & 3)) * 2), z4); \
                        const f32x4 dk = *(const LAS f32x4*)(set + HC_DK + (16 * kt + 4 * g) * 4); \
                _Pragma("unroll") \
                        for (int u = 0; u < 2; ++u) { acc[u][kt] = MFMA16(ak, vf[u], acc[u][kt]); acc[u][kt] = acc[u][kt] * dk; } } \
                _Pragma("unroll") \
                    for (int u = 0; u < 2; ++u) { float ssq = (oT[u][0] * oT[u][0] + oT[u][1] * oT[u][1]) + (oT[u][2] * oT[u][2] + oT[u][3] * oT[u][3]); \
                        ssq += __shfl_xor(ssq, 16); ssq += __shfl_xor(ssq, 32); \
                        if (g == 0) *(LAS float*)(set + HC_PART + ((2 * w + u) * 16 + i) * 4) = ssq; } } \
            } else { \
                if (itr + 1 >= 0 && itr + 1 < 32) { LAS unsigned char* set = F.lds + ((itr + 1) & 3) * HC_SET; \
                    float lfv[16], qv[8]; float run = 0.f;        \
                _Pragma("unroll") \
                    for (int s2 = 0; s2 < 16; ++s2) lfv[s2] = bf2f(*(const LAS unsigned short*)(set + HC_RAWF + s2 * 256 + k * 2)); \
                _Pragma("unroll") \
                    for (int j = 0; j < 8; ++j) qv[j] = bf2f(*(const LAS unsigned short*)(set + HC_RAWQ + (8 * tqu + j) * 256 + k * 2)); \
                    if (tqu == 0) { \
                _Pragma("unroll") \
                        for (int s2 = 0; s2 < 8; ++s2) { run += lfv[s2]; \
                            *(LAS unsigned short*)(set + HC_QH + s2 * 272 + k * 2) = (unsigned short)cvtpk_bf16(qv[s2] * exp_raw(run), 0.f); \
                            *(LAS unsigned short*)(set + HC_KT + s2 * 272 + k * 2) = (unsigned short)cvtpk_bf16((1.0f - exp_raw(lfv[s2])) * exp_raw(fminf(-run, 80.f)), 0.f); } \
                _Pragma("unroll") \
                        for (int s2 = 8; s2 < 16; ++s2) run += lfv[s2]; \
                        *(LAS float*)(set + HC_DK + k * 4) = exp_raw(run); \
                    } else { \
                _Pragma("unroll") \
                        for (int s2 = 0; s2 < 8; ++s2) run += lfv[s2]; \
                _Pragma("unroll") \
                        for (int s2 = 8; s2 < 16; ++s2) { run += lfv[s2]; \
                            *(LAS unsigned short*)(set + HC_QH + s2 * 272 + k * 2) = (unsigned short)cvtpk_bf16(qv[s2 - 8] * exp_raw(run), 0.f); \
                            *(LAS unsigned short*)(set + HC_KT + s2 * 272 + k * 2) = (unsigned short)cvtpk_bf16((1.0f - exp_raw(lfv[s2])) * exp_raw(fminf(-run, 80.f)), 0.f); } } } \
                if (itr + 2 < 32) { LAS unsigned char* set = F.lds + ((itr + 2) & 3) * HC_SET; \
                    *(LAS u32x4*)(set + HC_RAWF + row * 256 + chunk * 16) = pfq[D][0]; *(LAS u32x4*)(set + HC_RAWQ + row * 256 + chunk * 16) = pfq[D][1]; \
                    *(LAS u32x4*)(set + HC_V + row * 288 + chunk * 16) = pfq[D][2]; *(LAS u32x4*)(set + HC_G + row * 272 + chunk * 16) = pfq[D][3]; } \
            } \
            if (!(ROLE)) { const int pst = (itr + 5 < 32) ? itr + 5 : 31; const bf16* gq = gp + (size_t)pst * 16 * INC;     pfq[D][0] = *(const u32x4*)(gq + C_HF); pfq[D][1] = *(const u32x4*)(gq + C_HQ); pfq[D][2] = *(const u32x4*)(gq + C_HI); pfq[D][3] = *(const u32x4*)(gq + C_HG); } \
            __syncthreads(); } while (0)
__device__ __forceinline__ void hgrn_passC(Ctx& F) {
    bf16* PROJ = (bf16*)(F.ws + WS_PROJ);
    const float* HST = (const float*)(F.ws + WS_HST);
    const int i = F.lane & 15, g = F.lane >> 4, w = F.wave;
    const bool mfw = (w < 4);
    for (int it = F.bid; it < 256; it += F.G) {
        const int b = it >> 6, h = (it >> 4) & 3, sc = it & 15;
        const size_t rowbase = (size_t)b * SEQ + sc * 512;
        const int t = F.tid & 255, row = t >> 4, chunk = t & 15;
        const bf16* gp = PROJ + (rowbase + row) * INC + h * 128 + chunk * 8;
        u32x4 pfq[3][4];
#pragma unroll
        for (int d = 0; d < 3; ++d)
#pragma unroll
            for (int q = 0; q < 4; ++q) pfq[d][q] = (u32x4){0u, 0u, 0u, 0u};
        f32x4 gain[2]; f32x4 acc[2][8]; f32x4 oT[2];
#pragma unroll
        for (int u = 0; u < 2; ++u) { gain[u] = *(const f32x4*)(F.hg_gain + h * 128 + 16 * ((2 * w + u) & 7) + 4 * g); oT[u] = (f32x4){0.f, 0.f, 0.f, 0.f};
#pragma unroll
            for (int kt = 0; kt < 8; ++kt) acc[u][kt] = (f32x4){0.f, 0.f, 0.f, 0.f}; }
        const int k = t & 127, tq = t >> 7, tqu = __builtin_amdgcn_readfirstlane(tq);
        if (mfw) {
#pragma unroll
            for (int u = 0; u < 2; ++u)
#pragma unroll
                for (int kt = 0; kt < 8; ++kt) acc[u][kt] = *(const f32x4*)(HST + (size_t)it * 16384 + (((2 * w + u) * 8 + kt) * 64 + F.lane) * 4);
            __syncthreads();
            for (int base = -2; base <= 32; base += 3) { PASSC_ITER(base, 0, true); PASSC_ITER(base + 1, 1, true); PASSC_ITER(base + 2, 2, true); }
        } else {
#pragma unroll
            for (int d = 0; d < 3; ++d) { const bf16* gq = gp + (size_t)d * 16 * INC; pfq[d][0] = *(const u32x4*)(gq + C_HF); pfq[d][1] = *(const u32x4*)(gq + C_HQ); pfq[d][2] = *(const u32x4*)(gq + C_HI); pfq[d][3] = *(const u32x4*)(gq + C_HG); }
            __syncthreads();
            for (int base = -2; base <= 32; base += 3) { PASSC_ITER(base, 0, false); PASSC_ITER(base + 1, 1, false); PASSC_ITER(base + 2, 2, false); }
        }
    }
}
#undef PASSC_ITER

struct P3Pol {
    static constexpr bool PERM = true, FP8 = false, GATHER = false;
    const char* A; const char* B; const float* x; bf16* h1b; unsigned char* h1q; int G, c, flags;
    __device__ __forceinline__ bool next(int i, gm::Unit& u) const { int pm, pn; if (!gm::order_next(i, G, c, NTOK / 256, 4, pm, pn)) return false;
        u.pm = pm; u.pn = pn; u.A = A + (size_t)pm * 256 * 2048; u.B = B + (size_t)pn * 256 * 2048; u.e = 0; u.rows = 256; return true; }
    __device__ __forceinline__ void a_off(const gm::Unit&, int R0, int C0, int R1, int C1, unsigned (&vo)[2][2]) const {
        vo[0][0] = (unsigned)(R0 * 1024 + C0) * 2u; vo[0][1] = (unsigned)(R1 * 1024 + C1) * 2u; vo[1][0] = vo[0][0] + 128u * 2048u; vo[1][1] = vo[0][1] + 128u * 2048u; }
    __device__ __forceinline__ size_t koff(int t) const { return (size_t)t * 128; }
    __device__ __forceinline__ void acc_init(f32x4 (&acc)[2][2][4][2], const gm::Unit& u, int wr, int wc, int fr, int fq) const {
        const int row0 = u.pm * 256 + wr * 64 + fr, col0 = u.pn * 256 + wc * 32 + 8 * fq;
#pragma unroll
        for (int ai = 0; ai < 2; ++ai)
#pragma unroll
            for (int m = 0; m < 4; ++m) { const float* xp = x + (size_t)(row0 + ai * 128 + m * 16) * DM + col0;
#pragma unroll
                for (int bj = 0; bj < 2; ++bj) { acc[ai][bj][m][0] = __builtin_nontemporal_load((const f32x4*)(xp + bj * 128)); acc[ai][bj][m][1] = __builtin_nontemporal_load((const f32x4*)(xp + bj * 128 + 4)); } }
#pragma unroll
        for (int ai = 0; ai < 2; ++ai)
#pragma unroll
            for (int m = 0; m < 4; ++m)
#pragma unroll
                for (int bj = 0; bj < 2; ++bj) asm volatile("" : "+v"(acc[ai][bj][m][0]), "+v"(acc[ai][bj][m][1]));
    }
    __device__ __forceinline__ void meta_prefetch(const gm::Unit&, LAS unsigned char*, int, int) const {}
    __device__ __forceinline__ void epi(const f32x4 (&acc)[2][2][4][2], const gm::Unit& u, int wr, int wc, int fr, int fq, LAS unsigned char*, int) const {
        if (flags & 2) { if (acc[0][0][0][0][0] == 1.2345e-30f) h1q[0] = 1; return; }
        const int row0 = u.pm * 256 + wr * 64 + fr, col0 = u.pn * 256 + wc * 32 + 8 * fq;
#pragma unroll
        for (int ai = 0; ai < 2; ++ai)
#pragma unroll
            for (int m = 0; m < 4; ++m) { const size_t off = (size_t)(row0 + ai * 128 + m * 16) * DM + col0;
#pragma unroll
                for (int bj = 0; bj < 2; ++bj) { const f32x4 v0 = acc[ai][bj][m][0], v1 = acc[ai][bj][m][1];
                    u32x4 w; w.x = gm::cvt_pk_bf16(v0[0], v0[1]); w.y = gm::cvt_pk_bf16(v0[2], v0[3]); w.z = gm::cvt_pk_bf16(v1[0], v1[1]); w.w = gm::cvt_pk_bf16(v1[2], v1[3]);
                    *(u32x4*)(h1b + off + bj * 128) = w;
                    *(u32x2*)(h1q + off + bj * 128) = (u32x2){pk4_fp8(v0[0], v0[1], v0[2], v0[3]), pk4_fp8(v1[0], v1[1], v1[2], v1[3])}; } }
    }
};
__device__ __forceinline__ void phase3(Ctx& F) {
    P3Pol S{(const char*)(F.ws + WS_MIX), (const char*)(F.ws + WS_WOUT), F.x, (bf16*)(F.ws + WS_H1B), F.ws + WS_H1Q, F.G, F.vc, F.flags};
    gm::gemm_phase<P3Pol>(F.lds, S);
}

__device__ __forceinline__ void router_stage_weights(Ctx& F) {
    LAS unsigned short* WH = (LAS unsigned short*)F.lds; LAS unsigned short* WL = (LAS unsigned short*)(F.lds + 65536);
    __syncthreads();
    if (F.tid < 32) *(LAS float*)(F.lds + MISC_OFF + 1024 + 6912 + F.tid * 4) = F.b_router[F.tid];
    { f32x4 w4[16]; float g1[16];
#pragma unroll
      for (int it = 0; it < 16; ++it) { const int i4 = F.tid + it * NTHR, k = i4 >> 3, e0 = (i4 & 7) * 4; w4[it] = *(const f32x4*)(F.w_router + k * 32 + e0); g1[it] = F.ffn_gain[k]; }
#pragma unroll
      for (int it = 0; it < 16; ++it) { const int i4 = F.tid + it * NTHR, k = i4 >> 3, e0 = (i4 & 7) * 4;
#pragma unroll
          for (int c = 0; c < 4; ++c) { const float w = w4[it][c] * g1[it];
              const unsigned hi = f2bf(w); const unsigned lo = f2bf(w - bf2f((unsigned short)hi));
              WH[((k >> 4) * 32 + e0 + c) * 16 + (k & 15)] = (unsigned short)hi; WL[((k >> 4) * 32 + e0 + c) * 16 + (k & 15)] = (unsigned short)lo; } } }
}
__device__ __forceinline__ void phase_router_fast(Ctx& F) {
    LAS unsigned short* WH = (LAS unsigned short*)F.lds; LAS unsigned short* WL = (LAS unsigned short*)(F.lds + 65536);
    LAS unsigned char* M = F.lds + MISC_OFF + 1024;
    LAS float* rsd = (LAS float*)M; LAS int* sel_e = (LAS int*)(M + 512); LAS float* sel_g = (LAS float*)(M + 2560); LAS int* lpos = (LAS int*)(M + 4608); LAS int* hist = (LAS int*)(M + 6656); LAS int* base = hist + 32;
    unsigned* cnt = (unsigned*)(F.ws + WS_CTL) + CW_CNT;
    int* STOK = (int*)(F.ws + WS_STOK); float* SGATE = (float*)(F.ws + WS_SGATE); float* SRSTD = (float*)(F.ws + WS_SRSTD);
    for (int tb = F.bid; tb < NTOK / 128; tb += F.G) {
        const int tok0 = tb * 128;
        __syncthreads();
        if (F.tid < 32) hist[F.tid] = 0;
        if (F.wave < 4) {
            const int j = F.lane & 31, h = F.lane >> 5, tok = tok0 + F.wave * 32 + j;
            const bf16* hp = (const bf16*)(F.ws + WS_H1B) + (size_t)tok * DM + 8 * h;
            f32x16 acc;
#pragma unroll
            for (int r = 0; r < 16; ++r) acc[r] = 0.f;
            float ssq = 0.f;
            u32x4 xa[4], xb[4];
#pragma unroll
            for (int q = 0; q < 4; ++q) { xa[q] = *(const u32x4*)(hp + 16 * q); xb[q] = *(const u32x4*)(hp + 16 * (4 + q)); }
#define RT_STEPS(X, S0) { _Pragma("unroll") for (int q = 0; q < 4; ++q) { const int s_ = (S0) + q; const u32x4 xv = X[q]; \
                    const bf16x8 wh = *(const LAS bf16x8*)(WH + ((s_ * 32 + j) * 16 + 8 * h)); const bf16x8 wl = *(const LAS bf16x8*)(WL + ((s_ * 32 + j) * 16 + 8 * h)); \
                    const bf16x8 xf = __builtin_bit_cast(bf16x8, xv); \
                    acc = MFMA32(wh, xf, acc); acc = MFMA32(wl, xf, acc); \
                    ssq += (bflo(xv.x) * bflo(xv.x) + bfhi(xv.x) * bfhi(xv.x)) + (bflo(xv.y) * bflo(xv.y) + bfhi(xv.y) * bfhi(xv.y)) \
                         + (bflo(xv.z) * bflo(xv.z) + bfhi(xv.z) * bfhi(xv.z)) + (bflo(xv.w) * bflo(xv.w) + bfhi(xv.w) * bfhi(xv.w)); } \
                  { const int sn_ = ((S0) + 8 < 60) ? (S0) + 8 : 60; \
                    _Pragma("unroll") for (int q = 0; q < 4; ++q) X[q] = *(const u32x4*)(hp + 16 * (sn_ + q)); } }
            for (int s0 = 0; s0 < 64; s0 += 8) { RT_STEPS(xa, s0) RT_STEPS(xb, s0 + 4) }
#undef RT_STEPS
            ssq += __shfl_xor(ssq, 32);
            const float rstd = 1.0f / sqrtf(ssq * (1.f / DM) + EPS);
            float lg[16];
#pragma unroll
            for (int r = 0; r < 16; ++r) lg[r] = acc[r] * rstd + *(const LAS float*)(M + 6912 + ((r & 3) + 8 * (r >> 2) + 4 * h) * 4);
            float v[8]; int id[8]; unsigned used = 0u;
#pragma unroll
            for (int k = 0; k < 4; ++k) { float best = -3.0e38f; int bi = 0, br = 0;
#pragma unroll
                for (int r = 0; r < 16; ++r) { const bool c = !((used >> r) & 1u) && lg[r] > best; best = c ? lg[r] : best; bi = c ? ((r & 3) + 8 * (r >> 2) + 4 * h) : bi; br = c ? r : br; }
                used |= 1u << br; v[k] = best; id[k] = bi; }
#pragma unroll
            for (int k = 0; k < 4; ++k) { v[4 + k] = __shfl_xor(v[k], 32); id[4 + k] = __shfl_xor(id[k], 32); }
            float tv[4]; int ti[4]; unsigned u2 = 0u;
#pragma unroll
            for (int k = 0; k < 4; ++k) { float best = -3.0e38f; int bi = 1 << 30, bc = 0;
#pragma unroll
                for (int c8 = 0; c8 < 8; ++c8) { const bool c = !((u2 >> c8) & 1u) && (v[c8] > best || (v[c8] == best && id[c8] < bi)); best = c ? v[c8] : best; bi = c ? id[c8] : bi; bc = c ? c8 : bc; }
                u2 |= 1u << bc; tv[k] = best; ti[k] = bi; }
            float den = 0.f, pr[4];
#pragma unroll
            for (int k = 0; k < 4; ++k) { pr[k] = __expf(tv[k] - tv[0]); den += pr[k]; }
            const float rden = 1.0f / den;
            if (h == 0) { const int tl = F.wave * 32 + j; rsd[tl] = rstd;
#pragma unroll
                for (int k = 0; k < 4; ++k) { sel_e[tl * 4 + k] = ti[k]; sel_g[tl * 4 + k] = pr[k] * rden; } }
        }
        __syncthreads();
        if (F.tid < 128) {
#pragma unroll
            for (int k = 0; k < 4; ++k) lpos[F.tid * 4 + k] = atomicAdd((int*)&hist[sel_e[F.tid * 4 + k]], 1); }
        __syncthreads();
        if (F.tid < 32) base[F.tid] = (int)__hip_atomic_fetch_add(&cnt[64 * F.tid], (unsigned)hist[F.tid], __ATOMIC_RELAXED, __HIP_MEMORY_SCOPE_AGENT);
        __syncthreads();
        if (F.tid < 128) {
#pragma unroll
            for (int k = 0; k < 4; ++k) { const int e = sel_e[F.tid * 4 + k]; const size_t sl = (size_t)e * ECAP + base[e] + lpos[F.tid * 4 + k];
                STOK[sl] = (tok0 + F.tid) * 4 + k; SGATE[sl] = sel_g[F.tid * 4 + k]; SRSTD[sl] = rsd[F.tid]; } }
    }
    __syncthreads();
}

struct RbTab { LAS int* e; LAS int* start; LAS int* rows; LAS int* off; int nrb; };
__device__ __forceinline__ RbTab build_rbtab(Ctx& F) {
    RbTab T; LAS int* m = (LAS int*)(F.lds + MISC_OFF + 1024);
    T.e = m; T.start = m + 640; T.rows = m + 1280; T.off = m + 1920;
    LAS int* nrbp = m + 1920 + 64;
    const unsigned* cnt = (const unsigned*)(F.ws + WS_CTL) + CW_CNT;
    LAS int* cl = m + 1920 + 96;
    LAS int* tp = (LAS int*)(F.lds + IDX_OFF);
    __syncthreads();
    if (F.tid < NE) cl[F.tid] = (int)__hip_atomic_load(&cnt[64 * F.tid], __ATOMIC_RELAXED, __HIP_MEMORY_SCOPE_AGENT);
    __syncthreads();
    if (F.tid == 0) { int off = 0, rb = 0;
        for (int e = 0; e < NE; ++e) { const int c = cl[e]; T.off[e] = off; tp[e] = rb; off += c; rb += (c + 255) >> 8; }
        T.off[NE] = off; tp[NE] = rb; *nrbp = rb; }
    __syncthreads();
    { const int e = F.tid >> 4, c = cl[e], rb0 = tp[e];
      for (int i = F.tid & 15; i * 256 < c; i += 16) { const int rb = rb0 + i; T.e[rb] = e; T.start[rb] = i * 256; T.rows[rb] = (c - i * 256) < 256 ? (c - i * 256) : 256; } }
    __syncthreads();
    T.nrb = *nrbp;
    return T;
}

__device__ __forceinline__ f32x4 swiglu4_(f32x4 g, f32x4 u) {
    f32x4 hg, hu, e, s;
#pragma unroll
    for (int i = 0; i < 4; ++i) { hg[i] = fminf(g[i], SW_LIMIT); hu[i] = fminf(fmaxf(u[i], -SW_LIMIT), SW_LIMIT); }
    const f32x4 t = hg * (-1.44269504f * SW_ALPHA);
#pragma unroll
    for (int i = 0; i < 4; ++i) e[i] = __builtin_amdgcn_exp2f(t[i]);
    const f32x4 d = e + 1.0f;
#pragma unroll
    for (int i = 0; i < 4; ++i) s[i] = __builtin_amdgcn_rcpf(d[i]);
    return (hu + 1.0f) * (hg * s);
}
__device__ __forceinline__ float swiglu_(float hg, float hu) {
    hg = fminf(hg, SW_LIMIT); hu = fminf(fmaxf(hu, -SW_LIMIT), SW_LIMIT);
    return (hu + 1.0f) * (hg * sigmoidf_(SW_ALPHA * hg));
}
struct P4Pol {
    static constexpr bool PERM = true, FP8 = true, GATHER = true;
    const char* A; const char* B; unsigned char* hid; const int* stok; const float* srstd; const float* bg; const float* bu; RbTab T; int G, c, flags;
    __device__ __forceinline__ bool next(int i, gm::Unit& u) const { int pm, pn; if (!gm::order_next(i, G, c, T.nrb, 8, pm, pn)) return false;
        u.pm = pm; u.pn = pn; u.e = __builtin_amdgcn_readfirstlane(T.e[pm]); u.rows = __builtin_amdgcn_readfirstlane(T.rows[pm]); u.A = A; u.B = B + ((size_t)(u.e * 8 + pn) * 256) * 1024; return true; }
    __device__ __forceinline__ void a_off(const gm::Unit& u, int R0, int C0, int R1, int C1, unsigned (&vo)[2][2]) const {
        const int* lst = stok + (size_t)u.e * ECAP + T.start[u.pm];
#pragma unroll
        for (int h = 0; h < 2; ++h) { int r0 = R0 + 128 * h, r1 = R1 + 128 * h; r0 = r0 < u.rows ? r0 : 0; r1 = r1 < u.rows ? r1 : 0;
            vo[h][0] = (unsigned)(lst[r0] >> 2) * 1024u + (unsigned)C0 * 2u; vo[h][1] = (unsigned)(lst[r1] >> 2) * 1024u + (unsigned)C1 * 2u; }
    }
    __device__ __forceinline__ void idx_prefetch(const gm::Unit& u, LAS unsigned char* lds, int wid) const {
        if (wid < 4) { const int* lst = stok + (size_t)u.e * ECAP + __builtin_amdgcn_readfirstlane(T.start[u.pm]) + wid * 64 + (threadIdx.x & 63);
            __builtin_amdgcn_global_load_lds((const unsigned*)lst, (LAS unsigned*)(lds + IDX_OFF + wid * 256), 4, 0, 0); } }
    __device__ __forceinline__ void a_off_lds(const gm::Unit& u, int, int, int, int, LAS unsigned char* lds, unsigned (&vo)[2][2]) const {
        const LAS int* ib = (const LAS int*)(lds + IDX_OFF);
        int tq = threadIdx.x; asm volatile("" : "+v"(tq));
        int R0, C0, R1, C1; gm::stage_rc(tq * 16, R0, C0); gm::stage_rc(tq * 16 + 8192, R1, C1);
#pragma unroll
        for (int h = 0; h < 2; ++h) { int r0 = R0 + 128 * h, r1 = R1 + 128 * h; r0 = r0 < u.rows ? r0 : 0; r1 = r1 < u.rows ? r1 : 0;
            vo[h][0] = (unsigned)(ib[r0] >> 2) * 1024u + (unsigned)C0 * 2u; vo[h][1] = (unsigned)(ib[r1] >> 2) * 1024u + (unsigned)C1 * 2u; }
    }
    __device__ __forceinline__ size_t koff(int t) const { return (size_t)t * 128; }
    __device__ __forceinline__ void acc_init(f32x4 (&acc)[2][2][4][2], const gm::Unit&, int, int, int, int) const { gm::acc_zero(acc); }
    __device__ __forceinline__ void meta_prefetch(const gm::Unit& u, LAS unsigned char* lds, int wid, int ui) const {
        LAS unsigned char* mb = lds + META_OFF + (ui & 1) * META_BYTES; const int ln = threadIdx.x & 63;
        const float* src = (wid < 4) ? srstd + (size_t)u.e * ECAP + __builtin_amdgcn_readfirstlane(T.start[u.pm]) + wid * 64 + ln
                                     : ((wid < 6) ? bg : bu) + u.e * DFF + u.pn * 128 + (wid & 1) * 64 + ln;
        __builtin_amdgcn_global_load_lds((const unsigned*)src, (LAS unsigned*)(mb + wid * 256), 4, 0, 0);
    }
    __device__ __forceinline__ void epi(const f32x4 (&acc)[2][2][4][2], const gm::Unit& u, int wr, int wc, int fr, int fq, LAS unsigned char* lds, int ui) const {
        if (flags & 4) { if (acc[0][0][0][0][0] == 1.2345e-30f) hid[0] = 1; return; }
        const LAS unsigned char* mb = lds + META_OFF + (ui & 1) * META_BYTES;
        const size_t grow = (size_t)T.off[u.e] + T.start[u.pm];
        const int jl = wc * 32 + 8 * fq, j0 = u.pn * 128 + jl;
        const f32x4 bg0 = *(const LAS f32x4*)(mb + 1024 + jl * 4), bg1 = *(const LAS f32x4*)(mb + 1024 + jl * 4 + 16), bu0 = *(const LAS f32x4*)(mb + 1536 + jl * 4), bu1 = *(const LAS f32x4*)(mb + 1536 + jl * 4 + 16);
#pragma unroll
        for (int ai = 0; ai < 2; ++ai)
#pragma unroll
            for (int m = 0; m < 4; ++m) { const int r = ai * 128 + wr * 64 + m * 16 + fr;
                if (r < u.rows) { const float rs = *(const LAS float*)(mb + r * 4) * W8_INV;
                    const f32x4 g0 = acc[ai][0][m][0] * rs + bg0, g1 = acc[ai][0][m][1] * rs + bg1, u0 = acc[ai][1][m][0] * rs + bu0, u1 = acc[ai][1][m][1] * rs + bu1;
                    const f32x4 o0 = swiglu4_(g0, u0), o1 = swiglu4_(g1, u1);
                    *(u32x2*)(hid + (grow + r) * DFF + j0) = (u32x2){pk4_fp8(o0[0], o0[1], o0[2], o0[3]), pk4_fp8(o1[0], o1[1], o1[2], o1[3])}; } }
    }
};
__device__ __forceinline__ RbTab phase_gateup(Ctx& F) {
    RbTab T = build_rbtab(F);
    P4Pol S{(const char*)(F.ws + WS_H1Q), (const char*)(F.ws + WS_WGU), F.ws + WS_HID, (const int*)(F.ws + WS_STOK), (const float*)(F.ws + WS_SRSTD), F.b_gate, F.b_up, T, F.G, F.vc, F.flags};
    gm::gemm_phase<P4Pol>(F.lds, S);
    return T;
}

struct P5Pol {
    static constexpr bool PERM = true, FP8 = true, GATHER = false;
    const char* A; const char* B; const int* stok; const float* sgate; const float* bd; unsigned char* y; int* tslot; RbTab T; int G, c, flags;
    __device__ __forceinline__ bool next(int i, gm::Unit& u) const { int pm, pn; if (!gm::order_next(i, G, c, T.nrb, 4, pm, pn)) return false;
        u.pm = pm; u.pn = pn; u.e = __builtin_amdgcn_readfirstlane(T.e[pm]); u.rows = __builtin_amdgcn_readfirstlane(T.rows[pm]);
        const int grow = __builtin_amdgcn_readfirstlane(T.off[u.e] + T.start[pm]); u.A = A + (size_t)grow * 1024; u.B = B + ((size_t)u.e * 1024 + pn * 256) * 1024; return true; }
    __device__ __forceinline__ void a_off(const gm::Unit&, int R0, int C0, int R1, int C1, unsigned (&vo)[2][2]) const {
        vo[0][0] = (unsigned)(R0 * 1024 + C0 * 2); vo[0][1] = (unsigned)(R1 * 1024 + C1 * 2); vo[1][0] = vo[0][0] + 128u * 1024u; vo[1][1] = vo[0][1] + 128u * 1024u; }
    __device__ __forceinline__ size_t koff(int t) const { return (size_t)t * 128; }
    __device__ __forceinline__ void acc_init(f32x4 (&acc)[2][2][4][2], const gm::Unit&, int, int, int, int) const { gm::acc_zero(acc); }
    __device__ __forceinline__ void meta_prefetch(const gm::Unit& u, LAS unsigned char* lds, int wid, int ui) const {
        LAS unsigned char* mb = lds + META_OFF + (ui & 1) * META_BYTES; const int ln = threadIdx.x & 63;
        const size_t sb = (size_t)u.e * ECAP + __builtin_amdgcn_readfirstlane(T.start[u.pm]) + (wid & 3) * 64 + ln;
        const unsigned* src = (wid < 4) ? (const unsigned*)(stok + sb) : (const unsigned*)(sgate + sb);
        __builtin_amdgcn_global_load_lds(src, (LAS unsigned*)(mb + wid * 256), 4, 0, 0);
        if (wid < 4) __builtin_amdgcn_global_load_lds((const unsigned*)(bd + u.e * DM + u.pn * 256 + wid * 64 + ln), (LAS unsigned*)(mb + 2048 + wid * 256), 4, 0, 0);
    }
    __device__ __forceinline__ void epi(const f32x4 (&acc)[2][2][4][2], const gm::Unit& u, int wr, int wc, int fr, int fq, LAS unsigned char* lds, int ui) const {
        if (flags & 8) { if (acc[0][0][0][0][0] == 1.2345e-30f) y[0] = 1; return; }
        const LAS unsigned char* mb = lds + META_OFF + (ui & 1) * META_BYTES;
        const int cl = wc * 32 + 8 * fq, col0 = u.pn * 256 + cl; const size_t grow = (size_t)T.off[u.e] + T.start[u.pm];
        f32x4 bv[2][2];
#pragma unroll
        for (int bj = 0; bj < 2; ++bj) { bv[bj][0] = *(const LAS f32x4*)(mb + 2048 + (bj * 128 + cl) * 4); bv[bj][1] = *(const LAS f32x4*)(mb + 2048 + (bj * 128 + cl) * 4 + 16); }
#pragma unroll
        for (int ai = 0; ai < 2; ++ai)
#pragma unroll
            for (int m = 0; m < 4; ++m) { const int r = ai * 128 + wr * 64 + m * 16 + fr;
                if (r < u.rows) { const int tr = *(const LAS int*)(mb + r * 4); const float gt = *(const LAS float*)(mb + 1024 + r * 4) * Y8_SCALE, gw = gt * W8_INV;
                    unsigned char* p = y + (grow + r) * DM + col0;
                    if (u.pn == 0 && wc == 0 && fq == 0) tslot[tr] = (int)(grow + r);
#pragma unroll
                    for (int bj = 0; bj < 2; ++bj) { const f32x4 v0 = acc[ai][bj][m][0] * gw + bv[bj][0] * gt, v1 = acc[ai][bj][m][1] * gw + bv[bj][1] * gt;
                        *(u32x2*)(p + bj * 128) = (u32x2){pk4_fp8(v0[0], v0[1], v0[2], v0[3]), pk4_fp8(v1[0], v1[1], v1[2], v1[3])}; } } }
    }
};
__device__ __forceinline__ void phase_down(Ctx& F, const RbTab& T0, bool have) {
    RbTab T = T0;
    if (!have) T = build_rbtab(F);
    P5Pol S{(const char*)(F.ws + WS_HID), (const char*)(F.ws + WS_WDN), (const int*)(F.ws + WS_STOK), (const float*)(F.ws + WS_SGATE), F.b_down, F.ws + WS_Y, (int*)(F.ws + WS_TSLOT), T, F.G, F.vc, F.flags};
    gm::gemm_phase<P5Pol>(F.lds, S);
}

__device__ __forceinline__ void phase_final(Ctx& F) {
    const int gw = F.bid * NWAVES + F.wave, NGW = F.G * NWAVES;
    const unsigned char* Y = F.ws + WS_Y; const int* TS = (const int*)(F.ws + WS_TSLOT);
    f32x4 g4[4];
#pragma unroll
    for (int j = 0; j < 4; ++j) g4[j] = ((const f32x4*)F.fin_gain + F.lane)[64 * j];
#define PF_ROW(R) (((R) < NTOK) ? (R) : NTOK - 1)
#define PF_TS(R) TS[PF_ROW(R) * 4 + (F.lane & 3)]
#define PF_LOAD(HB, YV, R, TSV) { const int r_ = PF_ROW(R); \
        const int s0 = __builtin_amdgcn_readlane(TSV, 0), s1 = __builtin_amdgcn_readlane(TSV, 1), s2 = __builtin_amdgcn_readlane(TSV, 2), s3 = __builtin_amdgcn_readlane(TSV, 3); \
        const u32x2* hr = (const u32x2*)((const bf16*)(F.ws + WS_H1B) + (size_t)r_ * DM) + F.lane; \
        const unsigned* y0 = (const unsigned*)(Y + (size_t)s0 * DM) + F.lane; const unsigned* y1 = (const unsigned*)(Y + (size_t)s1 * DM) + F.lane; \
        const unsigned* y2 = (const unsigned*)(Y + (size_t)s2 * DM) + F.lane; const unsigned* y3 = (const unsigned*)(Y + (size_t)s3 * DM) + F.lane; \
        _Pragma("unroll") for (int j = 0; j < 4; ++j) { HB[j] = hr[64 * j]; YV[4 * j] = y0[64 * j]; YV[4 * j + 1] = y1[64 * j]; YV[4 * j + 2] = y2[64 * j]; YV[4 * j + 3] = y3[64 * j]; } }
#define PF_USE(HB, YV, R) { const int m_ = (R); if (m_ < NTOK) { \
        f32x4* xr = (f32x4*)(F.out + (size_t)m_ * DM) + F.lane; \
        f32x4 v[4]; float s = 0.f; \
        _Pragma("unroll") for (int j = 0; j < 4; ++j) { const u32x2 hb = HB[j]; v[j] = (f32x4){bflo(hb.x), bfhi(hb.x), bflo(hb.y), bfhi(hb.y)}; const unsigned a = YV[4 * j], b = YV[4 * j + 1], c = YV[4 * j + 2], d = YV[4 * j + 3]; \
            const f32x2 al = __builtin_amdgcn_cvt_pk_f32_fp8((int)a, false), ah = __builtin_amdgcn_cvt_pk_f32_fp8((int)a, true), bl = __builtin_amdgcn_cvt_pk_f32_fp8((int)b, false), bh = __builtin_amdgcn_cvt_pk_f32_fp8((int)b, true); \
            const f32x2 cl = __builtin_amdgcn_cvt_pk_f32_fp8((int)c, false), ch = __builtin_amdgcn_cvt_pk_f32_fp8((int)c, true), dl = __builtin_amdgcn_cvt_pk_f32_fp8((int)d, false), dh = __builtin_amdgcn_cvt_pk_f32_fp8((int)d, true); \
            v[j].x += ((al[0] + bl[0]) + (cl[0] + dl[0])) * Y8_INV; v[j].y += ((al[1] + bl[1]) + (cl[1] + dl[1])) * Y8_INV; \
            v[j].z += ((ah[0] + bh[0]) + (ch[0] + dh[0])) * Y8_INV; v[j].w += ((ah[1] + bh[1]) + (ch[1] + dh[1])) * Y8_INV; \
            s += (v[j].x * v[j].x + v[j].y * v[j].y) + (v[j].z * v[j].z + v[j].w * v[j].w); } \
        const float rstd = 1.0f / sqrtf(wave_sum(s) * (1.f / DM) + EPS); \
        _Pragma("unroll") for (int j = 0; j < 4; ++j) xr[64 * j] = v[j] * rstd * g4[j]; } }
    u32x2 hA[4], hB[4]; unsigned yA[16], yB[16];
    int ts0 = PF_TS(gw), ts1 = PF_TS(gw + NGW);
    PF_LOAD(hA, yA, gw, ts0)
    ts0 = PF_TS(gw + 2 * NGW);
    for (int m = gw; m < NTOK; m += 2 * NGW) {
        PF_LOAD(hB, yB, m + NGW, ts1)       ts1 = PF_TS(m + 3 * NGW);
        PF_USE(hA, yA, m)
        PF_LOAD(hA, yA, m + 2 * NGW, ts0)   ts0 = PF_TS(m + 4 * NGW);
        PF_USE(hB, yB, m + NGW)
    }
#undef PF_ROW
#undef PF_TS
#undef PF_LOAD
#undef PF_USE
}

struct Args { const float* in[17]; float* out; unsigned char* ws; int ph_lo, ph_hi, flags, pad; };
constexpr int NPHASE = 9;
__global__ void __launch_bounds__(NTHR, 2) fwd_kernel(Args args) {
    extern __shared__ __attribute__((aligned(16))) unsigned char lds_raw[];
    Ctx F;
    F.x = args.in[0]; F.w_in = args.in[1]; F.w_out = args.in[2]; F.lb_logits = args.in[3]; F.hg_gain = args.in[4]; F.sb_gain = args.in[5]; F.mix_gain = args.in[6]; F.ffn_gain = args.in[7];
    F.w_router = args.in[8]; F.b_router = args.in[9]; F.w_gate = args.in[10]; F.b_gate = args.in[11]; F.w_up = args.in[12]; F.b_up = args.in[13]; F.w_down = args.in[14]; F.b_down = args.in[15]; F.fin_gain = args.in[16];
    F.out = args.out; F.ws = args.ws; F.lds = (LAS unsigned char*)lds_raw;
    F.tid = threadIdx.x; F.lane = F.tid & 63; F.wave = __builtin_amdgcn_readfirstlane(F.tid >> 6); F.G = gridDim.x; F.bid = blockIdx.x; F.flags = args.flags;
    volatile LAS unsigned* MISC = (volatile LAS unsigned*)(F.lds + MISC_OFF);
    if (F.tid < 64) MISC[F.tid] = 0u;
    __syncthreads();
    const int lo = args.ph_lo, hi = args.ph_hi;
    XcdBarrier bar; bar.bar = (unsigned*)(F.ws + WS_CTL) + CW_BAR; bar.x = 0; bar.st = nullptr;
    if (hi - lo > 1) bar = xcd_barrier_post((unsigned*)(F.ws + WS_CTL) + CW_BAR, MISC + 8);
#ifdef TEST_PHASE
#define IN(k) ((k) == TEST_PHASE && lo <= (k))
#else
#define IN(k) (lo <= (k) && (k) < hi)
#endif
#define SEAM(k) do { if (IN(k) && IN((k) + 1)) xcd_barrier(bar); } while (0)
    if (IN(0)) { phase0(F); } SEAM(0);
    F.vc = F.bid;
    if (hi - lo > 1 && IN(0)) {
        if (F.tid == 0) { bool ok = (F.G % 8 == 0); unsigned* bw = (unsigned*)(F.ws + WS_CTL) + CW_BAR;
            unsigned cv[16];
#pragma unroll
            for (unsigned j = 0; j < 16; ++j) cv[j] = xb_ld(&bw[XB_XCNT(j)]);
            asm volatile("" ::: "memory");
#pragma unroll
            for (unsigned j = 0; j < 16; ++j) { const unsigned c = cv[j]; ok = ok && (j < 8 ? c == (unsigned)F.G / 8 : c == 0u); }
            MISC[3] = ok ? (MISC[10] * 8u + bar.x) : (unsigned)F.bid; }
        __syncthreads();
        F.vc = __builtin_amdgcn_readfirstlane((int)MISC[3]);
    }
    if (IN(1)) { phase1(F); } SEAM(1);
    if (IN(2)) {
        if (F.tid < 256) *(LAS f32x4*)(F.lds + 122880 + F.tid * 16) = *(const f32x4*)(F.ffn_gain + F.tid * 4);
        else if (F.tid < 384) *(LAS f32x4*)(F.lds + SBG_OFF + (F.tid - 256) * 16) = *(const f32x4*)(F.sb_gain + (F.tid - 256) * 4);
        hgrn_passA(F);
        if (F.wave < ATT_NW) sb_attn_fast(F, ATT_NW);
        moe_convert_jobs(F, (LAS float*)(F.lds + 49152 + F.wave * 8704), (const LAS float*)(F.lds + 122880));
        } SEAM(2);
    if (IN(3)) { hgrn_passB(F); if (hi - lo > 1) xcd_barrier(bar); hgrn_passC(F); } SEAM(3);
    if (IN(4)) { phase3(F); }
    if (IN(5)) router_stage_weights(F);
    SEAM(4);
    if (IN(5)) { phase_router_fast(F); } SEAM(5);
    RbTab Tgu; Tgu.e = nullptr; Tgu.start = nullptr; Tgu.rows = nullptr; Tgu.off = nullptr; Tgu.nrb = 0;
    if (IN(6)) { Tgu = phase_gateup(F); } SEAM(6);
    if (IN(7)) { phase_down(F, Tgu, IN(6)); } SEAM(7);
    if (IN(8)) { phase_final(F); }
#undef IN
#undef SEAM
}

extern "C" void kernel_launch(void* const* d_in, const int* in_sizes, int n_in, void* d_out, int out_size, void* d_ws, size_t ws_size, hipStream_t stream) {
    static int grid = 0;
    if (grid == 0) {
        if (n_in != 17 || in_sizes[0] != NTOK * DM || out_size != NTOK * DM || ws_size < WS_END2) {
            fprintf(stderr, "kernel_launch: unexpected shapes / workspace (n_in %d, in0 %d, out %d, ws %zu, need %zu); nothing launched\n", n_in, n_in > 0 ? in_sizes[0] : -1, out_size, ws_size, (size_t)WS_END); grid = -1; return; }
        int dev = 0, cus = 0;
        if (hipGetDevice(&dev) != hipSuccess || hipDeviceGetAttribute(&cus, hipDeviceAttributeMultiprocessorCount, dev) != hipSuccess) { grid = -1; return; }
        if (hipFuncSetAttribute((const void*)fwd_kernel, hipFuncAttributeMaxDynamicSharedMemorySize, LDS_BYTES) != hipSuccess) { fprintf(stderr, "kernel_launch: hipFuncSetAttribute failed\n"); grid = -1; return; }
        int per_cu = 0;
        if (hipOccupancyMaxActiveBlocksPerMultiprocessor(&per_cu, (const void*)fwd_kernel, NTHR, LDS_BYTES) != hipSuccess || per_cu < 1) fprintf(stderr, "kernel_launch: occupancy query reports %d\n", per_cu);
        (void)hipGetLastError();
        grid = cus;
    }
    if (grid < 0) return;
    (void)hipMemsetAsync((char*)d_ws + WS_CTL, 0, CTL_BYTES, stream);
    Args a{};
    for (int i = 0; i < 17; ++i) a.in[i] = (const float*)d_in[i];
    a.out = (float*)d_out; a.ws = (unsigned char*)d_ws;
#if N_LAUNCH_MODE == 1
#ifdef PROBE_K
    a.ph_lo = 0; a.ph_hi = PROBE_K; a.flags = PROBE_FLAGS;
    hipLaunchKernelGGL(fwd_kernel, dim3(grid), dim3(NTHR), LDS_BYTES, stream, a);
    (void)hipMemsetAsync((char*)d_ws + WS_CTL, 0, CTL_BYTES, stream);
#endif
    a.ph_lo = 0; a.ph_hi = NPHASE; a.flags = 0;
    hipLaunchKernelGGL(fwd_kernel, dim3(grid), dim3(NTHR), LDS_BYTES, stream, a);
#else
    for (int p = 0; p < NPHASE; ++p) { a.ph_lo = p; a.ph_hi = p + 1; hipLaunchKernelGGL(fwd_kernel, dim3(grid), dim3(NTHR), LDS_BYTES, stream, a); }
#endif
}
```
